# Optimizing an MI355X kernel written in HIP

```python
import math
import jax, jax.numpy as jnp
from jax import lax
import numpy as np

D_MODEL = 1024
BATCH = 16
SEQ = 2048
DEPTH = 4

N_POOL_GROUPS = 4
POOL_GROUP_DIM = 128
POOL_WIDTH = N_POOL_GROUPS * POOL_GROUP_DIM
POOL_WINDOWS = (2, 4, 8, 16)

ATT_HEADS = 4
ATT_QK_DIM = 64
ATT_V_DIM = 2 * ATT_QK_DIM
ATT_QK_WIDTH = ATT_HEADS * 2 * ATT_QK_DIM
ATT_WIDTH = ATT_HEADS * ATT_V_DIM
Q_BLOCK = 128

REC_HEADS = 4
REC_K_DIM = 128
REC_V_DIM = 128
REC_K_WIDTH = REC_HEADS * REC_K_DIM
REC_WIDTH = REC_HEADS * REC_V_DIM
REC_CHUNK = 64

N_BRANCHES = 3
FFN_HIDDEN = ((math.ceil(8 * D_MODEL / 3) + 255) // 256) * 256
NORM_EPS = 1e-6

IN_SIZES = (
    POOL_WIDTH,
    ATT_QK_WIDTH, ATT_QK_WIDTH, ATT_WIDTH,
    REC_K_WIDTH, REC_K_WIDTH, REC_K_WIDTH,
    REC_WIDTH, REC_WIDTH,
    N_BRANCHES * D_MODEL,
)
IN_COLS = (POOL_WIDTH + 2 * ATT_QK_WIDTH + ATT_WIDTH + 3 * REC_K_WIDTH
           + 2 * REC_WIDTH + N_BRANCHES * D_MODEL)

kernel_name = "hybrid_pool_diffattn_hgrn2_encoder"


def rms_norm(x, g):
    xf = x.astype(jnp.float32)
    y = xf * lax.rsqrt(jnp.mean(xf * xf, axis=-1, keepdims=True) + NORM_EPS)
    return (y * g).astype(x.dtype)


def split_cols(proj):
    out, off = [], 0
    for n in IN_SIZES:
        out.append(proj[..., off:off + n])
        off += n
    return out


def pool_mixer(u, pool_w, pool_scale):
    B, S, _ = u.shape
    uf = u.astype(jnp.float32).reshape(B, S, N_POOL_GROUPS, POOL_GROUP_DIM)
    cs = jnp.concatenate([jnp.zeros((B, 1, N_POOL_GROUPS, POOL_GROUP_DIM), jnp.float32),
                          jnp.cumsum(uf, axis=1)], axis=1)
    t = jnp.arange(S)
    outs = []
    for g, w in enumerate(POOL_WINDOWS):
        lo = jnp.clip(t - w // 2, 0, S - 1)
        hi = jnp.clip(t + w // 2 - 1, 0, S - 1)
        cnt = (hi - lo + 1).astype(jnp.float32)
        mean = (cs[:, hi + 1, g] - cs[:, lo, g]) / cnt[None, :, None]
        outs.append(mean - uf[:, :, g])
    d = jnp.stack(outs, axis=2).astype(u.dtype)
    y = jnp.einsum('bsgc,gcd->bsgd', d, pool_w).reshape(B, S, POOL_WIDTH)
    return y * pool_scale


def diff_attention(q, k, v, lam, gain, lambda_init):
    B, S, _ = q.shape
    q = q.reshape(B, S, ATT_HEADS, 2, ATT_QK_DIM)
    k = k.reshape(B, S, ATT_HEADS, 2, ATT_QK_DIM)
    v = v.reshape(B, S, ATT_HEADS, ATT_V_DIM)
    scale = ATT_QK_DIM ** -0.5
    slopes = jnp.exp2(-8.0 * jnp.arange(1, ATT_HEADS + 1, dtype=jnp.float32) / ATT_HEADS)
    pos = jnp.arange(S, dtype=jnp.float32)
    nb = S // Q_BLOCK
    qb = q.reshape(B, nb, Q_BLOCK, ATT_HEADS, 2, ATT_QK_DIM).swapaxes(0, 1)
    pb = pos.reshape(nb, Q_BLOCK)

    def block(args):
        qblk, qpos = args
        s = jnp.einsum('bqhcd,bkhcd->bhcqk', qblk, k,
                       preferred_element_type=jnp.float32) * scale
        dist = jnp.abs(qpos[:, None] - pos[None, :])
        s = s - slopes[:, None, None, None] * dist
        p = jax.nn.softmax(s, axis=-1)
        a = (p[:, :, 0] - lam * p[:, :, 1]).astype(v.dtype)
        return jnp.einsum('bhqk,bkhe->bqhe', a, v)

    o = lax.map(block, (qb, pb))
    o = o.swapaxes(0, 1).reshape(B, S, ATT_HEADS, ATT_V_DIM)
    o = rms_norm(o, gain) * (1.0 - lambda_init)
    return o.reshape(B, S, ATT_WIDTH)


def gla_direction(q, k, v, logf):
    B, S, H, DK = q.shape
    DV = v.shape[-1]
    L = REC_CHUNK
    nc = S // L

    def chunks(t):
        return t.astype(jnp.float32).reshape(B, nc, L, H, t.shape[-1]).transpose(1, 0, 3, 2, 4)

    tril = jnp.tril(jnp.ones((L, L), dtype=bool))[:, :, None]

    def step(state, inp):
        qc, kc, vc, gc = inp
        b = jnp.cumsum(gc, axis=2)
        b_last = b[:, :, -1:, :]
        o_inter = jnp.einsum('bhtk,bhkv->bhtv', qc * jnp.exp(b), state)
        rel = b[:, :, :, None, :] - b[:, :, None, :, :]
        decay = jnp.exp(jnp.where(tril, rel, -jnp.inf))
        scores = jnp.einsum('bhtk,bhsk,bhtsk->bhts', qc, kc, decay)
        o_intra = jnp.einsum('bhts,bhsv->bhtv', scores, vc)
        state = (jnp.exp(b_last).swapaxes(-1, -2) * state
                 + jnp.einsum('bhsk,bhsv->bhkv', kc * jnp.exp(b_last - b), vc))
        return state, o_inter + o_intra

    s0 = jnp.zeros((B, H, DK, DV), jnp.float32)
    _, o = lax.scan(step, s0, (chunks(q), chunks(k), chunks(v), chunks(logf)))
    return o.transpose(1, 0, 3, 2, 4).reshape(B, S, H, DV)


def hgrn2_mixer(q, f_fwd, f_bwd, i, g, lb_fwd, lb_bwd, gain):
    B, S, _ = q.shape
    heads = lambda t, d: t.reshape(B, S, REC_HEADS, d)
    qh = heads(q, REC_K_DIM).astype(jnp.float32) * (REC_K_DIM ** -0.5)
    ih = heads(i, REC_V_DIM)

    def gates(z, lb):
        lb = lb.astype(jnp.float32).reshape(REC_HEADS, REC_K_DIM)
        logf = jnp.logaddexp(jnp.log(lb), jnp.log1p(-lb)
                             + jax.nn.log_sigmoid(heads(z, REC_K_DIM).astype(jnp.float32)))
        return -jnp.expm1(logf), logf

    kf, lf = gates(f_fwd, lb_fwd)
    kb, lbk = gates(f_bwd, lb_bwd)
    o_f = gla_direction(qh, kf, ih, lf)
    flip = lambda t: jnp.flip(t, axis=1)
    o_b = flip(gla_direction(flip(qh), flip(kb), flip(ih), flip(lbk)))
    o = rms_norm((o_f + o_b).astype(q.dtype), gain).reshape(B, S, REC_WIDTH)
    return o * jax.nn.silu(g)


def setup_inputs(seed: int = 0) -> dict:
    key = jax.random.key(seed)
    ks = jax.random.split(key, 21)
    f32 = jnp.float32
    nrm = lambda k, shape: jax.random.normal(k, shape, f32)
    return {
        "x": nrm(ks[0], (BATCH, SEQ, D_MODEL)),
        "norm1_g": 1.0 + 0.02 * nrm(ks[1], (DEPTH, D_MODEL)),
        "w_in": nrm(ks[2], (DEPTH, D_MODEL, IN_COLS)) * D_MODEL ** -0.5,
        "pool_w": nrm(ks[3], (DEPTH, N_POOL_GROUPS, POOL_GROUP_DIM, POOL_GROUP_DIM)) * POOL_GROUP_DIM ** -0.5,
        "pool_scale": 1.0 + 0.1 * nrm(ks[4], (DEPTH, POOL_WIDTH)),
        "lam_q1": 0.1 * nrm(ks[5], (DEPTH, ATT_QK_DIM)),
        "lam_k1": 0.1 * nrm(ks[6], (DEPTH, ATT_QK_DIM)),
        "lam_q2": 0.1 * nrm(ks[7], (DEPTH, ATT_QK_DIM)),
        "lam_k2": 0.1 * nrm(ks[8], (DEPTH, ATT_QK_DIM)),
        "diff_norm_g": 1.0 + 0.02 * nrm(ks[9], (DEPTH, ATT_V_DIM)),
        "hgrn_lb": 0.5 * nrm(ks[10], (2, DEPTH, REC_K_WIDTH)),
        "hgrn_norm_g": 1.0 + 0.02 * nrm(ks[11], (DEPTH, REC_V_DIM)),
        "w_up_pool": nrm(ks[12], (DEPTH, POOL_WIDTH, D_MODEL)) * POOL_WIDTH ** -0.5,
        "w_up_attn": nrm(ks[13], (DEPTH, ATT_WIDTH, D_MODEL)) * ATT_WIDTH ** -0.5,
        "w_up_rec": nrm(ks[14], (DEPTH, REC_WIDTH, D_MODEL)) * REC_WIDTH ** -0.5,
        "w_out": nrm(ks[15], (DEPTH, D_MODEL, D_MODEL)) * D_MODEL ** -0.5,
        "norm2_g": 1.0 + 0.02 * nrm(ks[16], (DEPTH, D_MODEL)),
        "w_ffn_in": nrm(ks[17], (DEPTH, D_MODEL, 2 * FFN_HIDDEN)) * D_MODEL ** -0.5,
        "w_ffn_out": nrm(ks[18], (DEPTH, FFN_HIDDEN, D_MODEL)) * FFN_HIDDEN ** -0.5,
        "final_norm_g": 1.0 + 0.02 * nrm(ks[19], (D_MODEL,)),
    }


def reference(x, norm1_g, w_in, pool_w, pool_scale, lam_q1, lam_k1, lam_q2, lam_k2,
              diff_norm_g, hgrn_lb, hgrn_norm_g, w_up_pool, w_up_attn, w_up_rec, w_out,
              norm2_g, w_ffn_in, w_ffn_out, final_norm_g):
    B, S, _ = x.shape
    lb_all = jnp.cumsum(jax.nn.softmax(hgrn_lb.astype(jnp.float32), axis=1), axis=1)
    lb_all = lb_all - lb_all[:, :1]
    for l in range(DEPTH):
        h = rms_norm(x, norm1_g[l])
        proj = h @ w_in[l]
        u_pool, aq, ak, av, rq, rf, rb, ri, rg, gate_pre = split_cols(proj)

        y_pool = pool_mixer(u_pool, pool_w[l], pool_scale[l])

        lambda_init = 0.8 - 0.6 * math.exp(-0.3 * l)
        lam = (jnp.exp(jnp.sum(lam_q1[l].astype(jnp.float32) * lam_k1[l].astype(jnp.float32)))
               - jnp.exp(jnp.sum(lam_q2[l].astype(jnp.float32) * lam_k2[l].astype(jnp.float32)))
               + lambda_init)
        y_attn = diff_attention(aq, ak, av, lam, diff_norm_g[l], lambda_init)

        y_rec = hgrn2_mixer(rq, rf, rb, ri, rg, lb_all[0, l], lb_all[1, l], hgrn_norm_g[l])

        gates = jax.nn.sigmoid(gate_pre.reshape(B, S, N_BRANCHES, D_MODEL))
        merged = (gates[:, :, 0] * (y_pool @ w_up_pool[l])
                  + gates[:, :, 1] * (y_attn @ w_up_attn[l])
                  + gates[:, :, 2] * (y_rec @ w_up_rec[l]))
        x = x + merged @ w_out[l]

        h2 = rms_norm(x, norm2_g[l])
        gu = h2 @ w_ffn_in[l]
        x = x + (jax.nn.silu(gu[..., :FFN_HIDDEN]) * gu[..., FFN_HIDDEN:]) @ w_ffn_out[l]
    return rms_norm(x, final_norm_g)
```

```cpp
#include <hip/hip_runtime.h>
#include <hip/hip_cooperative_groups.h>
#include <cstdio>
#include <cstdint>
namespace cg = cooperative_groups;
namespace pg8 {
#define PG8_LAS __attribute__((address_space(3)))
typedef unsigned short bf16_t;
typedef short bf16x8 __attribute__((ext_vector_type(8)));
typedef float f32x4 __attribute__((ext_vector_type(4)));
typedef unsigned u32x4 __attribute__((ext_vector_type(4)));
constexpr int BM = 256, BK = 64, HALF = 128, HTB = HALF * BK * 2  , STAGE_BYTES = 8 * HTB, NXCD = 8, WGM = 8;

__host__ __device__ __forceinline__ int lds_byte(int r, int c) { const int st = (r >> 4) * 2 + (c >> 5), rr = r & 15, cc = c & 31, ob = rr * 64 + cc * 2; return st * 1024 + (ob ^ (((ob >> 9) & 1) << 5)); }
__host__ __device__ __forceinline__ void stage_rc(int b, int& R, int& C) { const int st = b / 1024, sb = b % 1024, swz = sb ^ (((sb >> 9) & 1) << 5); R = (st >> 1) * 16 + swz / 64; C = (st & 1) * 32 + (swz % 64) / 2; }
__host__ __device__ __forceinline__ int perm32(int rho) { const int n = rho >> 4, i = rho & 15; return 8 * (i >> 2) + 4 * n + (i & 3); }

struct Unit { int pm, pn; };
struct Gemm { const bf16_t* A; const bf16_t* Bt; int M, N, K; };

struct StaticOrder {
    int nM, nN, nwg, G, c;
    __host__ __device__ void init(int M, int N, int G_, int c_) { nM = M / BM; nN = N / BM; nwg = nM * nN; G = G_; c = c_; }
    __host__ __device__ bool next(int i, Unit& u) const {
        const long L = (long)i * G + c; if (L >= nwg) return false;
        int wgid = (int)L; { const int q = nwg / NXCD, r = nwg % NXCD, xcd = wgid % NXCD, off = wgid / NXCD; wgid = (xcd < r ? xcd * (q + 1) : r * (q + 1) + (xcd - r) * q) + off; }
        const int nig = WGM * nN, gid = wgid / nig, fm = gid * WGM, gsz = (nM - fm) < WGM ? (nM - fm) : WGM;
        u.pm = fm + ((wgid % nig) % gsz); u.pn = (wgid % nig) / gsz; return true;
    }
    __device__ __forceinline__ void a_ready(const Unit&) const {}
    __device__ __forceinline__ void done(const Unit&) const {}
};

typedef float f32x2c_ __attribute__((ext_vector_type(2)));
typedef __bf16 bf16x2c_ __attribute__((ext_vector_type(2)));
__device__ __forceinline__ unsigned cvt_pk_bf16(float lo, float hi) { const f32x2c_ v = {lo, hi}; const bf16x2c_ b = __builtin_convertvector(v, bf16x2c_); return __builtin_bit_cast(unsigned, b); }
typedef float f32x2 __attribute__((ext_vector_type(2)));
__device__ __forceinline__ float fast_sigmoid(float x) { return __builtin_amdgcn_rcpf(1.0f + __expf(-x)); }
typedef unsigned u32x2v __attribute__((ext_vector_type(2)));
struct EpiStore {
    static constexpr bool PERM = true, AFTER_DRAIN = false;
    bf16_t* O; int ldc;
    __device__ __forceinline__ void operator()(const f32x4 (&acc)[2][2][4][2], const Unit& u, int wr, int wc, int fr, int fq) const {
        const int row0 = u.pm * BM + wr * 64 + fr; const int col0 = u.pn * BM + wc * 32 + 8 * fq;
#pragma unroll
        for (int ai = 0; ai < 2; ++ai)
#pragma unroll
            for (int m = 0; m < 4; ++m) { bf16_t* rowp = O + (size_t)(row0 + ai * HALF + m * 16) * ldc + col0;
#pragma unroll
                for (int bj = 0; bj < 2; ++bj) { const f32x4 v0 = acc[ai][bj][m][0], v1 = acc[ai][bj][m][1];
                    u32x4 w; w.x = cvt_pk_bf16(v0[0], v0[1]); w.y = cvt_pk_bf16(v0[2], v0[3]); w.z = cvt_pk_bf16(v1[0], v1[1]); w.w = cvt_pk_bf16(v1[2], v1[3]);
                    *(u32x4*)(rowp + bj * HALF) = w; } }
    }
};
struct EpiMerge {
    static constexpr bool PERM = true, AFTER_DRAIN = false;
    bf16_t* proj; int ldp; int gate_col0; bf16_t* merged; int MT;
    __device__ __forceinline__ void operator()(const f32x4 (&acc)[2][2][4][2], const Unit& u, int wr, int wc, int fr, int fq) const {
        const int br = u.pm / MT, pmt = u.pm - br * MT, pnt = u.pn & 3;
        const int row0 = pmt * BM + wr * 64 + fr; const int col0 = pnt * BM + wc * 32 + 8 * fq;
#pragma unroll
        for (int ai = 0; ai < 2; ++ai)
#pragma unroll
            for (int m = 0; m < 4; ++m) { const size_t row = (size_t)(row0 + ai * HALF + m * 16); bf16_t* prow = proj + row * ldp;
#pragma unroll
                for (int bj = 0; bj < 2; ++bj) { const int col = col0 + bj * HALF;
                    const u32x4 gw = *(const u32x4*)(prow + gate_col0 + br * 1024 + col);
                    f32x4 g0, g1;
                    g0[0] = fast_sigmoid(__uint_as_float(gw.x << 16)); g0[1] = fast_sigmoid(__uint_as_float(gw.x & 0xffff0000u));
                    g0[2] = fast_sigmoid(__uint_as_float(gw.y << 16)); g0[3] = fast_sigmoid(__uint_as_float(gw.y & 0xffff0000u));
                    g1[0] = fast_sigmoid(__uint_as_float(gw.z << 16)); g1[1] = fast_sigmoid(__uint_as_float(gw.z & 0xffff0000u));
                    g1[2] = fast_sigmoid(__uint_as_float(gw.w << 16)); g1[3] = fast_sigmoid(__uint_as_float(gw.w & 0xffff0000u));
                    f32x4 v0 = g0 * acc[ai][bj][m][0], v1 = g1 * acc[ai][bj][m][1];
                    float* part = (float*)prow + col;
                    if (br > 0) { v0 += *(const f32x4*)part; v1 += *(const f32x4*)(part + 4); }
                    if (br < 2) { *(f32x4*)part = v0; *(f32x4*)(part + 4) = v1; }
                    else { u32x4 w; w.x = cvt_pk_bf16(v0[0], v0[1]); w.y = cvt_pk_bf16(v0[2], v0[3]); w.z = cvt_pk_bf16(v1[0], v1[1]); w.w = cvt_pk_bf16(v1[2], v1[3]);
                        *(u32x4*)(merged + row * 1024 + col) = w; } } }
    }
};
struct EpiResid {
    static constexpr bool PERM = false, AFTER_DRAIN = false;
    const float* base; float* out; int ldc;
    __device__ __forceinline__ void operator()(const f32x4 (&acc)[2][2][4][2], const Unit& u, int wr, int wc, int fr, int fq) const {
        const int row0 = u.pm * BM + wr * 64 + fr; const int col0 = u.pn * BM + wc * 32 + 4 * fq;
#pragma unroll
        for (int ai = 0; ai < 2; ++ai)
#pragma unroll
            for (int m = 0; m < 4; ++m) { const size_t off = (size_t)(row0 + ai * HALF + m * 16) * ldc + col0;
#pragma unroll
                for (int bj = 0; bj < 2; ++bj)
#pragma unroll
                    for (int n = 0; n < 2; ++n) { const f32x4 bs = *(const f32x4*)(base + off + bj * HALF + n * 16); *(f32x4*)(out + off + bj * HALF + n * 16) = bs + acc[ai][bj][m][n]; } }
    }
};
struct EpiSwiGLU {
    static constexpr bool PERM = true, AFTER_DRAIN = false;
    bf16_t* O; int ldc;
    __device__ __forceinline__ void operator()(const f32x4 (&acc)[2][2][4][2], const Unit& u, int wr, int wc, int fr, int fq) const {
        const int row0 = u.pm * BM + wr * 64 + fr; const int col0 = u.pn * HALF + wc * 32 + 8 * fq;
#pragma unroll
        for (int ai = 0; ai < 2; ++ai)
#pragma unroll
            for (int m = 0; m < 4; ++m) { bf16_t* rowp = O + (size_t)(row0 + ai * HALF + m * 16) * ldc + col0;
                f32x4 r0, r1;
#pragma unroll
                for (int e = 0; e < 4; ++e) { const float ga = acc[ai][0][m][0][e], gb = acc[ai][0][m][1][e];
                    r0[e] = ga * fast_sigmoid(ga) * acc[ai][1][m][0][e]; r1[e] = gb * fast_sigmoid(gb) * acc[ai][1][m][1][e]; }
                u32x4 w; w.x = cvt_pk_bf16(r0[0], r0[1]); w.y = cvt_pk_bf16(r0[2], r0[3]); w.z = cvt_pk_bf16(r1[0], r1[1]); w.w = cvt_pk_bf16(r1[2], r1[3]);
                *(u32x4*)rowp = w; }
    }
};
struct MergeOrder {
    StaticOrder S; int MT;
    __device__ void init(int M, int G_, int c_) { S.init(M, 1024, G_, c_); MT = M / BM; }
    __device__ bool next(int i, Unit& u) const { const int t = i / 3, br = i - 3 * t; Unit b; if (!S.next(t, b)) return false; u.pm = br * MT + b.pm; u.pn = br * 4 + b.pn; return true; }
    __device__ __forceinline__ void a_ready(const Unit&) const {}
    __device__ __forceinline__ void done(const Unit&) const {}
};

template <class Epi, class Sched, bool ALIGN_EPI = false, bool SP2 = false>
__device__ __forceinline__ void gemm_phase(PG8_LAS unsigned char* lds, const Gemm g, const Sched& S, const Epi& E) {
    int tid_ = threadIdx.x; asm volatile("" : "+v"(tid_));
    const int tid = tid_, wid = __builtin_amdgcn_readfirstlane(tid >> 6), lane = tid & 63, wr = wid >> 2, wc = wid & 3, fr = lane & 15, fq = lane >> 4;
    const int K = g.K, nt = K / BK;
    unsigned voffA[2], voffB[2];
#pragma unroll
    for (int i = 0; i < 2; ++i) { int R, C; stage_rc(tid * 16 + i * 8192, R, C); const int Rb = Epi::PERM ? ((R & ~31) + perm32(R & 31)) : R;
        voffA[i] = (unsigned)(R * K + C) * 2u; voffB[i] = (unsigned)(Rb * K + C) * 2u; }
    const size_t kstep = (size_t)(BK * 2);
    const size_t hstep = (size_t)HALF * K * 2;
    const size_t tstep = 2 * hstep;
    const unsigned ldsw = (unsigned)wid * 1024u;
    const int aoff = lds_byte(wr * 64 + fr, fq * 8), boff = lds_byte(wc * 32 + fr, fq * 8);
#define PG8_SA(b, h) (((b) * 2 + (h)) * HTB)
#define PG8_SB(b, h) ((4 + (b) * 2 + (h)) * HTB)
#define PG8_STAGE(bufoff, gbase, voff) do { _Pragma("unroll") for (int _i = 0; _i < 2; ++_i) \
        __builtin_amdgcn_global_load_lds((const unsigned*)((const char*)(gbase) + (voff)[_i]), (PG8_LAS unsigned*)(lds + (bufoff) + ldsw + _i * 8192), 16, 0, 0); } while (0)
#define PG8_LDA(dst, b, h) do { _Pragma("unroll") for (int m = 0; m < 4; ++m) _Pragma("unroll") for (int k = 0; k < 2; ++k) dst[m][k] = *(const PG8_LAS bf16x8*)(lds + PG8_SA(b, h) + aoff + m * 2048 + k * 1024); } while (0)
#define PG8_LDB(dst, b, h) do { _Pragma("unroll") for (int n = 0; n < 2; ++n) _Pragma("unroll") for (int k = 0; k < 2; ++k) dst[n][k] = *(const PG8_LAS bf16x8*)(lds + PG8_SB(b, h) + boff + n * 2048 + k * 1024); } while (0)
#define PG8_MMA(ai, bj, At, Bt) do { __builtin_amdgcn_s_setprio(1); _Pragma("unroll") for (int m = 0; m < 4; ++m) _Pragma("unroll") for (int n = 0; n < 2; ++n) _Pragma("unroll") for (int k = 0; k < 2; ++k) \
        acc[ai][bj][m][n] = __builtin_amdgcn_mfma_f32_16x16x32_bf16(Bt[n][k], At[m][k], acc[ai][bj][m][n], 0, 0, 0); __builtin_amdgcn_s_setprio(0); } while (0)
#define PG8_WAIT_V(n) asm volatile("s_waitcnt vmcnt(" #n ")" ::: "memory")
#define PG8_WAIT_L(n) asm volatile("s_waitcnt lgkmcnt(" #n ")" ::: "memory")
#define PG8_BAR __builtin_amdgcn_s_barrier()
#define PG8_SCHED __builtin_amdgcn_sched_barrier(0)
    Unit cur, nxt; int ui = 0;
    if (!S.next(0, cur)) return;
    f32x4 acc[2][2][4][2];
#pragma unroll
    for (int a = 0; a < 2; ++a)
#pragma unroll
        for (int b = 0; b < 2; ++b)
#pragma unroll
            for (int m = 0; m < 4; ++m)
#pragma unroll
                for (int n = 0; n < 2; ++n) acc[a][b][m][n] = (f32x4){0.f, 0.f, 0.f, 0.f};
    bf16x8 At[4][2], B0[2][2], B1[2][2];
    const char* cA = (const char*)g.A + (size_t)cur.pm * tstep; const char* cB = (const char*)g.Bt + (size_t)cur.pn * tstep;
    S.a_ready(cur);
    if constexpr (SP2) {
        PG8_STAGE(PG8_SB(0, 0), cB, voffB); PG8_STAGE(PG8_SB(0, 1), cB + hstep, voffB); PG8_STAGE(PG8_SA(0, 0), cA, voffA); PG8_STAGE(PG8_SA(0, 1), cA + hstep, voffA);
        if (wr == 1) PG8_BAR;
        PG8_WAIT_V(2); PG8_BAR;
        PG8_STAGE(PG8_SB(1, 0), cB + kstep, voffB); PG8_STAGE(PG8_SA(1, 0), cA + kstep, voffA); PG8_STAGE(PG8_SB(1, 1), cB + hstep + kstep, voffB);
        PG8_WAIT_V(6); PG8_BAR;
    } else {
        PG8_STAGE(PG8_SB(0, 0), cB, voffB); PG8_STAGE(PG8_SA(0, 0), cA, voffA); PG8_STAGE(PG8_SB(0, 1), cB + hstep, voffB); PG8_STAGE(PG8_SA(0, 1), cA + hstep, voffA);
        if (wr == 1) PG8_BAR;
        PG8_WAIT_V(4); PG8_BAR;
        PG8_STAGE(PG8_SB(1, 0), cB + kstep, voffB); PG8_STAGE(PG8_SA(1, 0), cA + kstep, voffA); PG8_STAGE(PG8_SB(1, 1), cB + hstep + kstep, voffB);
        PG8_WAIT_V(6); PG8_BAR;
    }
    for (;;) {
        const bool has_next = S.next(ui + 1, nxt);
        const char* nA = has_next ? (const char*)g.A + (size_t)nxt.pm * tstep : cA; const char* nB = has_next ? (const char*)g.Bt + (size_t)nxt.pn * tstep : cB;
        for (int t = 0; t < nt; t += 2) {
            const bool last = (t == nt - 2);
            const char* a1 = cA + (size_t)(t + 1) * kstep;
            const char* a2 = last ? nA : cA + (size_t)(t + 2) * kstep; const char* b2 = last ? nB : cB + (size_t)(t + 2) * kstep;
            const char* a3 = a2 + kstep; const char* b3 = b2 + kstep;
            if (last && has_next) S.a_ready(nxt);
            if constexpr (SP2) {
            PG8_LDB(B0, 0, 0); PG8_LDB(B1, 0, 1); PG8_SCHED; PG8_LDA(At, 0, 0); PG8_STAGE(PG8_SA(1, 1), a1 + hstep, voffA);
            PG8_WAIT_V(8); PG8_WAIT_L(0); PG8_BAR; PG8_MMA(0, 0, At, B0); PG8_MMA(0, 1, At, B1); PG8_BAR; PG8_SCHED;
            PG8_LDA(At, 0, 1); PG8_STAGE(PG8_SB(0, 0), b2, voffB); PG8_STAGE(PG8_SB(0, 1), b2 + hstep, voffB); PG8_STAGE(PG8_SA(0, 0), a2, voffA);
            PG8_WAIT_V(8); PG8_WAIT_L(0); PG8_BAR; PG8_MMA(1, 0, At, B0); PG8_MMA(1, 1, At, B1); PG8_BAR; PG8_SCHED;
            PG8_LDB(B0, 1, 0); PG8_LDB(B1, 1, 1); PG8_SCHED; PG8_LDA(At, 1, 0); PG8_STAGE(PG8_SA(0, 1), a2 + hstep, voffA);
            PG8_WAIT_V(8); PG8_WAIT_L(0); PG8_BAR; PG8_MMA(0, 0, At, B0); PG8_MMA(0, 1, At, B1); PG8_BAR; PG8_SCHED;
            PG8_LDA(At, 1, 1); PG8_STAGE(PG8_SB(1, 0), b3, voffB); PG8_STAGE(PG8_SB(1, 1), b3 + hstep, voffB); PG8_STAGE(PG8_SA(1, 0), a3, voffA);
            PG8_WAIT_V(8); PG8_WAIT_L(0); PG8_BAR; PG8_MMA(1, 0, At, B0); PG8_MMA(1, 1, At, B1); PG8_BAR; PG8_SCHED;
            } else {
            PG8_LDB(B0, 0, 0); PG8_SCHED; PG8_LDA(At, 0, 0); PG8_STAGE(PG8_SA(1, 1), a1 + hstep, voffA);
            PG8_WAIT_L(8); PG8_BAR; PG8_WAIT_L(0); PG8_MMA(0, 0, At, B0); PG8_BAR; PG8_SCHED;
            PG8_LDB(B1, 0, 1); PG8_STAGE(PG8_SB(0, 0), b2, voffB);
            PG8_BAR; PG8_WAIT_L(0); PG8_MMA(0, 1, At, B1); PG8_BAR;
            PG8_LDA(At, 0, 1); PG8_STAGE(PG8_SA(0, 0), a2, voffA);
            PG8_BAR; PG8_WAIT_L(0); PG8_MMA(1, 0, At, B0); PG8_BAR; PG8_SCHED;
            PG8_STAGE(PG8_SB(0, 1), b2 + hstep, voffB);
            PG8_WAIT_V(6); PG8_BAR; PG8_MMA(1, 1, At, B1); PG8_BAR;
            PG8_LDB(B0, 1, 0); PG8_SCHED; PG8_LDA(At, 1, 0); PG8_STAGE(PG8_SA(0, 1), a2 + hstep, voffA);
            PG8_WAIT_L(8); PG8_BAR; PG8_WAIT_L(0); PG8_MMA(0, 0, At, B0); PG8_BAR; PG8_SCHED;
            PG8_LDB(B1, 1, 1); PG8_STAGE(PG8_SB(1, 0), b3, voffB);
            PG8_BAR; PG8_WAIT_L(0); PG8_MMA(0, 1, At, B1); PG8_BAR;
            PG8_LDA(At, 1, 1); PG8_STAGE(PG8_SA(1, 0), a3, voffA);
            PG8_BAR; PG8_WAIT_L(0); PG8_MMA(1, 0, At, B0); PG8_BAR; PG8_SCHED;
            PG8_STAGE(PG8_SB(1, 1), b3 + hstep, voffB);
            PG8_WAIT_V(6); PG8_BAR; PG8_MMA(1, 1, At, B1); PG8_BAR;
            }
        }
        if constexpr (ALIGN_EPI) { if (wr == 0) PG8_BAR; }
        if constexpr (!Epi::AFTER_DRAIN) { E(acc, cur, wr, wc, fr, fq); S.done(cur); }
        if (!has_next) break;
#pragma unroll
        for (int a = 0; a < 2; ++a)
#pragma unroll
            for (int b = 0; b < 2; ++b)
#pragma unroll
                for (int m = 0; m < 4; ++m)
#pragma unroll
                    for (int n = 0; n < 2; ++n) acc[a][b][m][n] = (f32x4){0.f, 0.f, 0.f, 0.f};
        cur = nxt; cA = nA; cB = nB; ++ui;
        if constexpr (ALIGN_EPI) { if (wr == 1) PG8_BAR; }
    }
    PG8_WAIT_V(0);
    if constexpr (!ALIGN_EPI) { if (wr == 0) PG8_BAR; }
    PG8_BAR;
    if constexpr (Epi::AFTER_DRAIN) { E.fused(acc, cur, wr, wc, fr, fq, lds, wid, lane); S.done(cur); }
#undef PG8_SA
#undef PG8_SB
#undef PG8_STAGE
#undef PG8_LDA
#undef PG8_LDB
#undef PG8_MMA
#undef PG8_WAIT_V
#undef PG8_WAIT_L
#undef PG8_BAR
#undef PG8_SCHED
}
}

#define LAS __attribute__((address_space(3)))
typedef unsigned short bf16_t;
typedef short bf16x8 __attribute__((ext_vector_type(8)));
typedef float f32x4 __attribute__((ext_vector_type(4)));
typedef float f32x16 __attribute__((ext_vector_type(16)));
typedef unsigned u32x4 __attribute__((ext_vector_type(4)));
typedef unsigned u32x2 __attribute__((ext_vector_type(2)));

constexpr int D = 1024, SEQ = 2048, DEPTH = 4, NHALF = 2, HB = 8, TH = HB * SEQ;
constexpr int INC = 7680, FF = 2816;
constexpr int C_POOL = 0, C_AQ = 512, C_AK = 1024, C_AV = 1536, C_RQ = 2048, C_RF = 2560, C_RB = 3072, C_RI = 3584, C_RG = 4096, C_GATE = 4608;
constexpr float EPS = 1e-6f;
constexpr int NT = 512, NW = 8;
constexpr int LDS_BYTES = 155648;
constexpr int LDS_ITEM_OFF = 155136;

constexpr size_t MiB = 1u << 20;
constexpr size_t WS_CTL = 0, CTL_BYTES = 4096;
constexpr size_t WS_W = 2 * MiB, W_LAYER = 37 * MiB;
constexpr size_t WO_IN = 0, WO_POOL = (size_t)INC * D * 2, WO_UP = WO_POOL + 4 * 128 * 128 * 2, WO_OUT = WO_UP + (size_t)3 * D * 512 * 2,
                 WO_FFI = WO_OUT + (size_t)D * D * 2, WO_FFO = WO_FFI + (size_t)2 * FF * D * 2, WO_END = WO_FFO + (size_t)D * FF * 2;
static_assert(WO_END <= W_LAYER, "weights per layer");
constexpr size_t WS_PROJ = 150 * MiB;
constexpr size_t WS_H = 390 * MiB;
constexpr size_t WS_Y = 422 * MiB;
constexpr size_t WS_O2 = 470 * MiB;
constexpr size_t WS_END = 502 * MiB;
static_assert(WS_W + DEPTH * W_LAYER <= WS_PROJ && WS_PROJ + (size_t)TH * INC * 2 <= WS_H && WS_H + (size_t)TH * D * 2 <= WS_Y && WS_Y + (size_t)3 * TH * 512 * 2 <= WS_O2 && WS_O2 + (size_t)2 * TH * 512 * 2 <= WS_END, "ws map");

struct Params { const float* in[20]; float* out; unsigned char* ws; };
enum { I_X = 0, I_N1G, I_WIN, I_POOLW, I_POOLS, I_LQ1, I_LK1, I_LQ2, I_LK2, I_DNG, I_HLB, I_HNG, I_WUP, I_WUA, I_WUR, I_WOUT, I_N2G, I_WFI, I_WFO, I_FNG };

typedef float f32x2c __attribute__((ext_vector_type(2)));
typedef __bf16 bf16x2c __attribute__((ext_vector_type(2)));
__device__ __forceinline__ unsigned pkbf(float lo, float hi) { const f32x2c v = {lo, hi}; const bf16x2c b = __builtin_convertvector(v, bf16x2c); return __builtin_bit_cast(unsigned, b); }
__device__ __forceinline__ float bflo(unsigned w) { return __uint_as_float(w << 16); }
__device__ __forceinline__ float bfhi(unsigned w) { return __uint_as_float(w & 0xffff0000u); }
__device__ __forceinline__ float bfe(const u32x4& w, int e) { const unsigned x = w[e >> 1]; return (e & 1) ? bfhi(x) : bflo(x); }
__device__ __forceinline__ float sigm(float x) { return __builtin_amdgcn_rcpf(1.0f + __expf(-x)); }
__device__ __forceinline__ float wave_sum(float v) {
#pragma unroll
    for (int o = 1; o < 64; o <<= 1) v += __shfl_xor(v, o);
    return v;
}
#define BARRIER() __syncthreads()

__device__ __forceinline__ void p0_transpose_item(const float* W, int K, int N, bf16_t* WT, int row_off, int mode, LAS float* scr, int item, int lane) {
    const int nblk = N / 32, kb = item / nblk, nb = item - kb * nblk, k0 = 64 * kb, n0 = 32 * nb;
#pragma unroll 8
    for (int i = 0; i < 32; ++i) { const int kk = 2 * i + (lane >> 5); scr[kk * 33 + (lane & 31)] = W[(size_t)(k0 + kk) * N + n0 + (lane & 31)]; }
    asm volatile("s_waitcnt lgkmcnt(0)" ::: "memory");
    int drow0;
    if (mode == 1) { const int bj = n0 / FF, jj = n0 - bj * FF; drow0 = (jj >> 7) * 256 + bj * 128 + (jj & 127); } else drow0 = row_off + n0;
    const int c = lane & 7;
#pragma unroll
    for (int j = 0; j < 4; ++j) { const int n = (lane >> 3) + 8 * j; const LAS float* s = scr + (8 * c) * 33 + n;
        u32x4 o; o.x = pkbf(s[0 * 33], s[1 * 33]); o.y = pkbf(s[2 * 33], s[3 * 33]); o.z = pkbf(s[4 * 33], s[5 * 33]); o.w = pkbf(s[6 * 33], s[7 * 33]);
        *(u32x4*)(WT + (size_t)(drow0 + n) * K + k0 + 8 * c) = o; }
    asm volatile("s_waitcnt lgkmcnt(0)" ::: "memory");
}
__device__ __forceinline__ void p0_prologue(const Params& p, LAS unsigned char* lds, int gw, int NGW, int wave, int lane) {
    LAS float* scr = (LAS float*)(lds + wave * 16384);
    constexpr int I_IN = (D / 64) * (INC / 32), I_PL = 4 * 2 * 4, I_UP = (512 / 64) * (D / 32), I_OUT = (D / 64) * (D / 32), I_FI = (D / 64) * (2 * FF / 32), I_FO = (FF / 64) * (D / 32);
    constexpr int PER_LAYER = I_IN + I_PL + 3 * I_UP + I_OUT + I_FI + I_FO;
    for (int it = gw; it < DEPTH * PER_LAYER; it += NGW) {
        const int l = it / PER_LAYER; int r = it - l * PER_LAYER;
        unsigned char* wl = p.ws + WS_W + (size_t)l * W_LAYER;
        if (r < I_IN) { p0_transpose_item(p.in[I_WIN] + (size_t)l * D * INC, D, INC, (bf16_t*)(wl + WO_IN), 0, 0, scr, r, lane); continue; } r -= I_IN;
        if (r < I_PL) { const int g = r >> 3; p0_transpose_item(p.in[I_POOLW] + (size_t)(l * 4 + g) * 128 * 128, 128, 128, (bf16_t*)(wl + WO_POOL) + (size_t)g * 128 * 128, 0, 0, scr, r & 7, lane); continue; } r -= I_PL;
        if (r < 3 * I_UP) { const int br = r / I_UP; const float* src = p.in[br == 0 ? I_WUP : (br == 1 ? I_WUA : I_WUR)] + (size_t)l * 512 * D;
            p0_transpose_item(src, 512, D, (bf16_t*)(wl + WO_UP), br * D, 0, scr, r - br * I_UP, lane); continue; } r -= 3 * I_UP;
        if (r < I_OUT) { p0_transpose_item(p.in[I_WOUT] + (size_t)l * D * D, D, D, (bf16_t*)(wl + WO_OUT), 0, 0, scr, r, lane); continue; } r -= I_OUT;
        if (r < I_FI) { p0_transpose_item(p.in[I_WFI] + (size_t)l * D * 2 * FF, D, 2 * FF, (bf16_t*)(wl + WO_FFI), 0, 1, scr, r, lane); continue; } r -= I_FI;
        p0_transpose_item(p.in[I_WFO] + (size_t)l * FF * D, FF, D, (bf16_t*)(wl + WO_FFO), 0, 0, scr, r, lane);
    }
}

__device__ __forceinline__ void norm_rows_bf16(const float* x, const float* g, bf16_t* h, int nrows, int gw, int NGW, int lane) {
    for (int row = gw; row < nrows; row += NGW) {
        const f32x4* xr = (const f32x4*)(x + (size_t)row * D) + lane;
        f32x4 v[4]; float ss = 0.f;
#pragma unroll
        for (int j = 0; j < 4; ++j) { v[j] = xr[64 * j]; ss += (v[j][0] * v[j][0] + v[j][1] * v[j][1]) + (v[j][2] * v[j][2] + v[j][3] * v[j][3]); }
        const float rstd = rsqrtf(wave_sum(ss) * (1.0f / D) + EPS);
        u32x2* o = (u32x2*)(h + (size_t)row * D) + lane;
#pragma unroll
        for (int j = 0; j < 4; ++j) { const f32x4 gv = ((const f32x4*)g)[lane + 64 * j]; const f32x4 y = v[j] * rstd * gv; u32x2 w; w.x = pkbf(y[0], y[1]); w.y = pkbf(y[2], y[3]); o[64 * j] = w; }
    }
}
__device__ __forceinline__ void norm_rows_f32_inplace(float* x, const float* g, int nrows, int gw, int NGW, int lane) {
    for (int row = gw; row < nrows; row += NGW) {
        f32x4* xr = (f32x4*)(x + (size_t)row * D) + lane;
        f32x4 v[4]; float ss = 0.f;
#pragma unroll
        for (int j = 0; j < 4; ++j) { v[j] = xr[64 * j]; ss += (v[j][0] * v[j][0] + v[j][1] * v[j][1]) + (v[j][2] * v[j][2] + v[j][3] * v[j][3]); }
        const float rstd = rsqrtf(wave_sum(ss) * (1.0f / D) + EPS);
#pragma unroll
        for (int j = 0; j < 4; ++j) { const f32x4 gv = ((const f32x4*)g)[lane + 64 * j]; xr[64 * j] = v[j] * rstd * gv; }
    }
}
__device__ __forceinline__ void hgrn_combine(const bf16_t* of, const bf16_t* ob, const bf16_t* proj, const float* gain, bf16_t* yrec, int gw, int NGW, int lane) {
    for (int row = gw; row < TH; row += NGW) {
        const u32x4 a = *((const u32x4*)(of + (size_t)row * 512) + lane), b = *((const u32x4*)(ob + (size_t)row * 512) + lane);
        const u32x4 gz = *((const u32x4*)(proj + (size_t)row * INC + C_RG) + lane);
        float o[8]; float ss = 0.f;
#pragma unroll
        for (int e = 0; e < 8; ++e) { o[e] = bfe(a, e) + bfe(b, e); ss += o[e] * o[e]; }
        ss += __shfl_xor(ss, 1); ss += __shfl_xor(ss, 2); ss += __shfl_xor(ss, 4); ss += __shfl_xor(ss, 8);
        const float rstd = rsqrtf(ss * (1.0f / 128.0f) + EPS);
        const f32x4 g0 = *(const f32x4*)(gain + ((8 * lane) & 127)), g1 = *(const f32x4*)(gain + ((8 * lane) & 127) + 4);
        float y[8];
#pragma unroll
        for (int e = 0; e < 8; ++e) { const float z = bfe(gz, e); const float gg = e < 4 ? g0[e] : g1[e - 4]; y[e] = o[e] * rstd * gg * (z * sigm(z)); }
        u32x4 w; w.x = pkbf(y[0], y[1]); w.y = pkbf(y[2], y[3]); w.z = pkbf(y[4], y[5]); w.w = pkbf(y[6], y[7]);
        *((u32x4*)(yrec + (size_t)row * 512) + lane) = w;
    }
}

__device__ __forceinline__ void pool_unit(LAS unsigned char* lds, const bf16_t* proj, const bf16_t* wpool  , const float* pscale  , bf16_t* ypool, int unit, int tid) {
    const int tile = unit >> 2, g = unit & 3, t0 = tile * 128, p0 = t0 & (SEQ - 1), hw = 1 << g;
    LAS bf16_t* U = (LAS bf16_t*)lds; LAS bf16_t* Dt = (LAS bf16_t*)(lds + 39168); LAS bf16_t* Bw = (LAS bf16_t*)(lds + 39168 + 34816);
    for (int idx = tid; idx < 144 * 16; idx += NT) { const int r = idx >> 4, cs = idx & 15; const int pp = p0 - 8 + r;
        u32x4 v = (u32x4){0u, 0u, 0u, 0u};
        if (pp >= 0 && pp < SEQ) v = *(const u32x4*)(proj + (size_t)(t0 - 8 + r) * INC + C_POOL + g * 128 + cs * 8);
        *(LAS u32x4*)(U + r * 136 + cs * 8) = v; }
    for (int idx = tid; idx < 128 * 16; idx += NT) { const int r = idx >> 4, cs = idx & 15;
        *(LAS u32x4*)(Bw + r * 136 + cs * 8) = *(const u32x4*)(wpool + (size_t)g * 128 * 128 + r * 128 + cs * 8); }
    BARRIER();
    for (int idx = tid; idx < 128 * 16; idx += NT) { const int r = idx >> 4, cs = idx & 15; const int pp = p0 + r;
        int lo = pp - hw; if (lo < 0) lo = 0; int hi = pp + hw - 1; if (hi > SEQ - 1) hi = SEQ - 1;
        float s[8];
#pragma unroll
        for (int e = 0; e < 8; ++e) s[e] = 0.f;
        for (int q = lo; q <= hi; ++q) { const u32x4 v = *(const LAS u32x4*)(U + (q - p0 + 8) * 136 + cs * 8);
#pragma unroll
            for (int e = 0; e < 8; ++e) s[e] += bfe(v, e); }
        const float inv = 1.0f / (float)(hi - lo + 1);
        const u32x4 c = *(const LAS u32x4*)(U + (r + 8) * 136 + cs * 8);
        u32x4 w; w.x = pkbf(s[0] * inv - bfe(c, 0), s[1] * inv - bfe(c, 1)); w.y = pkbf(s[2] * inv - bfe(c, 2), s[3] * inv - bfe(c, 3));
        w.z = pkbf(s[4] * inv - bfe(c, 4), s[5] * inv - bfe(c, 5)); w.w = pkbf(s[6] * inv - bfe(c, 6), s[7] * inv - bfe(c, 7));
        *(LAS u32x4*)(Dt + r * 136 + cs * 8) = w; }
    BARRIER();
    const int wave = tid >> 6, lane = tid & 63, lr = lane & 15, lg = lane >> 4;
    f32x4 acc[8];
#pragma unroll
    for (int cb = 0; cb < 8; ++cb) acc[cb] = (f32x4){0.f, 0.f, 0.f, 0.f};
#pragma unroll
    for (int st = 0; st < 4; ++st) { const bf16x8 a = *(const LAS bf16x8*)(Dt + (16 * wave + lr) * 136 + 32 * st + 8 * lg);
#pragma unroll
        for (int cb = 0; cb < 8; ++cb) { const bf16x8 b = *(const LAS bf16x8*)(Bw + (16 * cb + lr) * 136 + 32 * st + 8 * lg);
            acc[cb] = __builtin_amdgcn_mfma_f32_16x16x32_bf16(a, b, acc[cb], 0, 0, 0); } }
#pragma unroll
    for (int cb = 0; cb < 8; ++cb) { const int n = g * 128 + 16 * cb + lr; const float sc = pscale[n];
#pragma unroll
        for (int r = 0; r < 4; ++r) { const int row = t0 + 16 * wave + 4 * lg + r; ypool[(size_t)row * 512 + n] = (bf16_t)(pkbf(acc[cb][r] * sc, 0.f) & 0xffffu); } }
    BARRIER();
}

constexpr int AT_Q = 0, AT_K = 34816, AT_V = AT_K + 2 * 17408, AT_END = AT_V + 2 * 17408;
static_assert(AT_END <= LDS_ITEM_OFF && 128 * 132 * 4 <= 4 * 17408, "attention LDS");
__device__ __forceinline__ void attn_unit(LAS unsigned char* lds, const bf16_t* proj, const float* lq1, const float* lk1, const float* lq2, const float* lk2, const float* dng, int layer, bf16_t* yattn, int unit, int tid) {
    const int b = unit >> 6, h = (unit >> 4) & 3, qb = unit & 15;
    const int wave = tid >> 6, lane = tid & 63, l31 = lane & 31, hi = lane >> 5, rg = wave & 3, c = wave >> 2;
    LAS bf16_t* Qs = (LAS bf16_t*)(lds + AT_Q);
    const size_t tok0 = (size_t)b * SEQ;
    const float lambda_init = 0.8f - 0.6f * __expf(-0.3f * (float)layer);
    float s1 = 0.f, s2 = 0.f;
    for (int i = 0; i < 64; ++i) { s1 += lq1[i] * lk1[i]; s2 += lq2[i] * lk2[i]; }
    const float lam = __expf(s1) - __expf(s2) + lambda_init;
    const float LOG2E = 1.4426950408889634f;
    const float sc2 = 0.125f * LOG2E;
    const float slope2 = exp2f(-2.0f * (float)(h + 1)) * LOG2E;
#pragma unroll
    for (int i = 0; i < 4; ++i) { const int idx = tid + NT * i, r = idx >> 4, cs = idx & 15;
        *(LAS u32x4*)(Qs + r * 136 + cs * 8) = *(const u32x4*)(proj + (tok0 + qb * 128 + r) * INC + C_AQ + h * 128 + cs * 8); }
    const int kr0 = tid >> 4, kcs = tid & 15;
    const int vkp = tid >> 4, vvg = tid & 15;
    u32x4 kreg[2], vreg[2];
    {
        const bf16_t* kb = proj + (tok0 + kr0) * INC + C_AK + h * 128 + kcs * 8;
        kreg[0] = *(const u32x4*)kb; kreg[1] = *(const u32x4*)(kb + (size_t)32 * INC);
        const bf16_t* vb = proj + (tok0 + 2 * vkp) * INC + C_AV + h * 128 + vvg * 8;
        vreg[0] = *(const u32x4*)vb; vreg[1] = *(const u32x4*)(vb + INC);
    }
    f32x16 O[4];
#pragma unroll
    for (int vt = 0; vt < 4; ++vt)
#pragma unroll
        for (int r = 0; r < 16; ++r) O[vt][r] = 0.f;
    float mrun = -1e30f, lrun = 0.f;
    const int qpos = qb * 128 + 32 * rg + l31;
    const LAS bf16_t* qrow = Qs + (32 * rg + l31) * 136 + c * 64 + 8 * hi;
    for (int kt = 0; kt < SEQ / 64; ++kt) {
        const int cur = kt & 1;
        LAS bf16_t* Kc = (LAS bf16_t*)(lds + AT_K + cur * 17408); LAS bf16_t* Vc = (LAS bf16_t*)(lds + AT_V + cur * 17408);
        *(LAS u32x4*)(Kc + kr0 * 136 + kcs * 8) = kreg[0]; *(LAS u32x4*)(Kc + (kr0 + 32) * 136 + kcs * 8) = kreg[1];
#pragma unroll
        for (int e = 0; e < 8; ++e) { const unsigned lo = (e & 1) ? (vreg[0][e >> 1] >> 16) : (vreg[0][e >> 1] & 0xffffu); const unsigned hi16 = (e & 1) ? (vreg[1][e >> 1] & 0xffff0000u) : (vreg[1][e >> 1] << 16);
            *(LAS unsigned*)(Vc + (8 * vvg + e) * 68 + 2 * vkp) = lo | hi16; }
        BARRIER();
        if (kt + 1 < SEQ / 64) {
            const bf16_t* kb = proj + (tok0 + (kt + 1) * 64 + kr0) * INC + C_AK + h * 128 + kcs * 8;
            kreg[0] = *(const u32x4*)kb; kreg[1] = *(const u32x4*)(kb + (size_t)32 * INC);
            const bf16_t* vb = proj + (tok0 + (kt + 1) * 64 + 2 * vkp) * INC + C_AV + h * 128 + vvg * 8;
            vreg[0] = *(const u32x4*)vb; vreg[1] = *(const u32x4*)(vb + INC);
        }
        f32x16 S[2];
#pragma unroll
        for (int ks = 0; ks < 2; ++ks)
#pragma unroll
            for (int r = 0; r < 16; ++r) S[ks][r] = 0.f;
#pragma unroll
        for (int st = 0; st < 4; ++st) {
            const bf16x8 qf = *(const LAS bf16x8*)(qrow + 16 * st);
#pragma unroll
            for (int ks = 0; ks < 2; ++ks) { const bf16x8 kf = *(const LAS bf16x8*)(Kc + (32 * ks + l31) * 136 + c * 64 + 16 * st + 8 * hi);
                S[ks] = __builtin_amdgcn_mfma_f32_32x32x16_bf16(kf, qf, S[ks], 0, 0, 0); }
        }
        float mx = -1e30f;
#pragma unroll
        for (int ks = 0; ks < 2; ++ks) { const float fq = (float)(qpos - (64 * kt + 32 * ks + 4 * hi));
#pragma unroll
            for (int r = 0; r < 16; ++r) { const float dd = fabsf(fq - (float)((r & 3) + 8 * (r >> 2))); const float v = S[ks][r] * sc2 - slope2 * dd; S[ks][r] = v; mx = fmaxf(mx, v); } }
        mx = fmaxf(mx, __shfl_xor(mx, 32));
        const float mnew = fmaxf(mrun, mx); const float alpha = __builtin_amdgcn_exp2f(mrun - mnew);
        float psum = 0.f;
#pragma unroll
        for (int ks = 0; ks < 2; ++ks)
#pragma unroll
            for (int r = 0; r < 16; ++r) { const float pv = __builtin_amdgcn_exp2f(S[ks][r] - mnew); S[ks][r] = pv; psum += pv; }
        mrun = mnew; lrun = lrun * alpha + psum;
        bf16x8 pf[2][2];
#pragma unroll
        for (int ks = 0; ks < 2; ++ks)
#pragma unroll
            for (int s = 0; s < 2; ++s) { u32x4 pw; pw.x = pkbf(S[ks][8 * s + 0], S[ks][8 * s + 1]); pw.y = pkbf(S[ks][8 * s + 2], S[ks][8 * s + 3]);
                pw.z = pkbf(S[ks][8 * s + 4], S[ks][8 * s + 5]); pw.w = pkbf(S[ks][8 * s + 6], S[ks][8 * s + 7]); pf[ks][s] = __builtin_bit_cast(bf16x8, pw); }
#pragma unroll
        for (int vt = 0; vt < 4; ++vt) {
            f32x16 o = O[vt] * alpha;
#pragma unroll
            for (int ks = 0; ks < 2; ++ks)
#pragma unroll
                for (int s = 0; s < 2; ++s) {
                    const LAS bf16_t* vp = Vc + (32 * vt + l31) * 68 + 32 * ks + 16 * s + 4 * hi;
                    const u32x2 a = *(const LAS u32x2*)vp, bq = *(const LAS u32x2*)(vp + 8);
                    const u32x4 w = (u32x4){a.x, a.y, bq.x, bq.y};
                    o = __builtin_amdgcn_mfma_f32_32x32x16_bf16(__builtin_bit_cast(bf16x8, w), pf[ks][s], o, 0, 0, 0);
                }
            O[vt] = o;
        }
    }
    const float ltot = lrun + __shfl_xor(lrun, 32);
    LAS float* X = (LAS float*)(lds + AT_K);
    BARRIER();
    if (c == 1) { const float sc = lam / ltot;
#pragma unroll
        for (int vt = 0; vt < 4; ++vt)
#pragma unroll
            for (int rq = 0; rq < 4; ++rq) { const f32x4 w = (f32x4){O[vt][4 * rq + 0] * sc, O[vt][4 * rq + 1] * sc, O[vt][4 * rq + 2] * sc, O[vt][4 * rq + 3] * sc};
                *(LAS f32x4*)(X + (32 * rg + l31) * 132 + 32 * vt + 8 * rq + 4 * hi) = w; } }
    BARRIER();
    if (c == 0) { const float i0 = 1.0f / ltot; float ss = 0.f;
#pragma unroll
        for (int vt = 0; vt < 4; ++vt)
#pragma unroll
            for (int rq = 0; rq < 4; ++rq) { const f32x4 x = *(const LAS f32x4*)(X + (32 * rg + l31) * 132 + 32 * vt + 8 * rq + 4 * hi);
#pragma unroll
                for (int e = 0; e < 4; ++e) { const float o = O[vt][4 * rq + e] * i0 - x[e]; O[vt][4 * rq + e] = o; ss += o * o; } }
        ss += __shfl_xor(ss, 32);
        const float rs = rsqrtf(ss * (1.0f / 128.0f) + EPS) * (1.0f - lambda_init);
#pragma unroll
        for (int vt = 0; vt < 4; ++vt)
#pragma unroll
            for (int rq = 0; rq < 4; ++rq) { const int v0 = 32 * vt + 8 * rq + 4 * hi; const f32x4 gv = *(const f32x4*)(dng + v0);
                u32x2 w; w.x = pkbf(O[vt][4 * rq + 0] * rs * gv[0], O[vt][4 * rq + 1] * rs * gv[1]); w.y = pkbf(O[vt][4 * rq + 2] * rs * gv[2], O[vt][4 * rq + 3] * rs * gv[3]);
                *(LAS u32x2*)(Qs + (32 * rg + l31) * 136 + v0) = w; } }
    BARRIER();
#pragma unroll
    for (int i = 0; i < 4; ++i) { const int idx = tid + NT * i, r = idx >> 4, cs = idx & 15;
        *(u32x4*)(yattn + (tok0 + qb * 128 + r) * 512 + h * 128 + cs * 8) = *(const LAS u32x4*)(Qs + r * 136 + cs * 8); }
    BARRIER();
}

constexpr int HG_Q = 0, HG_K = 17408, HG_C = HG_K + 33792, HG_B = HG_C + 33792, HG_V = HG_B + 6144, HG_S = HG_V + 18432, HG_SC = HG_S + 34816, HG_END = HG_SC + 9216;
static_assert(HG_END <= LDS_ITEM_OFF, "hgrn LDS");
__device__ __forceinline__ void hgrn_unit(LAS unsigned char* lds, const bf16_t* proj, const float* hlb  , int layer, bf16_t* o2  , int unit, int tid) {
    const int b = unit >> 3, h = (unit >> 1) & 3, dir = unit & 1;
    const int wave = tid >> 6, lane = tid & 63, lr = lane & 15, lg = lane >> 4;
    LAS bf16_t* Qs = (LAS bf16_t*)(lds + HG_Q); LAS float* Ks = (LAS float*)(lds + HG_K); LAS float* Cs = (LAS float*)(lds + HG_C); LAS float* Bs = (LAS float*)(lds + HG_B);
    LAS bf16_t* Vt = (LAS bf16_t*)(lds + HG_V); LAS bf16_t* St = (LAS bf16_t*)(lds + HG_S); LAS bf16_t* Sc = (LAS bf16_t*)(lds + HG_SC);
    const size_t tok0 = (size_t)b * SEQ;
    const float scale_q = 0.08838834764831845f;
    if (tid < 128) { const float* a = hlb + (size_t)dir * DEPTH * 512 + h * 128 + tid;
        const float a0 = a[0], a1 = a[512], a2 = a[1024], a3 = a[1536]; const float mx = fmaxf(fmaxf(a0, a1), fmaxf(a2, a3));
        const float e0 = __expf(a0 - mx), e1 = __expf(a1 - mx), e2 = __expf(a2 - mx), e3 = __expf(a3 - mx); const float inv = 1.0f / (e0 + e1 + e2 + e3);
        float lb = 0.f; if (layer >= 1) lb += e1 * inv; if (layer >= 2) lb += e2 * inv; if (layer >= 3) lb += e3 * inv;
        Bs[11 * 128 + tid] = lb; }
    for (int idx = tid; idx < 128 * 136 / 2; idx += NT) ((LAS unsigned*)St)[idx] = 0u;
    f32x4 st[8];
#pragma unroll
    for (int vb = 0; vb < 8; ++vb) st[vb] = (f32x4){0.f, 0.f, 0.f, 0.f};
    const int fcol = (dir == 0 ? C_RF : C_RB) + h * 128;
    const int r0 = tid >> 4, cs = tid & 15;
    u32x4 qreg[2], zreg[2], vreg[2];
#define tok_of(ci_, r_) (tok0 + (size_t)(dir == 0 ? ((ci_) * 64 + (r_)) : (SEQ - 1 - ((ci_) * 64 + (r_)))))
#pragma unroll
    for (int i = 0; i < 2; ++i) { const bf16_t* rp = proj + tok_of(0, r0 + 32 * i) * INC + cs * 8;
        qreg[i] = *(const u32x4*)(rp + C_RQ + h * 128); zreg[i] = *(const u32x4*)(rp + fcol); vreg[i] = *(const u32x4*)(rp + C_RI + h * 128); }
    BARRIER();
    for (int ci = 0; ci < SEQ / 64; ++ci) {
        const f32x4 lb0 = *(const LAS f32x4*)(Bs + 11 * 128 + cs * 8), lb1 = *(const LAS f32x4*)(Bs + 11 * 128 + cs * 8 + 4);
#pragma unroll
        for (int i = 0; i < 2; ++i) { const int r = r0 + 32 * i;
            *(LAS u32x4*)(Qs + r * 136 + cs * 8) = qreg[i];
            f32x4 k0v, k1v, c0v, c1v;
#pragma unroll
            for (int e = 0; e < 8; ++e) { const float z = fminf(fmaxf(bfe(zreg[i], e), -30.0f), 30.0f); const float lb = e < 4 ? lb0[e] : lb1[e - 4];
                const float ez = __expf(-z); const float sg = __builtin_amdgcn_rcpf(1.0f + ez); const float f = lb + (1.0f - lb) * sg;
                const float kk = (1.0f - lb) * (ez * sg);
                const float lf = __logf(fmaxf(f, 1e-37f));
                if (e < 4) { k0v[e] = kk; c0v[e] = lf; } else { k1v[e - 4] = kk; c1v[e - 4] = lf; } }
            *(LAS f32x4*)(Ks + r * 132 + cs * 8) = k0v; *(LAS f32x4*)(Ks + r * 132 + cs * 8 + 4) = k1v;
            *(LAS f32x4*)(Cs + r * 132 + cs * 8) = c0v; *(LAS f32x4*)(Cs + r * 132 + cs * 8 + 4) = c1v;
#pragma unroll
            for (int e = 0; e < 8; ++e) { const unsigned x = vreg[i][e >> 1]; Vt[(cs * 8 + e) * 72 + r] = (bf16_t)((e & 1) ? (x >> 16) : (x & 0xffffu)); } }
        BARRIER();
        if (ci + 1 < SEQ / 64) {
#pragma unroll
            for (int i = 0; i < 2; ++i) { const bf16_t* rp = proj + tok_of(ci + 1, r0 + 32 * i) * INC + cs * 8;
                qreg[i] = *(const u32x4*)(rp + C_RQ + h * 128); zreg[i] = *(const u32x4*)(rp + fcol); vreg[i] = *(const u32x4*)(rp + C_RI + h * 128); } }
        { const int i = tid >> 7, k = tid & 127; float c = 0.f;
#pragma unroll
            for (int r = 0; r < 16; ++r) { c += Cs[(16 * i + r) * 132 + k]; Cs[(16 * i + r) * 132 + k] = c; }
            Bs[(5 + i) * 128 + k] = c; }
        BARRIER();
        if (tid < 128) { const float t0 = Bs[5 * 128 + tid], t1 = Bs[6 * 128 + tid], t2 = Bs[7 * 128 + tid], t3 = Bs[8 * 128 + tid];
            Bs[tid] = 0.f; Bs[128 + tid] = t0; Bs[256 + tid] = t0 + t1; Bs[384 + tid] = t0 + t1 + t2; Bs[512 + tid] = t0 + t1 + t2 + t3; }
        BARRIER();
#pragma unroll
        for (int bb = 0; bb < 2; ++bb) { const int id = 2 * wave + bb, bi = id >> 2, bj = id & 3;
            f32x4 acc = (f32x4){0.f, 0.f, 0.f, 0.f};
            if (bj <= bi) {
#pragma unroll
                for (int stp = 0; stp < 4; ++stp) { const int k0 = 32 * stp + 8 * lg; const int t = 16 * bi + lr, s = 16 * bj + lr;
                    const u32x4 qv = *(const LAS u32x4*)(Qs + t * 136 + k0);
                    float av[8], bv[8];
#pragma unroll
                    for (int e = 0; e < 8; ++e) { av[e] = bfe(qv, e) * scale_q * __expf(Cs[t * 132 + k0 + e]);
                        const float ex = fminf(Bs[bi * 128 + k0 + e] - Bs[bj * 128 + k0 + e] - Cs[s * 132 + k0 + e], 80.0f); bv[e] = Ks[s * 132 + k0 + e] * __expf(ex); }
                    u32x4 aw, bw; aw.x = pkbf(av[0], av[1]); aw.y = pkbf(av[2], av[3]); aw.z = pkbf(av[4], av[5]); aw.w = pkbf(av[6], av[7]);
                    bw.x = pkbf(bv[0], bv[1]); bw.y = pkbf(bv[2], bv[3]); bw.z = pkbf(bv[4], bv[5]); bw.w = pkbf(bv[6], bv[7]);
                    acc = __builtin_amdgcn_mfma_f32_16x16x32_bf16(__builtin_bit_cast(bf16x8, aw), __builtin_bit_cast(bf16x8, bw), acc, 0, 0, 0); }
            }
#pragma unroll
            for (int r = 0; r < 4; ++r) { float v = acc[r]; if (bi == bj && lr > 4 * lg + r) v = 0.f; Sc[(16 * bi + 4 * lg + r) * 72 + 16 * bj + lr] = (bf16_t)(pkbf(v, 0.f) & 0xffffu); } }
        BARRIER();
        { const int tb = wave & 3, vh = wave >> 2;
            f32x4 oa[4];
#pragma unroll
            for (int vb = 0; vb < 4; ++vb) oa[vb] = (f32x4){0.f, 0.f, 0.f, 0.f};
#pragma unroll
            for (int stp = 0; stp < 2; ++stp) { const bf16x8 a = *(const LAS bf16x8*)(Sc + (16 * tb + lr) * 72 + 32 * stp + 8 * lg);
#pragma unroll
                for (int vb = 0; vb < 4; ++vb) { const bf16x8 bq = *(const LAS bf16x8*)(Vt + (64 * vh + 16 * vb + lr) * 72 + 32 * stp + 8 * lg);
                    oa[vb] = __builtin_amdgcn_mfma_f32_16x16x32_bf16(a, bq, oa[vb], 0, 0, 0); } }
#pragma unroll
            for (int stp = 0; stp < 4; ++stp) { const int k0 = 32 * stp + 8 * lg, t = 16 * tb + lr;
                const u32x4 qv = *(const LAS u32x4*)(Qs + t * 136 + k0);
                float av[8];
#pragma unroll
                for (int e = 0; e < 8; ++e) av[e] = bfe(qv, e) * scale_q * __expf(Cs[t * 132 + k0 + e] + Bs[tb * 128 + k0 + e]);
                u32x4 aw; aw.x = pkbf(av[0], av[1]); aw.y = pkbf(av[2], av[3]); aw.z = pkbf(av[4], av[5]); aw.w = pkbf(av[6], av[7]);
                const bf16x8 a = __builtin_bit_cast(bf16x8, aw);
#pragma unroll
                for (int vb = 0; vb < 4; ++vb) { const bf16x8 bq = *(const LAS bf16x8*)(St + (64 * vh + 16 * vb + lr) * 136 + k0);
                    oa[vb] = __builtin_amdgcn_mfma_f32_16x16x32_bf16(a, bq, oa[vb], 0, 0, 0); } }
            bf16_t* ob = o2 + (size_t)dir * TH * 512;
#pragma unroll
            for (int r = 0; r < 4; ++r) { const size_t tk = tok_of(ci, 16 * tb + 4 * lg + r);
#pragma unroll
                for (int vb = 0; vb < 4; ++vb) ob[tk * 512 + h * 128 + 64 * vh + 16 * vb + lr] = (bf16_t)(pkbf(oa[vb][r], 0.f) & 0xffffu); } }
        BARRIER();
        { const int kb = 16 * wave;
#pragma unroll
            for (int r = 0; r < 4; ++r) { const float dec = __expf(Bs[512 + kb + 4 * lg + r]);
#pragma unroll
                for (int vb = 0; vb < 8; ++vb) st[vb][r] *= dec; }
#pragma unroll
            for (int stp = 0; stp < 2; ++stp) { const int k = kb + lr; const int jsub = 2 * stp + (lg >> 1); const float bl = Bs[512 + k] - Bs[jsub * 128 + k];
                float av[8];
#pragma unroll
                for (int e = 0; e < 8; ++e) { const int s = 32 * stp + 8 * lg + e; av[e] = Ks[s * 132 + k] * __expf(bl - Cs[s * 132 + k]); }
                u32x4 aw; aw.x = pkbf(av[0], av[1]); aw.y = pkbf(av[2], av[3]); aw.z = pkbf(av[4], av[5]); aw.w = pkbf(av[6], av[7]);
                const bf16x8 a = __builtin_bit_cast(bf16x8, aw);
#pragma unroll
                for (int vb = 0; vb < 8; ++vb) { const bf16x8 bq = *(const LAS bf16x8*)(Vt + (16 * vb + lr) * 72 + 32 * stp + 8 * lg);
                    st[vb] = __builtin_amdgcn_mfma_f32_16x16x32_bf16(a, bq, st[vb], 0, 0, 0); } }
#pragma unroll
            for (int vb = 0; vb < 8; ++vb) { u32x2 w; w.x = pkbf(st[vb][0], st[vb][1]); w.y = pkbf(st[vb][2], st[vb][3]); *(LAS u32x2*)(St + (16 * vb + lr) * 136 + kb + 4 * lg) = w; } }
        BARRIER();
    }
#undef tok_of
}

constexpr int N_SCAN = HB * 4 * 2;
constexpr int N_ATT = HB * 4 * (SEQ / 128);
constexpr int N_POOLU = (TH / 128) * 4;

__global__ void __launch_bounds__(NT, 2) mega_fwd(Params p) {
    extern __shared__ __attribute__((aligned(16))) unsigned char smem[];
    cg::grid_group grid = cg::this_grid();
    LAS unsigned char* lds = (LAS unsigned char*)smem;
    const int G = gridDim.x, bid = blockIdx.x, NGW = G * NW;
#define GRID_SYNC() do { asm volatile("s_waitcnt vmcnt(0) lgkmcnt(0)" ::: "memory"); grid.sync(); __builtin_amdgcn_fence(__ATOMIC_ACQUIRE, "agent"); asm volatile("s_waitcnt vmcnt(0)" ::: "memory"); } while (0)
#define OPAQUE_TID() int tid = threadIdx.x; asm volatile("" : "+v"(tid)); const int lane = tid & 63, wave = __builtin_amdgcn_readfirstlane(tid >> 6), gw = bid * NW + wave; (void)lane; (void)gw
    unsigned char* ws = p.ws;
    unsigned* ctl = (unsigned*)(ws + WS_CTL);
    bf16_t* proj = (bf16_t*)(ws + WS_PROJ); bf16_t* hbuf = (bf16_t*)(ws + WS_H); bf16_t* ycat = (bf16_t*)(ws + WS_Y); bf16_t* o2 = (bf16_t*)(ws + WS_O2);
    bf16_t* act = proj;

    { OPAQUE_TID(); p0_prologue(p, lds, gw, NGW, wave, lane); }
    GRID_SYNC();

    for (int half = 0; half < NHALF; ++half) {
        const float* xin = p.in[I_X] + (size_t)half * TH * D;
        float* xres = p.out + (size_t)half * TH * D;
        for (int l = 0; l < DEPTH; ++l) {
            unsigned char* wl = ws + WS_W + (size_t)l * W_LAYER;
            const float* xcur = (l == 0) ? xin : xres;
            { OPAQUE_TID(); norm_rows_bf16(xcur, p.in[I_N1G] + l * D, hbuf, TH, gw, NGW, lane); }
            GRID_SYNC();
            { pg8::Gemm g{hbuf, (const bf16_t*)(wl + WO_IN), TH, INC, D}; pg8::StaticOrder S; S.init(TH, INC, G, bid);
              pg8::EpiStore E{proj, INC};
              pg8::gemm_phase<pg8::EpiStore, pg8::StaticOrder, true, true>(lds, g, S, E); }
            GRID_SYNC();
            {
                OPAQUE_TID();
                for (int u = bid; u < N_SCAN; u += G) hgrn_unit(lds, proj, p.in[I_HLB], l, o2, u, tid);
                unsigned* ctr = ctl + 64 * (1 + half * DEPTH + l);
                LAS unsigned* item_w = (LAS unsigned*)(lds + LDS_ITEM_OFF);
                for (;;) {
                    if (tid == 0) *item_w = atomicAdd(ctr, 1u);
                    BARRIER();
                    const int item = (int)*item_w;
                    BARRIER();
                    if (item >= N_ATT + N_POOLU) break;
                    asm volatile("" : "+v"(tid));
                    if (item < N_ATT) attn_unit(lds, proj, p.in[I_LQ1] + l * 64, p.in[I_LK1] + l * 64, p.in[I_LQ2] + l * 64, p.in[I_LK2] + l * 64, p.in[I_DNG] + l * 128, l, ycat + (size_t)TH * 512, item, tid);
                    else pool_unit(lds, proj, (const bf16_t*)(wl + WO_POOL), p.in[I_POOLS] + l * 512, ycat, item - N_ATT, tid);
                }
            }
            GRID_SYNC();
            { OPAQUE_TID(); hgrn_combine(o2, o2 + (size_t)TH * 512, proj, p.in[I_HNG] + l * 128, ycat + (size_t)2 * TH * 512, gw, NGW, lane); }
            GRID_SYNC();
            { pg8::Gemm g{ycat, (const bf16_t*)(wl + WO_UP), 3 * TH, 3 * D, 512}; pg8::MergeOrder S; S.init(TH, G, bid);
              pg8::EpiMerge E{proj, INC, C_GATE, hbuf, TH / 256};
              pg8::gemm_phase<pg8::EpiMerge, pg8::MergeOrder, true, true>(lds, g, S, E); }
            GRID_SYNC();
            { pg8::Gemm g{hbuf, (const bf16_t*)(wl + WO_OUT), TH, D, D}; pg8::StaticOrder S; S.init(TH, D, G, bid);
              pg8::EpiResid E{xcur, xres, D};
              pg8::gemm_phase<pg8::EpiResid, pg8::StaticOrder, true, true>(lds, g, S, E); }
            GRID_SYNC();
            { OPAQUE_TID(); norm_rows_bf16(xres, p.in[I_N2G] + l * D, hbuf, TH, gw, NGW, lane); }
            GRID_SYNC();
            { pg8::Gemm g{hbuf, (const bf16_t*)(wl + WO_FFI), TH, 2 * FF, D}; pg8::StaticOrder S; S.init(TH, 2 * FF, G, bid);
              pg8::EpiSwiGLU E{act, FF};
              pg8::gemm_phase<pg8::EpiSwiGLU, pg8::StaticOrder, true, true>(lds, g, S, E); }
            GRID_SYNC();
            { pg8::Gemm g{act, (const bf16_t*)(wl + WO_FFO), TH, D, FF}; pg8::StaticOrder S; S.init(TH, D, G, bid);
              pg8::EpiResid E{xres, xres, D};
              pg8::gemm_phase<pg8::EpiResid, pg8::StaticOrder, true, true>(lds, g, S, E); }
            GRID_SYNC();
        }
    }
    { OPAQUE_TID(); norm_rows_f32_inplace(p.out, p.in[I_FNG], NHALF * TH, gw, NGW, lane); }
}

extern "C" void kernel_launch(void* const* d_in, const int* in_sizes, int n_in, void* d_out, int out_size, void* d_ws, size_t ws_size, hipStream_t stream) {
    static int grid = 0;
    if (grid == 0) {
        if (n_in != 20 || in_sizes[0] != NHALF * TH * D || out_size != NHALF * TH * D || ws_size < WS_END) {
            fprintf(stderr, "kernel_launch: unexpected shapes (n_in %d, in0 %d, out %d, ws %zu); nothing launched\n", n_in, n_in > 0 ? in_sizes[0] : -1, out_size, ws_size); grid = -1; return; }
        int dev = 0, cus = 0, per_cu = 0;
        if (hipGetDevice(&dev) != hipSuccess || hipDeviceGetAttribute(&cus, hipDeviceAttributeMultiprocessorCount, dev) != hipSuccess) { grid = -1; return; }
        if (hipFuncSetAttribute((const void*)mega_fwd, hipFuncAttributeMaxDynamicSharedMemorySize, LDS_BYTES) != hipSuccess) { fprintf(stderr, "kernel_launch: hipFuncSetAttribute failed\n"); grid = -1; return; }
        if (hipOccupancyMaxActiveBlocksPerMultiprocessor(&per_cu, (const void*)mega_fwd, NT, LDS_BYTES) != hipSuccess || per_cu < 1) { fprintf(stderr, "kernel_launch: occupancy query says %d\n", per_cu); per_cu = 1; }
        (void)hipGetLastError();
        grid = cus * 1;
    }
    if (grid < 0) return;
    (void)hipMemsetAsync((char*)d_ws + WS_CTL, 0, CTL_BYTES, stream);
    Params prm{};
    for (int i = 0; i < 20; ++i) prm.in[i] = (const float*)d_in[i];
    prm.out = (float*)d_out; prm.ws = (unsigned char*)d_ws;
    void* args[] = {&prm};
    hipError_t e = hipLaunchCooperativeKernel((const void*)mega_fwd, dim3(grid), dim3(NT), args, LDS_BYTES, stream);
    if (e != hipSuccess) fprintf(stderr, "cooperative launch failed: %s (grid %d)\n", hipGetErrorString(e), grid);
}
```

```cpp
#include <hip/hip_runtime.h>
#include <hip/hip_cooperative_groups.h>
#include <cstdio>
#include <cstdint>
namespace cg = cooperative_groups;
namespace pg8 {
#define PG8_LAS __attribute__((address_space(3)))
typedef unsigned short bf16_t;
typedef short bf16x8 __attribute__((ext_vector_type(8)));
typedef float f32x4 __attribute__((ext_vector_type(4)));
typedef unsigned u32x4 __attribute__((ext_vector_type(4)));
constexpr int BM = 256, BK = 64, HALF = 128, HTB = HALF * BK * 2  , STAGE_BYTES = 8 * HTB, NXCD = 8, WGM = 8;

__host__ __device__ __forceinline__ int lds_byte(int r, int c) { const int st = (r >> 4) * 2 + (c >> 5), rr = r & 15, cc = c & 31, ob = rr * 64 + cc * 2; return st * 1024 + (ob ^ (((ob >> 9) & 1) << 5)); }
__host__ __device__ __forceinline__ void stage_rc(int b, int& R, int& C) { const int st = b / 1024, sb = b % 1024, swz = sb ^ (((sb >> 9) & 1) << 5); R = (st >> 1) * 16 + swz / 64; C = (st & 1) * 32 + (swz % 64) / 2; }
__host__ __device__ __forceinline__ int perm32(int rho) { const int n = rho >> 4, i = rho & 15; return 8 * (i >> 2) + 4 * n + (i & 3); }

struct Unit { int pm, pn; };
struct Gemm { const bf16_t* A; const bf16_t* Bt; int M, N, K; };

struct StaticOrder {
    int nM, nN, nwg, G, c;
    __host__ __device__ void init(int M, int N, int G_, int c_) { nM = M / BM; nN = N / BM; nwg = nM * nN; G = G_; c = c_; }
    __host__ __device__ bool next(int i, Unit& u) const {
        const long L = (long)i * G + c; if (L >= nwg) return false;
        int wgid = (int)L; { const int q = nwg / NXCD, r = nwg % NXCD, xcd = wgid % NXCD, off = wgid / NXCD; wgid = (xcd < r ? xcd * (q + 1) : r * (q + 1) + (xcd - r) * q) + off; }
        const int nig = WGM * nN, gid = wgid / nig, fm = gid * WGM, gsz = (nM - fm) < WGM ? (nM - fm) : WGM;
        u.pm = fm + ((wgid % nig) % gsz); u.pn = (wgid % nig) / gsz; return true;
    }
    __device__ __forceinline__ void a_ready(const Unit&) const {}
    __device__ __forceinline__ void done(const Unit&) const {}
};

typedef float f32x2c_ __attribute__((ext_vector_type(2)));
typedef __bf16 bf16x2c_ __attribute__((ext_vector_type(2)));
__device__ __forceinline__ unsigned cvt_pk_bf16(float lo, float hi) { const f32x2c_ v = {lo, hi}; const bf16x2c_ b = __builtin_convertvector(v, bf16x2c_); return __builtin_bit_cast(unsigned, b); }
typedef float f32x2 __attribute__((ext_vector_type(2)));
__device__ __forceinline__ float fast_sigmoid(float x) { return __builtin_amdgcn_rcpf(1.0f + __expf(-x)); }
typedef unsigned u32x2v __attribute__((ext_vector_type(2)));
struct EpiStore {
    static constexpr bool PERM = true, AFTER_DRAIN = false, KEEP = false;
    bf16_t* O; int ldc; bf16_t* G; int nrm;
    __device__ __forceinline__ void operator()(const f32x4 (&acc)[2][2][4][2], const Unit& u, int wr, int wc, int fr, int fq) const {
        const int row0 = u.pm * BM + wr * 64 + fr; const int col0 = u.pn * BM + wc * 32 + 8 * fq;
        const bool dump = u.pn >= nrm;
        bf16_t* gt = G + ((size_t)(u.pm * 12 + (u.pn - nrm)) << 16) + (wr * 4 + wc) * 512 + (fq * 16 + fr) * 8;
#pragma unroll
        for (int ai = 0; ai < 2; ++ai)
#pragma unroll
            for (int m = 0; m < 4; ++m) { bf16_t* rowp = O + (size_t)(row0 + ai * HALF + m * 16) * ldc + col0;
#pragma unroll
                for (int bj = 0; bj < 2; ++bj) { const f32x4 v0 = acc[ai][bj][m][0], v1 = acc[ai][bj][m][1];
                    u32x4 w; w.x = cvt_pk_bf16(v0[0], v0[1]); w.y = cvt_pk_bf16(v0[2], v0[3]); w.z = cvt_pk_bf16(v1[0], v1[1]); w.w = cvt_pk_bf16(v1[2], v1[3]);
                    if (dump) *(u32x4*)(gt + ((ai * 4 + m) * 2 + bj) * 4096) = w; else *(u32x4*)(rowp + bj * HALF) = w; } }
    }
};
struct EpiMerge {
    static constexpr bool PERM = true, AFTER_DRAIN = false, KEEP = false;
    bf16_t* proj; int ldp; int gate_col0; bf16_t* merged; int MT;
    __device__ __forceinline__ void operator()(const f32x4 (&acc)[2][2][4][2], const Unit& u, int wr, int wc, int fr, int fq) const {
        const int br = u.pm / MT, pmt = u.pm - br * MT, pnt = u.pn & 3;
        const int row0 = pmt * BM + wr * 64 + fr; const int col0 = pnt * BM + wc * 32 + 8 * fq;
#pragma unroll
        for (int ai = 0; ai < 2; ++ai)
#pragma unroll
            for (int mp = 0; mp < 2; ++mp) {
                u32x4 gw[2][2]; f32x4 p0[2][2], p1[2][2];
#pragma unroll
                for (int mm = 0; mm < 2; ++mm)
#pragma unroll
                    for (int bj = 0; bj < 2; ++bj) { const size_t row = (size_t)(row0 + ai * HALF + (2 * mp + mm) * 16); bf16_t* prow = proj + row * ldp; const int col = col0 + bj * HALF;
                        gw[mm][bj] = *(const u32x4*)(prow + gate_col0 + br * 1024 + col);
                        if (br > 0) { const float* part = (const float*)prow + col; p0[mm][bj] = *(const f32x4*)part; p1[mm][bj] = *(const f32x4*)(part + 4); }
                        else { p0[mm][bj] = (f32x4){0.f, 0.f, 0.f, 0.f}; p1[mm][bj] = (f32x4){0.f, 0.f, 0.f, 0.f}; } }
#pragma unroll
                for (int mm = 0; mm < 2; ++mm)
#pragma unroll
                    for (int bj = 0; bj < 2; ++bj) { const int m = 2 * mp + mm; const size_t row = (size_t)(row0 + ai * HALF + m * 16); bf16_t* prow = proj + row * ldp; const int col = col0 + bj * HALF;
                        const u32x4 g = gw[mm][bj]; f32x4 g0, g1;
                        g0[0] = fast_sigmoid(__uint_as_float(g.x << 16)); g0[1] = fast_sigmoid(__uint_as_float(g.x & 0xffff0000u));
                        g0[2] = fast_sigmoid(__uint_as_float(g.y << 16)); g0[3] = fast_sigmoid(__uint_as_float(g.y & 0xffff0000u));
                        g1[0] = fast_sigmoid(__uint_as_float(g.z << 16)); g1[1] = fast_sigmoid(__uint_as_float(g.z & 0xffff0000u));
                        g1[2] = fast_sigmoid(__uint_as_float(g.w << 16)); g1[3] = fast_sigmoid(__uint_as_float(g.w & 0xffff0000u));
                        const f32x4 v0 = g0 * acc[ai][bj][m][0] + p0[mm][bj], v1 = g1 * acc[ai][bj][m][1] + p1[mm][bj];
                        if (br < 2) { float* part = (float*)prow + col; *(f32x4*)part = v0; *(f32x4*)(part + 4) = v1; }
                        else { u32x4 w; w.x = cvt_pk_bf16(v0[0], v0[1]); w.y = cvt_pk_bf16(v0[2], v0[3]); w.z = cvt_pk_bf16(v1[0], v1[1]); w.w = cvt_pk_bf16(v1[2], v1[3]);
                            *(u32x4*)(merged + row * 1024 + col) = w; } }
            }
    }
};
struct EpiMerge2 {
    static constexpr bool PERM = true, AFTER_DRAIN = false, KEEP = true;
    const bf16_t* G; bf16_t* merged; int MT;
    static __device__ __forceinline__ float epos(unsigned bits) { return 1.0f + __expf(-fminf(fmaxf(__uint_as_float(bits), -30.0f), 30.0f)); }
    __device__ __forceinline__ bool apply(f32x4 (&acc)[2][2][4][2], const Unit& u, int wr, int wc, int fr, int fq) const {
        const int br = u.pm / MT, pmt = u.pm - br * MT, pnt = u.pn & 3;
        const int row0 = pmt * BM + wr * 64 + fr; const int col0 = pnt * BM + wc * 32 + 8 * fq;
        const bf16_t* gt = G + ((size_t)(pmt * 12 + br * 4 + pnt) << 16) + (wr * 4 + wc) * 512 + (fq * 16 + fr) * 8;
#pragma unroll
        for (int ai = 0; ai < 2; ++ai)
#pragma unroll
            for (int m = 0; m < 4; ++m) { const size_t row = (size_t)(row0 + ai * HALF + m * 16);
#pragma unroll
                for (int bj = 0; bj < 2; ++bj) { const int col = col0 + bj * HALF; const bf16_t* gp = gt + ((ai * 4 + m) * 2 + bj) * 4096;
                    const u32x4 ga = *(const u32x4*)gp;
                    float f[8];
                    if (br < 2) { const u32x4 gb = *(const u32x4*)(gp + (4 << 16));
#pragma unroll
                        for (int e = 0; e < 4; ++e) { f[2 * e] = epos(gb[e] << 16) * __builtin_amdgcn_rcpf(epos(ga[e] << 16)); f[2 * e + 1] = epos(gb[e] & 0xffff0000u) * __builtin_amdgcn_rcpf(epos(ga[e] & 0xffff0000u)); }
                    } else {
#pragma unroll
                        for (int e = 0; e < 4; ++e) { f[2 * e] = __builtin_amdgcn_rcpf(epos(ga[e] << 16)); f[2 * e + 1] = __builtin_amdgcn_rcpf(epos(ga[e] & 0xffff0000u)); }
                    }
                    f32x4 v0 = acc[ai][bj][m][0], v1 = acc[ai][bj][m][1];
                    v0[0] *= f[0]; v0[1] *= f[1]; v0[2] *= f[2]; v0[3] *= f[3]; v1[0] *= f[4]; v1[1] *= f[5]; v1[2] *= f[6]; v1[3] *= f[7];
                    if (br < 2) { acc[ai][bj][m][0] = v0; acc[ai][bj][m][1] = v1; }
                    else { u32x4 w; w.x = cvt_pk_bf16(v0[0], v0[1]); w.y = cvt_pk_bf16(v0[2], v0[3]); w.z = cvt_pk_bf16(v1[0], v1[1]); w.w = cvt_pk_bf16(v1[2], v1[3]);
                        *(u32x4*)(merged + row * 1024 + col) = w; } } }
        return br < 2;
    }
};
struct EpiResid {
    static constexpr bool PERM = false, AFTER_DRAIN = false, KEEP = false;
    const float* base; float* out; int ldc;
    __device__ __forceinline__ void operator()(const f32x4 (&acc)[2][2][4][2], const Unit& u, int wr, int wc, int fr, int fq) const {
        const int row0 = u.pm * BM + wr * 64 + fr; const int col0 = u.pn * BM + wc * 32 + 4 * fq;
#pragma unroll
        for (int ai = 0; ai < 2; ++ai) {
            f32x4 bs[4][2][2];
#pragma unroll
            for (int m = 0; m < 4; ++m) { const size_t off = (size_t)(row0 + ai * HALF + m * 16) * ldc + col0;
#pragma unroll
                for (int bj = 0; bj < 2; ++bj)
#pragma unroll
                    for (int n = 0; n < 2; ++n) bs[m][bj][n] = *(const f32x4*)(base + off + bj * HALF + n * 16); }
#pragma unroll
            for (int m = 0; m < 4; ++m) { const size_t off = (size_t)(row0 + ai * HALF + m * 16) * ldc + col0;
#pragma unroll
                for (int bj = 0; bj < 2; ++bj)
#pragma unroll
                    for (int n = 0; n < 2; ++n) *(f32x4*)(out + off + bj * HALF + n * 16) = bs[m][bj][n] + acc[ai][bj][m][n]; }
        }
    }
};
struct EpiSwiGLU {
    static constexpr bool PERM = true, AFTER_DRAIN = false, KEEP = false;
    bf16_t* O; int ldc;
    __device__ __forceinline__ void operator()(const f32x4 (&acc)[2][2][4][2], const Unit& u, int wr, int wc, int fr, int fq) const {
        const int row0 = u.pm * BM + wr * 64 + fr; const int col0 = u.pn * HALF + wc * 32 + 8 * fq;
#pragma unroll
        for (int ai = 0; ai < 2; ++ai)
#pragma unroll
            for (int m = 0; m < 4; ++m) { bf16_t* rowp = O + (size_t)(row0 + ai * HALF + m * 16) * ldc + col0;
                f32x4 r0, r1;
#pragma unroll
                for (int e = 0; e < 4; ++e) { const float ga = acc[ai][0][m][0][e], gb = acc[ai][0][m][1][e];
                    r0[e] = ga * fast_sigmoid(ga) * acc[ai][1][m][0][e]; r1[e] = gb * fast_sigmoid(gb) * acc[ai][1][m][1][e]; }
                u32x4 w; w.x = cvt_pk_bf16(r0[0], r0[1]); w.y = cvt_pk_bf16(r0[2], r0[3]); w.z = cvt_pk_bf16(r1[0], r1[1]); w.w = cvt_pk_bf16(r1[2], r1[3]);
                *(u32x4*)rowp = w; }
    }
};
struct MergeOrder {
    StaticOrder S; int MT;
    __device__ void init(int M, int G_, int c_) { S.init(M, 1024, G_, c_); MT = M / BM; }
    __device__ bool next(int i, Unit& u) const { const int t = i / 3, br = i - 3 * t; Unit b; if (!S.next(t, b)) return false; u.pm = br * MT + b.pm; u.pn = br * 4 + b.pn; return true; }
    __device__ __forceinline__ void a_ready(const Unit&) const {}
    __device__ __forceinline__ void done(const Unit&) const {}
};

template <class Epi, class Sched, bool ALIGN_EPI = false, bool SP2 = false>
__device__ __forceinline__ void gemm_phase(PG8_LAS unsigned char* lds, const Gemm g, const Sched& S, const Epi& E) {
    int tid_ = threadIdx.x; asm volatile("" : "+v"(tid_));
    const int tid = tid_, wid = __builtin_amdgcn_readfirstlane(tid >> 6), lane = tid & 63, wr = wid >> 2, wc = wid & 3, fr = lane & 15, fq = lane >> 4;
    const int K = g.K, nt = K / BK;
    unsigned voffA[2], voffB[2];
#pragma unroll
    for (int i = 0; i < 2; ++i) { int R, C; stage_rc(tid * 16 + i * 8192, R, C); const int Rb = Epi::PERM ? ((R & ~31) + perm32(R & 31)) : R;
        voffA[i] = (unsigned)(R * K + C) * 2u; voffB[i] = (unsigned)(Rb * K + C) * 2u; }
    const size_t kstep = (size_t)(BK * 2);
    const size_t hstep = (size_t)HALF * K * 2;
    const size_t tstep = 2 * hstep;
    const unsigned ldsw = (unsigned)wid * 1024u;
    const int aoff = lds_byte(wr * 64 + fr, fq * 8), boff = lds_byte(wc * 32 + fr, fq * 8);
#define PG8_SA(b, h) (((b) * 2 + (h)) * HTB)
#define PG8_SB(b, h) ((4 + (b) * 2 + (h)) * HTB)
#define PG8_STAGE(bufoff, gbase, voff) do { _Pragma("unroll") for (int _i = 0; _i < 2; ++_i) \
        __builtin_amdgcn_global_load_lds((const unsigned*)((const char*)(gbase) + (voff)[_i]), (PG8_LAS unsigned*)(lds + (bufoff) + ldsw + _i * 8192), 16, 0, 0); } while (0)
#define PG8_LDA(dst, b, h) do { _Pragma("unroll") for (int m = 0; m < 4; ++m) _Pragma("unroll") for (int k = 0; k < 2; ++k) dst[m][k] = *(const PG8_LAS bf16x8*)(lds + PG8_SA(b, h) + aoff + m * 2048 + k * 1024); } while (0)
#define PG8_LDB(dst, b, h) do { _Pragma("unroll") for (int n = 0; n < 2; ++n) _Pragma("unroll") for (int k = 0; k < 2; ++k) dst[n][k] = *(const PG8_LAS bf16x8*)(lds + PG8_SB(b, h) + boff + n * 2048 + k * 1024); } while (0)
#define PG8_MMA(ai, bj, At, Bt) do { __builtin_amdgcn_s_setprio(1); _Pragma("unroll") for (int m = 0; m < 4; ++m) _Pragma("unroll") for (int n = 0; n < 2; ++n) _Pragma("unroll") for (int k = 0; k < 2; ++k) \
        acc[ai][bj][m][n] = __builtin_amdgcn_mfma_f32_16x16x32_bf16(Bt[n][k], At[m][k], acc[ai][bj][m][n], 0, 0, 0); __builtin_amdgcn_s_setprio(0); } while (0)
#define PG8_WAIT_V(n) asm volatile("s_waitcnt vmcnt(" #n ")" ::: "memory")
#define PG8_WAIT_L(n) asm volatile("s_waitcnt lgkmcnt(" #n ")" ::: "memory")
#define PG8_BAR __builtin_amdgcn_s_barrier()
#define PG8_SCHED __builtin_amdgcn_sched_barrier(0)
    Unit cur, nxt; int ui = 0;
    if (!S.next(0, cur)) return;
    f32x4 acc[2][2][4][2];
#pragma unroll
    for (int a = 0; a < 2; ++a)
#pragma unroll
        for (int b = 0; b < 2; ++b)
#pragma unroll
            for (int m = 0; m < 4; ++m)
#pragma unroll
                for (int n = 0; n < 2; ++n) acc[a][b][m][n] = (f32x4){0.f, 0.f, 0.f, 0.f};
    bf16x8 At[4][2], B0[2][2], B1[2][2];
    const char* cA = (const char*)g.A + (size_t)cur.pm * tstep; const char* cB = (const char*)g.Bt + (size_t)cur.pn * tstep;
    S.a_ready(cur);
    if constexpr (SP2) {
        PG8_STAGE(PG8_SB(0, 0), cB, voffB); PG8_STAGE(PG8_SB(0, 1), cB + hstep, voffB); PG8_STAGE(PG8_SA(0, 0), cA, voffA); PG8_STAGE(PG8_SA(0, 1), cA + hstep, voffA);
        if (wr == 1) PG8_BAR;
        PG8_WAIT_V(2); PG8_BAR;
        PG8_STAGE(PG8_SB(1, 0), cB + kstep, voffB); PG8_STAGE(PG8_SA(1, 0), cA + kstep, voffA); PG8_STAGE(PG8_SB(1, 1), cB + hstep + kstep, voffB);
        PG8_WAIT_V(6); PG8_BAR;
    } else {
        PG8_STAGE(PG8_SB(0, 0), cB, voffB); PG8_STAGE(PG8_SA(0, 0), cA, voffA); PG8_STAGE(PG8_SB(0, 1), cB + hstep, voffB); PG8_STAGE(PG8_SA(0, 1), cA + hstep, voffA);
        if (wr == 1) PG8_BAR;
        PG8_WAIT_V(4); PG8_BAR;
        PG8_STAGE(PG8_SB(1, 0), cB + kstep, voffB); PG8_STAGE(PG8_SA(1, 0), cA + kstep, voffA); PG8_STAGE(PG8_SB(1, 1), cB + hstep + kstep, voffB);
        PG8_WAIT_V(6); PG8_BAR;
    }
    for (;;) {
        const bool has_next = S.next(ui + 1, nxt);
        const char* nA = has_next ? (const char*)g.A + (size_t)nxt.pm * tstep : cA; const char* nB = has_next ? (const char*)g.Bt + (size_t)nxt.pn * tstep : cB;
        for (int t = 0; t < nt; t += 2) {
            const bool last = (t == nt - 2);
            const char* a1 = cA + (size_t)(t + 1) * kstep;
            const char* a2 = last ? nA : cA + (size_t)(t + 2) * kstep; const char* b2 = last ? nB : cB + (size_t)(t + 2) * kstep;
            const char* a3 = a2 + kstep; const char* b3 = b2 + kstep;
            if (last && has_next) S.a_ready(nxt);
            if constexpr (SP2) {
            PG8_LDB(B0, 0, 0); PG8_LDB(B1, 0, 1); PG8_SCHED; PG8_LDA(At, 0, 0); PG8_STAGE(PG8_SA(1, 1), a1 + hstep, voffA);
            PG8_WAIT_V(8); PG8_WAIT_L(0); PG8_BAR; PG8_MMA(0, 0, At, B0); PG8_MMA(0, 1, At, B1); PG8_BAR; PG8_SCHED;
            PG8_LDA(At, 0, 1); PG8_STAGE(PG8_SB(0, 0), b2, voffB); PG8_STAGE(PG8_SB(0, 1), b2 + hstep, voffB); PG8_STAGE(PG8_SA(0, 0), a2, voffA);
            PG8_WAIT_V(8); PG8_WAIT_L(0); PG8_BAR; PG8_MMA(1, 0, At, B0); PG8_MMA(1, 1, At, B1); PG8_BAR; PG8_SCHED;
            PG8_LDB(B0, 1, 0); PG8_LDB(B1, 1, 1); PG8_SCHED; PG8_LDA(At, 1, 0); PG8_STAGE(PG8_SA(0, 1), a2 + hstep, voffA);
            PG8_WAIT_V(8); PG8_WAIT_L(0); PG8_BAR; PG8_MMA(0, 0, At, B0); PG8_MMA(0, 1, At, B1); PG8_BAR; PG8_SCHED;
            PG8_LDA(At, 1, 1); PG8_STAGE(PG8_SB(1, 0), b3, voffB); PG8_STAGE(PG8_SB(1, 1), b3 + hstep, voffB); PG8_STAGE(PG8_SA(1, 0), a3, voffA);
            PG8_WAIT_V(8); PG8_WAIT_L(0); PG8_BAR; PG8_MMA(1, 0, At, B0); PG8_MMA(1, 1, At, B1); PG8_BAR; PG8_SCHED;
            } else {
            PG8_LDB(B0, 0, 0); PG8_SCHED; PG8_LDA(At, 0, 0); PG8_STAGE(PG8_SA(1, 1), a1 + hstep, voffA);
            PG8_WAIT_L(8); PG8_BAR; PG8_WAIT_L(0); PG8_MMA(0, 0, At, B0); PG8_BAR; PG8_SCHED;
            PG8_LDB(B1, 0, 1); PG8_STAGE(PG8_SB(0, 0), b2, voffB);
            PG8_BAR; PG8_WAIT_L(0); PG8_MMA(0, 1, At, B1); PG8_BAR;
            PG8_LDA(At, 0, 1); PG8_STAGE(PG8_SA(0, 0), a2, voffA);
            PG8_BAR; PG8_WAIT_L(0); PG8_MMA(1, 0, At, B0); PG8_BAR; PG8_SCHED;
            PG8_STAGE(PG8_SB(0, 1), b2 + hstep, voffB);
            PG8_WAIT_V(6); PG8_BAR; PG8_MMA(1, 1, At, B1); PG8_BAR;
            PG8_LDB(B0, 1, 0); PG8_SCHED; PG8_LDA(At, 1, 0); PG8_STAGE(PG8_SA(0, 1), a2 + hstep, voffA);
            PG8_WAIT_L(8); PG8_BAR; PG8_WAIT_L(0); PG8_MMA(0, 0, At, B0); PG8_BAR; PG8_SCHED;
            PG8_LDB(B1, 1, 1); PG8_STAGE(PG8_SB(1, 0), b3, voffB);
            PG8_BAR; PG8_WAIT_L(0); PG8_MMA(0, 1, At, B1); PG8_BAR;
            PG8_LDA(At, 1, 1); PG8_STAGE(PG8_SA(1, 0), a3, voffA);
            PG8_BAR; PG8_WAIT_L(0); PG8_MMA(1, 0, At, B0); PG8_BAR; PG8_SCHED;
            PG8_STAGE(PG8_SB(1, 1), b3 + hstep, voffB);
            PG8_WAIT_V(6); PG8_BAR; PG8_MMA(1, 1, At, B1); PG8_BAR;
            }
        }
        if constexpr (ALIGN_EPI) { if (wr == 0) PG8_BAR; }
        bool keep_acc = false;
        if constexpr (!Epi::AFTER_DRAIN) { if constexpr (Epi::KEEP) keep_acc = E.apply(acc, cur, wr, wc, fr, fq); else E(acc, cur, wr, wc, fr, fq); S.done(cur); }
        if (!has_next) break;
        if (!keep_acc) {
#pragma unroll
        for (int a = 0; a < 2; ++a)
#pragma unroll
            for (int b = 0; b < 2; ++b)
#pragma unroll
                for (int m = 0; m < 4; ++m)
#pragma unroll
                    for (int n = 0; n < 2; ++n) acc[a][b][m][n] = (f32x4){0.f, 0.f, 0.f, 0.f};
        }
        cur = nxt; cA = nA; cB = nB; ++ui;
        if constexpr (ALIGN_EPI) { if (wr == 1) PG8_BAR; }
    }
    PG8_WAIT_V(0);
    if constexpr (!ALIGN_EPI) { if (wr == 0) PG8_BAR; }
    PG8_BAR;
    if constexpr (Epi::AFTER_DRAIN) { E.fused(acc, cur, wr, wc, fr, fq, lds, wid, lane); S.done(cur); }
#undef PG8_SA
#undef PG8_SB
#undef PG8_STAGE
#undef PG8_LDA
#undef PG8_LDB
#undef PG8_MMA
#undef PG8_WAIT_V
#undef PG8_WAIT_L
#undef PG8_BAR
#undef PG8_SCHED
}
}

#define LAS __attribute__((address_space(3)))
typedef unsigned short bf16_t;
typedef short bf16x8 __attribute__((ext_vector_type(8)));
typedef float f32x4 __attribute__((ext_vector_type(4)));
typedef float f32x16 __attribute__((ext_vector_type(16)));
typedef unsigned u32x4 __attribute__((ext_vector_type(4)));
typedef unsigned u32x2 __attribute__((ext_vector_type(2)));

constexpr int D = 1024, SEQ = 2048, DEPTH = 4, NHALF = 2, HB = 8, TH = HB * SEQ;
constexpr int INC = 4608, NPROJ = 7680, FF = 2816;
constexpr int C_POOL = 0, C_AQ = 512, C_AK = 1024, C_AV = 1536, C_RQ = 2048, C_RF = 2560, C_RB = 3072, C_RI = 3584, C_RG = 4096, C_GATE = 4608;
constexpr float EPS = 1e-6f;
constexpr int NT = 512, NW = 8;
constexpr int LDS_BYTES = 155648;
constexpr int LDS_ITEM_OFF = 155136;

constexpr size_t MiB = 1u << 20;
constexpr size_t WS_CTL = 0, CTL_BYTES = 65536;
constexpr size_t WS_W = 2 * MiB, W_LAYER = 37 * MiB;
constexpr size_t WO_IN = 0, WO_POOL = (size_t)NPROJ * D * 2, WO_UP = WO_POOL + 4 * 128 * 128 * 2, WO_OUT = WO_UP + (size_t)3 * D * 512 * 2,
                 WO_FFI = WO_OUT + (size_t)D * D * 2, WO_FFO = WO_FFI + (size_t)2 * FF * D * 2, WO_END = WO_FFO + (size_t)D * FF * 2;
static_assert(WO_END <= W_LAYER, "weights per layer");
constexpr size_t WS_PROJ = 150 * MiB;
constexpr size_t WS_GATE = 294 * MiB;
constexpr size_t WS_H = 390 * MiB;
constexpr size_t WS_Y = 422 * MiB;
constexpr size_t WS_O2 = 470 * MiB;
constexpr size_t WS_END = 502 * MiB;
static_assert(WS_W + DEPTH * W_LAYER <= WS_PROJ && WS_PROJ + (size_t)TH * INC * 2 <= WS_GATE && WS_GATE + (size_t)TH * 3072 * 2 <= WS_H && WS_H + (size_t)TH * D * 2 <= WS_Y && WS_Y + (size_t)3 * TH * 512 * 2 <= WS_O2 && WS_O2 + (size_t)2 * TH * 512 * 2 <= WS_END, "ws map");

struct Params { const float* in[20]; float* out; unsigned char* ws; };
enum { I_X = 0, I_N1G, I_WIN, I_POOLW, I_POOLS, I_LQ1, I_LK1, I_LQ2, I_LK2, I_DNG, I_HLB, I_HNG, I_WUP, I_WUA, I_WUR, I_WOUT, I_N2G, I_WFI, I_WFO, I_FNG };

typedef float f32x2c __attribute__((ext_vector_type(2)));
typedef __bf16 bf16x2c __attribute__((ext_vector_type(2)));
__device__ __forceinline__ unsigned pkbf(float lo, float hi) { const f32x2c v = {lo, hi}; const bf16x2c b = __builtin_convertvector(v, bf16x2c); return __builtin_bit_cast(unsigned, b); }
__device__ __forceinline__ float bflo(unsigned w) { return __uint_as_float(w << 16); }
__device__ __forceinline__ float bfhi(unsigned w) { return __uint_as_float(w & 0xffff0000u); }
__device__ __forceinline__ float bfe(const u32x4& w, int e) { const unsigned x = w[e >> 1]; return (e & 1) ? bfhi(x) : bflo(x); }
__device__ __forceinline__ float sigm(float x) { return __builtin_amdgcn_rcpf(1.0f + __expf(-x)); }
__device__ __forceinline__ float wave_sum(float v) {
#pragma unroll
    for (int o = 1; o < 64; o <<= 1) v += __shfl_xor(v, o);
    return v;
}
#define BARRIER() __syncthreads()

__device__ __forceinline__ void p0_transpose_item(const float* W, int K, int N, bf16_t* WT, int row_off, int mode, LAS float* scr, int item, int lane) {
    const int nblk = N / 32, kb = item / nblk, nb = item - kb * nblk, k0 = 64 * kb, n0 = 32 * nb;
#pragma unroll 8
    for (int i = 0; i < 32; ++i) { const int kk = 2 * i + (lane >> 5); scr[kk * 33 + (lane & 31)] = W[(size_t)(k0 + kk) * N + n0 + (lane & 31)]; }
    asm volatile("s_waitcnt lgkmcnt(0)" ::: "memory");
    int drow0;
    if (mode == 1) { const int bj = n0 / FF, jj = n0 - bj * FF; drow0 = (jj >> 7) * 256 + bj * 128 + (jj & 127); } else drow0 = row_off + n0;
    const int c = lane & 7;
#pragma unroll
    for (int j = 0; j < 4; ++j) { const int n = (lane >> 3) + 8 * j; const LAS float* s = scr + (8 * c) * 33 + n;
        u32x4 o; o.x = pkbf(s[0 * 33], s[1 * 33]); o.y = pkbf(s[2 * 33], s[3 * 33]); o.z = pkbf(s[4 * 33], s[5 * 33]); o.w = pkbf(s[6 * 33], s[7 * 33]);
        *(u32x4*)(WT + (size_t)(drow0 + n) * K + k0 + 8 * c) = o; }
    asm volatile("s_waitcnt lgkmcnt(0)" ::: "memory");
}
__device__ __forceinline__ void p0_prologue(const Params& p, LAS unsigned char* lds, int gw, int NGW, int wave, int lane) {
    LAS float* scr = (LAS float*)(lds + wave * 16384);
    constexpr int I_IN = (D / 64) * (NPROJ / 32), I_PL = 4 * 2 * 4, I_UP = (512 / 64) * (D / 32), I_OUT = (D / 64) * (D / 32), I_FI = (D / 64) * (2 * FF / 32), I_FO = (FF / 64) * (D / 32);
    constexpr int PER_LAYER = I_IN + I_PL + 3 * I_UP + I_OUT + I_FI + I_FO;
    for (int it = gw; it < DEPTH * PER_LAYER; it += NGW) {
        const int l = it / PER_LAYER; int r = it - l * PER_LAYER;
        unsigned char* wl = p.ws + WS_W + (size_t)l * W_LAYER;
        if (r < I_IN) { p0_transpose_item(p.in[I_WIN] + (size_t)l * D * NPROJ, D, NPROJ, (bf16_t*)(wl + WO_IN), 0, 0, scr, r, lane); continue; } r -= I_IN;
        if (r < I_PL) { const int g = r >> 3; p0_transpose_item(p.in[I_POOLW] + (size_t)(l * 4 + g) * 128 * 128, 128, 128, (bf16_t*)(wl + WO_POOL) + (size_t)g * 128 * 128, 0, 0, scr, r & 7, lane); continue; } r -= I_PL;
        if (r < 3 * I_UP) { const int br = r / I_UP; const float* src = p.in[br == 0 ? I_WUP : (br == 1 ? I_WUA : I_WUR)] + (size_t)l * 512 * D;
            p0_transpose_item(src, 512, D, (bf16_t*)(wl + WO_UP), br * D, 0, scr, r - br * I_UP, lane); continue; } r -= 3 * I_UP;
        if (r < I_OUT) { p0_transpose_item(p.in[I_WOUT] + (size_t)l * D * D, D, D, (bf16_t*)(wl + WO_OUT), 0, 0, scr, r, lane); continue; } r -= I_OUT;
        if (r < I_FI) { p0_transpose_item(p.in[I_WFI] + (size_t)l * D * 2 * FF, D, 2 * FF, (bf16_t*)(wl + WO_FFI), 0, 1, scr, r, lane); continue; } r -= I_FI;
        p0_transpose_item(p.in[I_WFO] + (size_t)l * FF * D, FF, D, (bf16_t*)(wl + WO_FFO), 0, 0, scr, r, lane);
    }
}

__device__ __forceinline__ void norm_rows_bf16(const float* x, const float* g, bf16_t* h, int nrows, int gw, int NGW, int lane) {
    for (int row = gw; row < nrows; row += NGW) {
        const f32x4* xr = (const f32x4*)(x + (size_t)row * D) + lane;
        f32x4 v[4]; float ss = 0.f;
#pragma unroll
        for (int j = 0; j < 4; ++j) { v[j] = xr[64 * j]; ss += (v[j][0] * v[j][0] + v[j][1] * v[j][1]) + (v[j][2] * v[j][2] + v[j][3] * v[j][3]); }
        const float rstd = rsqrtf(wave_sum(ss) * (1.0f / D) + EPS);
        u32x2* o = (u32x2*)(h + (size_t)row * D) + lane;
#pragma unroll
        for (int j = 0; j < 4; ++j) { const f32x4 gv = ((const f32x4*)g)[lane + 64 * j]; const f32x4 y = v[j] * rstd * gv; u32x2 w; w.x = pkbf(y[0], y[1]); w.y = pkbf(y[2], y[3]); o[64 * j] = w; }
    }
}
__device__ __forceinline__ void norm_rows_f32_inplace(float* x, const float* g, int nrows, int gw, int NGW, int lane, int probe_rows) {
    for (int row = gw; row < nrows; row += NGW) {
        f32x4* xr = (f32x4*)(x + (size_t)row * D) + lane;
        f32x4 v[4]; float ss = 0.f;
#pragma unroll
        for (int j = 0; j < 4; ++j) { v[j] = xr[64 * j]; ss += (v[j][0] * v[j][0] + v[j][1] * v[j][1]) + (v[j][2] * v[j][2] + v[j][3] * v[j][3]); }
        const float rstd = rsqrtf(wave_sum(ss) * (1.0f / D) + EPS);
#pragma unroll
        for (int j = 0; j < 4; ++j) { const f32x4 gv = ((const f32x4*)g)[lane + 64 * j]; const float pd = (row < probe_rows) ? ((lane & 1) ? 0.0078125f : -0.0078125f) : 0.f; xr[64 * j] = v[j] * rstd * gv + pd; }
    }
}
__device__ __forceinline__ void hgrn_combine(const bf16_t* of, const bf16_t* ob, const bf16_t* proj, const float* gain, bf16_t* yrec, int gw, int NGW, int lane) {
    for (int row = gw; row < TH; row += NGW) {
        const u32x4 a = *((const u32x4*)(of + (size_t)row * 512) + lane), b = *((const u32x4*)(ob + (size_t)row * 512) + lane);
        const u32x4 gz = *((const u32x4*)(proj + (size_t)row * INC + C_RG) + lane);
        float o[8]; float ss = 0.f;
#pragma unroll
        for (int e = 0; e < 8; ++e) { o[e] = bfe(a, e) + bfe(b, e); ss += o[e] * o[e]; }
        ss += __shfl_xor(ss, 1); ss += __shfl_xor(ss, 2); ss += __shfl_xor(ss, 4); ss += __shfl_xor(ss, 8);
        const float rstd = rsqrtf(ss * (1.0f / 128.0f) + EPS);
        const f32x4 g0 = *(const f32x4*)(gain + ((8 * lane) & 127)), g1 = *(const f32x4*)(gain + ((8 * lane) & 127) + 4);
        float y[8];
#pragma unroll
        for (int e = 0; e < 8; ++e) { const float z = bfe(gz, e); const float gg = e < 4 ? g0[e] : g1[e - 4]; y[e] = o[e] * rstd * gg * (z * sigm(z)); }
        u32x4 w; w.x = pkbf(y[0], y[1]); w.y = pkbf(y[2], y[3]); w.z = pkbf(y[4], y[5]); w.w = pkbf(y[6], y[7]);
        *((u32x4*)(yrec + (size_t)row * 512) + lane) = w;
    }
}

__device__ __forceinline__ void pool_unit(LAS unsigned char* lds, const bf16_t* proj, const bf16_t* wpool  , const float* pscale  , bf16_t* ypool, int unit, int tid) {
    const int tile = unit >> 2, g = unit & 3, t0 = tile * 128, p0 = t0 & (SEQ - 1), hw = 1 << g;
    LAS bf16_t* U = (LAS bf16_t*)lds; LAS bf16_t* Dt = (LAS bf16_t*)(lds + 39168); LAS bf16_t* Bw = (LAS bf16_t*)(lds + 39168 + 34816);
    for (int idx = tid; idx < 144 * 16; idx += NT) { const int r = idx >> 4, cs = idx & 15; const int pp = p0 - 8 + r;
        u32x4 v = (u32x4){0u, 0u, 0u, 0u};
        if (pp >= 0 && pp < SEQ) v = *(const u32x4*)(proj + (size_t)(t0 - 8 + r) * INC + C_POOL + g * 128 + cs * 8);
        *(LAS u32x4*)(U + r * 136 + cs * 8) = v; }
    for (int idx = tid; idx < 128 * 16; idx += NT) { const int r = idx >> 4, cs = idx & 15;
        *(LAS u32x4*)(Bw + r * 136 + cs * 8) = *(const u32x4*)(wpool + (size_t)g * 128 * 128 + r * 128 + cs * 8); }
    BARRIER();
    for (int idx = tid; idx < 128 * 16; idx += NT) { const int r = idx >> 4, cs = idx & 15; const int pp = p0 + r;
        int lo = pp - hw; if (lo < 0) lo = 0; int hi = pp + hw - 1; if (hi > SEQ - 1) hi = SEQ - 1;
        float s[8];
#pragma unroll
        for (int e = 0; e < 8; ++e) s[e] = 0.f;
        for (int q = lo; q <= hi; ++q) { const u32x4 v = *(const LAS u32x4*)(U + (q - p0 + 8) * 136 + cs * 8);
#pragma unroll
            for (int e = 0; e < 8; ++e) s[e] += bfe(v, e); }
        const float inv = 1.0f / (float)(hi - lo + 1);
        const u32x4 c = *(const LAS u32x4*)(U + (r + 8) * 136 + cs * 8);
        u32x4 w; w.x = pkbf(s[0] * inv - bfe(c, 0), s[1] * inv - bfe(c, 1)); w.y = pkbf(s[2] * inv - bfe(c, 2), s[3] * inv - bfe(c, 3));
        w.z = pkbf(s[4] * inv - bfe(c, 4), s[5] * inv - bfe(c, 5)); w.w = pkbf(s[6] * inv - bfe(c, 6), s[7] * inv - bfe(c, 7));
        *(LAS u32x4*)(Dt + r * 136 + cs * 8) = w; }
    BARRIER();
    const int wave = tid >> 6, lane = tid & 63, lr = lane & 15, lg = lane >> 4;
    f32x4 acc[8];
#pragma unroll
    for (int cb = 0; cb < 8; ++cb) acc[cb] = (f32x4){0.f, 0.f, 0.f, 0.f};
#pragma unroll
    for (int st = 0; st < 4; ++st) { const bf16x8 a = *(const LAS bf16x8*)(Dt + (16 * wave + lr) * 136 + 32 * st + 8 * lg);
#pragma unroll
        for (int cb = 0; cb < 8; ++cb) { const bf16x8 b = *(const LAS bf16x8*)(Bw + (16 * cb + lr) * 136 + 32 * st + 8 * lg);
            acc[cb] = __builtin_amdgcn_mfma_f32_16x16x32_bf16(a, b, acc[cb], 0, 0, 0); } }
#pragma unroll
    for (int cb = 0; cb < 8; ++cb) { const int n = g * 128 + 16 * cb + lr; const float sc = pscale[n];
#pragma unroll
        for (int r = 0; r < 4; ++r) { const int row = t0 + 16 * wave + 4 * lg + r; ypool[(size_t)row * 512 + n] = (bf16_t)(pkbf(acc[cb][r] * sc, 0.f) & 0xffffu); } }
    BARRIER();
}

constexpr int AT_Q = 0, AT_K = 34816, AT_V = AT_K + 2 * 17408, AT_END = AT_V + 2 * 17408;
static_assert(AT_END <= LDS_ITEM_OFF && 128 * 132 * 4 <= 4 * 17408, "attention LDS");
__device__ __forceinline__ void attn_unit(LAS unsigned char* lds, const bf16_t* proj, const float* lq1, const float* lk1, const float* lq2, const float* lk2, const float* dng, int layer, bf16_t* yattn, int unit, int tid) {
    const int b = unit >> 6, h = (unit >> 4) & 3, qb = unit & 15;
    const int wave = tid >> 6, lane = tid & 63, l31 = lane & 31, hi = lane >> 5, rg = wave & 3, c = wave >> 2;
    LAS bf16_t* Qs = (LAS bf16_t*)(lds + AT_Q);
    const size_t tok0 = (size_t)b * SEQ;
    const float lambda_init = 0.8f - 0.6f * __expf(-0.3f * (float)layer);
    float s1 = 0.f, s2 = 0.f;
    for (int i = 0; i < 64; ++i) { s1 += lq1[i] * lk1[i]; s2 += lq2[i] * lk2[i]; }
    const float lam = __expf(s1) - __expf(s2) + lambda_init;
    const float LOG2E = 1.4426950408889634f;
    const float sc2 = 0.125f * LOG2E;
    const float slope2 = exp2f(-2.0f * (float)(h + 1)) * LOG2E;
#pragma unroll
    for (int i = 0; i < 4; ++i) { const int idx = tid + NT * i, r = idx >> 4, cs = idx & 15;
        const u32x4 qv = *(const u32x4*)(proj + (tok0 + qb * 128 + r) * INC + C_AQ + h * 128 + cs * 8);
        u32x4 qs; qs.x = pkbf(bflo(qv.x) * sc2, bfhi(qv.x) * sc2); qs.y = pkbf(bflo(qv.y) * sc2, bfhi(qv.y) * sc2); qs.z = pkbf(bflo(qv.z) * sc2, bfhi(qv.z) * sc2); qs.w = pkbf(bflo(qv.w) * sc2, bfhi(qv.w) * sc2);
        *(LAS u32x4*)(Qs + r * 136 + cs * 8) = qs; }
    const int kr0 = tid >> 4, kcs = tid & 15;
    const int vkp = tid >> 4, vvg = tid & 15;
    u32x4 kreg[2], vreg[2];
    {
        const bf16_t* kb = proj + (tok0 + kr0) * INC + C_AK + h * 128 + kcs * 8;
        kreg[0] = *(const u32x4*)kb; kreg[1] = *(const u32x4*)(kb + (size_t)32 * INC);
        const bf16_t* vb = proj + (tok0 + 2 * vkp) * INC + C_AV + h * 128 + vvg * 8;
        vreg[0] = *(const u32x4*)vb; vreg[1] = *(const u32x4*)(vb + INC);
    }
    f32x16 O[4];
#pragma unroll
    for (int vt = 0; vt < 4; ++vt)
#pragma unroll
        for (int r = 0; r < 16; ++r) O[vt][r] = 0.f;
    float mrun = 0.f, lrun = 0.f;
    const int qpos = qb * 128 + 32 * rg + l31;
    const LAS bf16_t* qrow = Qs + (32 * rg + l31) * 136 + c * 64 + 8 * hi;
    for (int kt = 0; kt < SEQ / 64; ++kt) {
        const int cur = kt & 1;
        LAS bf16_t* Kc = (LAS bf16_t*)(lds + AT_K + cur * 17408); LAS bf16_t* Vc = (LAS bf16_t*)(lds + AT_V + cur * 17408);
        *(LAS u32x4*)(Kc + kr0 * 136 + kcs * 8) = kreg[0]; *(LAS u32x4*)(Kc + (kr0 + 32) * 136 + kcs * 8) = kreg[1];
#pragma unroll
        for (int e = 0; e < 8; ++e) { const unsigned lo = (e & 1) ? (vreg[0][e >> 1] >> 16) : (vreg[0][e >> 1] & 0xffffu); const unsigned hi16 = (e & 1) ? (vreg[1][e >> 1] & 0xffff0000u) : (vreg[1][e >> 1] << 16);
            *(LAS unsigned*)(Vc + (8 * vvg + e) * 68 + 2 * vkp) = lo | hi16; }
        BARRIER();
        if (kt + 1 < SEQ / 64) {
            const bf16_t* kb = proj + (tok0 + (kt + 1) * 64 + kr0) * INC + C_AK + h * 128 + kcs * 8;
            kreg[0] = *(const u32x4*)kb; kreg[1] = *(const u32x4*)(kb + (size_t)32 * INC);
            const bf16_t* vb = proj + (tok0 + (kt + 1) * 64 + 2 * vkp) * INC + C_AV + h * 128 + vvg * 8;
            vreg[0] = *(const u32x4*)vb; vreg[1] = *(const u32x4*)(vb + INC);
        }
        f32x16 S[2];
#pragma unroll
        for (int ks = 0; ks < 2; ++ks)
#pragma unroll
            for (int r = 0; r < 16; ++r) S[ks][r] = -mrun;
#pragma unroll
        for (int st = 0; st < 4; ++st) {
            const bf16x8 qf = *(const LAS bf16x8*)(qrow + 16 * st);
#pragma unroll
            for (int ks = 0; ks < 2; ++ks) { const bf16x8 kf = *(const LAS bf16x8*)(Kc + (32 * ks + l31) * 136 + c * 64 + 16 * st + 8 * hi);
                S[ks] = __builtin_amdgcn_mfma_f32_32x32x16_bf16(kf, qf, S[ks], 0, 0, 0); }
        }
        float mx = -1e30f;
#pragma unroll
        for (int ks = 0; ks < 2; ++ks) { const float fq = (float)(qpos - (64 * kt + 32 * ks + 4 * hi));
#pragma unroll
            for (int r = 0; r < 16; ++r) { const float tt = fq - (float)((r & 3) + 8 * (r >> 2)); const float v = fmaf(-slope2, fabsf(tt), S[ks][r]); S[ks][r] = v; mx = fmaxf(mx, v); } }
        mx = fmaxf(mx, __shfl_xor(mx, 32));
        float psum = 0.f, delta = 0.f;
        if (kt == 0 || __builtin_amdgcn_ballot_w64(mx > 4.0f) != 0ull) {
            delta = (kt == 0) ? mx : fmaxf(mx, 0.f); const float alpha = (kt == 0) ? 1.0f : __builtin_amdgcn_exp2f(-delta);
            mrun += delta; lrun *= alpha;
#pragma unroll
            for (int vt = 0; vt < 4; ++vt) O[vt] = O[vt] * alpha;
        }
#pragma unroll
        for (int ks = 0; ks < 2; ++ks)
#pragma unroll
            for (int r = 0; r < 16; ++r) { const float pv = __builtin_amdgcn_exp2f(S[ks][r] - delta); S[ks][r] = pv; psum += pv; }
        lrun += psum;
        bf16x8 pf[2][2];
#pragma unroll
        for (int ks = 0; ks < 2; ++ks)
#pragma unroll
            for (int s = 0; s < 2; ++s) { u32x4 pw; pw.x = pkbf(S[ks][8 * s + 0], S[ks][8 * s + 1]); pw.y = pkbf(S[ks][8 * s + 2], S[ks][8 * s + 3]);
                pw.z = pkbf(S[ks][8 * s + 4], S[ks][8 * s + 5]); pw.w = pkbf(S[ks][8 * s + 6], S[ks][8 * s + 7]); pf[ks][s] = __builtin_bit_cast(bf16x8, pw); }
#pragma unroll
        for (int vt = 0; vt < 4; ++vt) {
            f32x16 o = O[vt];
#pragma unroll
            for (int ks = 0; ks < 2; ++ks)
#pragma unroll
                for (int s = 0; s < 2; ++s) {
                    const LAS bf16_t* vp = Vc + (32 * vt + l31) * 68 + 32 * ks + 16 * s + 4 * hi;
                    const u32x2 a = *(const LAS u32x2*)vp, bq = *(const LAS u32x2*)(vp + 8);
                    const u32x4 w = (u32x4){a.x, a.y, bq.x, bq.y};
                    o = __builtin_amdgcn_mfma_f32_32x32x16_bf16(__builtin_bit_cast(bf16x8, w), pf[ks][s], o, 0, 0, 0);
                }
            O[vt] = o;
        }
    }
    const float ltot = lrun + __shfl_xor(lrun, 32);
    LAS float* X = (LAS float*)(lds + AT_K);
    BARRIER();
    if (c == 1) { const float sc = lam / ltot;
#pragma unroll
        for (int vt = 0; vt < 4; ++vt)
#pragma unroll
            for (int rq = 0; rq < 4; ++rq) { const f32x4 w = (f32x4){O[vt][4 * rq + 0] * sc, O[vt][4 * rq + 1] * sc, O[vt][4 * rq + 2] * sc, O[vt][4 * rq + 3] * sc};
                *(LAS f32x4*)(X + (32 * rg + l31) * 132 + 32 * vt + 8 * rq + 4 * hi) = w; } }
    BARRIER();
    if (c == 0) { const float i0 = 1.0f / ltot; float ss = 0.f;
#pragma unroll
        for (int vt = 0; vt < 4; ++vt)
#pragma unroll
            for (int rq = 0; rq < 4; ++rq) { const f32x4 x = *(const LAS f32x4*)(X + (32 * rg + l31) * 132 + 32 * vt + 8 * rq + 4 * hi);
#pragma unroll
                for (int e = 0; e < 4; ++e) { const float o = O[vt][4 * rq + e] * i0 - x[e]; O[vt][4 * rq + e] = o; ss += o * o; } }
        ss += __shfl_xor(ss, 32);
        const float rs = rsqrtf(ss * (1.0f / 128.0f) + EPS) * (1.0f - lambda_init);
#pragma unroll
        for (int vt = 0; vt < 4; ++vt)
#pragma unroll
            for (int rq = 0; rq < 4; ++rq) { const int v0 = 32 * vt + 8 * rq + 4 * hi; const f32x4 gv = *(const f32x4*)(dng + v0);
                u32x2 w; w.x = pkbf(O[vt][4 * rq + 0] * rs * gv[0], O[vt][4 * rq + 1] * rs * gv[1]); w.y = pkbf(O[vt][4 * rq + 2] * rs * gv[2], O[vt][4 * rq + 3] * rs * gv[3]);
                *(LAS u32x2*)(Qs + (32 * rg + l31) * 136 + v0) = w; } }
    BARRIER();
#pragma unroll
    for (int i = 0; i < 4; ++i) { const int idx = tid + NT * i, r = idx >> 4, cs = idx & 15;
        *(u32x4*)(yattn + (tok0 + qb * 128 + r) * 512 + h * 128 + cs * 8) = *(const LAS u32x4*)(Qs + r * 136 + cs * 8); }
    BARRIER();
}

constexpr int HG_QD = 0, HG_QG = 17408, HG_KE = 34816, HG_KT = 52224, HG_V = HG_KT + 18432, HG_S = HG_V + 18432, HG_VEC = HG_S + 34816, HG_SCP = HG_VEC + 8192, HG_LB = HG_SCP + 18432, HG_END = HG_LB + 512;
static_assert(HG_END <= LDS_ITEM_OFF, "hgrn LDS");
__device__ __forceinline__ bf16x8 scale_frag(const u32x4 w, const f32x4 m0, const f32x4 m1) {
    u32x4 o; o.x = pkbf(bflo(w.x) * m0[0], bfhi(w.x) * m0[1]); o.y = pkbf(bflo(w.y) * m0[2], bfhi(w.y) * m0[3]); o.z = pkbf(bflo(w.z) * m1[0], bfhi(w.z) * m1[1]); o.w = pkbf(bflo(w.w) * m1[2], bfhi(w.w) * m1[3]);
    return __builtin_bit_cast(bf16x8, o);
}
#ifndef PROBE
#define PROBE 0
#endif
#define HG_T0(id) do { if (PROBE == (id) && blockIdx.x == 0 && tid == 0) *(LAS unsigned long long*)(lds + LDS_ITEM_OFF + 128) = __builtin_amdgcn_s_memrealtime(); } while (0)
#define HG_T1(id) do { if (PROBE == (id) && blockIdx.x == 0 && tid == 0) *(LAS unsigned long long*)(lds + LDS_ITEM_OFF + 136) += __builtin_amdgcn_s_memrealtime() - *(LAS unsigned long long*)(lds + LDS_ITEM_OFF + 128); } while (0)
__device__ __forceinline__ void hgrn_unit(LAS unsigned char* lds, const bf16_t* proj, const float* hlb  , int layer, bf16_t* o2  , int unit, int tid) {
    const int b = unit >> 3, h = (unit >> 1) & 3, dir = unit & 1;
    const int wave = __builtin_amdgcn_readfirstlane(tid >> 6), lane = tid & 63, lr = lane & 15, lg = lane >> 4;
    LAS bf16_t* Qd = (LAS bf16_t*)(lds + HG_QD); LAS bf16_t* Qg = (LAS bf16_t*)(lds + HG_QG); LAS bf16_t* Ke = (LAS bf16_t*)(lds + HG_KE); LAS bf16_t* KeT = (LAS bf16_t*)(lds + HG_KT);
    LAS bf16_t* Vt = (LAS bf16_t*)(lds + HG_V); LAS bf16_t* St = (LAS bf16_t*)(lds + HG_S); LAS float* Vec = (LAS float*)(lds + HG_VEC); LAS bf16_t* Sc = (LAS bf16_t*)(lds + HG_SCP);
    LAS float* lbv = (LAS float*)(lds + HG_LB);
    const size_t tok0 = (size_t)b * SEQ;
    const float scale_q = 0.08838834764831845f;
    if (tid < 128) { const float* a = hlb + (size_t)dir * DEPTH * 512 + h * 128 + tid;
        const float a0 = a[0], a1 = a[512], a2 = a[1024], a3 = a[1536]; const float mx = fmaxf(fmaxf(a0, a1), fmaxf(a2, a3));
        const float e0 = __expf(a0 - mx), e1 = __expf(a1 - mx), e2 = __expf(a2 - mx), e3 = __expf(a3 - mx); const float inv = 1.0f / (e0 + e1 + e2 + e3);
        float lb = 0.f; if (layer >= 1) lb += e1 * inv; if (layer >= 2) lb += e2 * inv; if (layer >= 3) lb += e3 * inv;
        lbv[tid] = lb; }
    for (int idx = tid; idx < 128 * 136 / 2; idx += NT) ((LAS unsigned*)St)[idx] = 0u;
    f32x4 st[8];
#pragma unroll
    for (int vb = 0; vb < 8; ++vb) st[vb] = (f32x4){0.f, 0.f, 0.f, 0.f};
    const int ci4 = wave >> 1, half = lane >> 5, cp2 = 2 * (((wave & 1) << 5) | (lane & 31)), rb8 = 16 * ci4 + 8 * half;
    const __amdgpu_buffer_rsrc_t rsrc = __builtin_amdgcn_make_buffer_rsrc((void*)(proj + tok0 * INC + h * 128), (short)0, SEQ * INC * 2, 0x00020000);
    const int fcol = (dir == 0 ? C_RF : C_RB);
    const int vo = cp2 * 2 + (dir == 0 ? half : 1 - half) * (8 * INC * 2);
#define HG_ROWOFF(ci_, r_) ((dir == 0 ? ((ci_) * 64 + 16 * ci4 + (r_)) : (SEQ - 9 - ((ci_) * 64 + 16 * ci4 + (r_)))) * (INC * 2))
    unsigned qraw[8], zraw[8], vraw[8];
#pragma unroll
    for (int r = 0; r < 8; ++r) { const int ro = HG_ROWOFF(0, r);
        qraw[r] = __builtin_amdgcn_raw_buffer_load_b32(rsrc, vo, ro + C_RQ * 2, 0); zraw[r] = __builtin_amdgcn_raw_buffer_load_b32(rsrc, vo, ro + fcol * 2, 0); vraw[r] = __builtin_amdgcn_raw_buffer_load_b32(rsrc, vo, ro + C_RI * 2, 0); }
    BARRIER();
    typedef float f2 __attribute__((ext_vector_type(2)));
    for (int ci = 0; ci < SEQ / 64; ++ci) {
        HG_T0(12);
        {
            const f2 lb = *(const LAS f2*)(lbv + cp2), oml = 1.0f - lb;
            f2 ff[8]; f2 Pl = (f2){1.0f, 1.0f};
#pragma unroll
            for (int r = 0; r < 8; ++r) { f2 z = (f2){bflo(zraw[r]), bfhi(zraw[r])}; z = __builtin_elementwise_min(__builtin_elementwise_max(z, (f2){-30.0f, -30.0f}), (f2){30.0f, 30.0f});
                f2 ez; ez.x = __expf(-z.x); ez.y = __expf(-z.y); f2 sg; sg.x = __builtin_amdgcn_rcpf(1.0f + ez.x); sg.y = __builtin_amdgcn_rcpf(1.0f + ez.y);
                const f2 f = lb + oml * sg; ff[r] = f; Pl = Pl * f; }
            f2 Po; Po.x = __shfl_xor(Pl.x, 32); Po.y = __shfl_xor(Pl.y, 32);
            const f2 one = (f2){1.0f, 1.0f};
            f2 P = half ? Po : one;
#pragma unroll
            for (int r = 0; r < 8; ++r) { P = P * ff[r];
                const f2 qd = (f2){bflo(qraw[r]), bfhi(qraw[r])} * scale_q * P;
                *(LAS unsigned*)(Qd + (rb8 + r) * 136 + cp2) = pkbf(qd.x, qd.y); }
            if (half == 0) *(LAS f2*)(Vec + ci4 * 128 + cp2) = Pl * Po;
            unsigned kw0[4], kw1[4], vw0[4], vw1[4]; f2 suf = half ? one : Po;
#pragma unroll
            for (int r = 7; r >= 0; --r) { const f2 q = (f2){bflo(qraw[r]), bfhi(qraw[r])} * scale_q;
                const f2 ke = (1.0f - ff[r]) * suf; f2 iv; iv.x = fminf(__builtin_amdgcn_rcpf(suf.x), 5.5e34f); iv.y = fminf(__builtin_amdgcn_rcpf(suf.y), 5.5e34f); const f2 qg = q * iv;
                *(LAS unsigned*)(Qg + (rb8 + r) * 136 + cp2) = pkbf(qg.x, qg.y);
                const unsigned kd = pkbf(ke.x, ke.y); *(LAS unsigned*)(Ke + (rb8 + r) * 136 + cp2) = kd;
                const unsigned vd = vraw[r];
                if (r & 1) { kw0[r >> 1] = kd << 16; kw1[r >> 1] = kd & 0xffff0000u; vw0[r >> 1] = vd << 16; vw1[r >> 1] = vd & 0xffff0000u; }
                else { kw0[r >> 1] |= kd & 0xffffu; kw1[r >> 1] |= kd >> 16; vw0[r >> 1] |= vd & 0xffffu; vw1[r >> 1] |= vd >> 16; }
                suf = suf * ff[r]; }
            *(LAS u32x4*)(KeT + cp2 * 72 + rb8) = (u32x4){kw0[0], kw0[1], kw0[2], kw0[3]}; *(LAS u32x4*)(KeT + (cp2 + 1) * 72 + rb8) = (u32x4){kw1[0], kw1[1], kw1[2], kw1[3]};
            *(LAS u32x4*)(Vt + cp2 * 72 + rb8) = (u32x4){vw0[0], vw0[1], vw0[2], vw0[3]}; *(LAS u32x4*)(Vt + (cp2 + 1) * 72 + rb8) = (u32x4){vw1[0], vw1[1], vw1[2], vw1[3]};
        }
        BARRIER();
        if (ci + 1 < SEQ / 64) {
#pragma unroll
            for (int r = 0; r < 8; ++r) { const int ro = HG_ROWOFF(ci + 1, r);
                qraw[r] = __builtin_amdgcn_raw_buffer_load_b32(rsrc, vo, ro + C_RQ * 2, 0); zraw[r] = __builtin_amdgcn_raw_buffer_load_b32(rsrc, vo, ro + fcol * 2, 0); vraw[r] = __builtin_amdgcn_raw_buffer_load_b32(rsrc, vo, ro + C_RI * 2, 0); } }
        HG_T1(12); HG_T0(13);
        if (tid < 128) { const float T0 = Vec[tid], T1 = Vec[128 + tid], T2 = Vec[256 + tid], T3 = Vec[384 + tid];
            Vec[4 * 128 + tid] = T0; Vec[5 * 128 + tid] = T0 * T1; Vec[6 * 128 + tid] = T0 * T1 * T2;
            Vec[7 * 128 + tid] = T1; Vec[8 * 128 + tid] = T2; Vec[9 * 128 + tid] = T1 * T2;
            Vec[10 * 128 + tid] = T1 * T2 * T3; Vec[11 * 128 + tid] = T2 * T3; Vec[12 * 128 + tid] = T3; Vec[13 * 128 + tid] = 1.0f;
            Vec[14 * 128 + tid] = (T0 * T1) * (T2 * T3); }
        BARRIER();
        HG_T1(13); HG_T0(14);
        const int tb = wave & 3, vh = wave >> 2;
        {
            int nb = 1, i0 = 3, j0 = 0, i1 = 0, j1 = 0;
            switch (wave) { case 1: j0 = 1; break; case 2: i0 = 2; break; case 3: nb = 2; i0 = 0; j0 = 0; i1 = 1; j1 = 0; break; case 4: nb = 2; i0 = 1; j0 = 1; i1 = 2; j1 = 1; break;
                            case 5: nb = 2; i0 = 2; j0 = 2; i1 = 3; j1 = 2; break; case 6: j0 = 3; break; case 7: nb = 0; break; default: break; }
            for (int q = 0; q < nb; ++q) { const int bi = q ? i1 : i0, bj = q ? j1 : j0;
                f32x4 acc = (f32x4){0.f, 0.f, 0.f, 0.f};
                const int dsel = (bi - bj < 2) ? -1 : (bi == 2 ? 7 : (bj == 1 ? 8 : 9));
#pragma unroll
                for (int stp = 0; stp < 4; ++stp) { const int k0 = 32 * stp + 8 * lg;
                    bf16x8 a;
                    if (bj == bi) a = *(const LAS bf16x8*)(Qg + (16 * bi + lr) * 136 + k0);
                    else if (dsel < 0) a = *(const LAS bf16x8*)(Qd + (16 * bi + lr) * 136 + k0);
                    else a = scale_frag(*(const LAS u32x4*)(Qd + (16 * bi + lr) * 136 + k0), *(const LAS f32x4*)(Vec + dsel * 128 + k0), *(const LAS f32x4*)(Vec + dsel * 128 + k0 + 4));
                    const bf16x8 bq = *(const LAS bf16x8*)(Ke + (16 * bj + lr) * 136 + k0);
                    acc = __builtin_amdgcn_mfma_f32_16x16x32_bf16(a, bq, acc, 0, 0, 0); }
#pragma unroll
                for (int r = 0; r < 4; ++r) { float v = acc[r]; if (bj == bi && lr > 4 * lg + r) v = 0.f; Sc[(16 * bi + 4 * lg + r) * 72 + 16 * bj + lr] = (bf16_t)(pkbf(v, 0.f) & 0xffffu); } }
            if (wave == 7) {
#pragma unroll
                for (int zb = 0; zb < 6; ++zb) { const int bi = zb < 3 ? 0 : (zb < 5 ? 1 : 2), bj = zb < 3 ? zb + 1 : (zb < 5 ? zb - 1 : 3);
#pragma unroll
                    for (int r = 0; r < 4; ++r) Sc[(16 * bi + 4 * lg + r) * 72 + 16 * bj + lr] = (bf16_t)0; } }
        }
        f32x4 oa[4];
#pragma unroll
        for (int vb = 0; vb < 4; ++vb) oa[vb] = (f32x4){0.f, 0.f, 0.f, 0.f};
#pragma unroll
        for (int stp = 0; stp < 4; ++stp) { const int k0 = 32 * stp + 8 * lg;
            bf16x8 a;
            if (tb == 0) a = *(const LAS bf16x8*)(Qd + lr * 136 + k0);
            else a = scale_frag(*(const LAS u32x4*)(Qd + (16 * tb + lr) * 136 + k0), *(const LAS f32x4*)(Vec + (3 + tb) * 128 + k0), *(const LAS f32x4*)(Vec + (3 + tb) * 128 + k0 + 4));
#pragma unroll
            for (int vb = 0; vb < 4; ++vb) { const bf16x8 bq = *(const LAS bf16x8*)(St + (64 * vh + 16 * vb + lr) * 136 + k0);
                oa[vb] = __builtin_amdgcn_mfma_f32_16x16x32_bf16(a, bq, oa[vb], 0, 0, 0); } }
        BARRIER();
        HG_T1(14); HG_T0(15);
        {
#pragma unroll
            for (int stp = 0; stp < 2; ++stp) { const bf16x8 a = *(const LAS bf16x8*)(Sc + (16 * tb + lr) * 72 + 32 * stp + 8 * lg);
#pragma unroll
                for (int vb = 0; vb < 4; ++vb) { const bf16x8 bq = *(const LAS bf16x8*)(Vt + (64 * vh + 16 * vb + lr) * 72 + 32 * stp + 8 * lg);
                    oa[vb] = __builtin_amdgcn_mfma_f32_16x16x32_bf16(a, bq, oa[vb], 0, 0, 0); } }
            bf16_t* ob = o2 + (size_t)dir * TH * 512;
#pragma unroll
            for (int r = 0; r < 4; ++r) { const int pp_ = ci * 64 + 16 * tb + 4 * lg + r; const size_t tk = tok0 + (size_t)(dir == 0 ? pp_ : (SEQ - 1 - pp_));
#pragma unroll
                for (int vb = 0; vb < 4; ++vb) ob[tk * 512 + h * 128 + 64 * vh + 16 * vb + lr] = (bf16_t)(pkbf(oa[vb][r], 0.f) & 0xffffu); } }
        { const int kb = 16 * wave;
#pragma unroll
            for (int r = 0; r < 4; ++r) { const float dec = Vec[14 * 128 + kb + 4 * lg + r];
#pragma unroll
                for (int vb = 0; vb < 8; ++vb) st[vb][r] *= dec; }
#pragma unroll
            for (int stp = 0; stp < 2; ++stp) { const float fj = Vec[(10 + 2 * stp + (lg >> 1)) * 128 + kb + lr];
                const f32x4 m = (f32x4){fj, fj, fj, fj};
                const bf16x8 a = scale_frag(*(const LAS u32x4*)(KeT + (kb + lr) * 72 + 32 * stp + 8 * lg), m, m);
#pragma unroll
                for (int vb = 0; vb < 8; ++vb) { const bf16x8 bq = *(const LAS bf16x8*)(Vt + (16 * vb + lr) * 72 + 32 * stp + 8 * lg);
                    st[vb] = __builtin_amdgcn_mfma_f32_16x16x32_bf16(a, bq, st[vb], 0, 0, 0); } }
#pragma unroll
            for (int vb = 0; vb < 8; ++vb) { u32x2 w; w.x = pkbf(st[vb][0], st[vb][1]); w.y = pkbf(st[vb][2], st[vb][3]); *(LAS u32x2*)(St + (16 * vb + lr) * 136 + kb + 4 * lg) = w; } }
        BARRIER();
        HG_T1(15);
    }
#undef HG_ROWOFF
}
#define XB_TMO      128
#define XB_XCNT(j)  (256  + 64 * (j))
#define XB_XSUB(j)  (1280 + 64 * (j))
#define XB_XGEN(j)  (2304 + 64 * (j))
#define XB_TOP      3328
#define XB_TOPGEN   3392
#define XCD_BAR_WORDS 3456
#define XB_SPIN_CAP (1u << 22)

__device__ __forceinline__ unsigned xb_ld(unsigned* p)              { return __hip_atomic_load(p, __ATOMIC_RELAXED, __HIP_MEMORY_SCOPE_AGENT); }
__device__ __forceinline__ unsigned xb_add(unsigned* p, unsigned v) { return __hip_atomic_fetch_add(p, v, __ATOMIC_RELAXED, __HIP_MEMORY_SCOPE_AGENT); }
__device__ __forceinline__ unsigned xb_xcc_id() { return (unsigned)__builtin_amdgcn_s_getreg((3 << 11) | 20) & 0xFu; }
#define XB_SPIN(cond, bar) do { unsigned _sp = 0; while (cond) { __builtin_amdgcn_s_sleep(1); \
    if ((++_sp & 255u) == 0u) { if (xb_ld(&(bar)[XB_TMO])) break; if (_sp > XB_SPIN_CAP) { atomicAdd(&(bar)[XB_TMO], 1u); break; } } } } while (0)

struct XcdBarrier {
    unsigned* bar; unsigned x;
    volatile LAS unsigned* st;
};

__device__ __forceinline__ XcdBarrier xcd_barrier_post(unsigned* bar, volatile LAS unsigned* st) {
    XcdBarrier b; b.bar = bar; b.x = xb_xcc_id(); b.st = st;
    if (threadIdx.x == 0) (void)xb_add(&bar[XB_XCNT(b.x)], 1u);
    return b;
}
__device__ __forceinline__ void xcd_barrier_complete(unsigned* bar, unsigned x, unsigned& nloc, unsigned& nx) {
    const unsigned G = gridDim.x * gridDim.y * gridDim.z;
    unsigned sum, cnt, mine, sp = 0u;
    for (;;) {
        sum = 0u; cnt = 0u; mine = 0u;
#pragma unroll
        for (unsigned j = 0; j < 16; ++j) { const unsigned c = xb_ld(&bar[XB_XCNT(j)]); sum += c; cnt += (c > 0u) ? 1u : 0u; mine = (j == x) ? c : mine; }
        if (sum == G) break;
        __builtin_amdgcn_s_sleep(1);
        if ((++sp & 255u) == 0u) { if (xb_ld(&bar[XB_TMO])) break; if (sp > XB_SPIN_CAP) { atomicAdd(&bar[XB_TMO], 1u); break; } }
    }
    nloc = mine > 0u ? mine : 1u; nx = cnt > 0u ? cnt : 1u;
}

__device__ __forceinline__ void xcd_barrier(const XcdBarrier& b) {
    asm volatile("s_waitcnt vmcnt(0)" ::: "memory");
    __syncthreads();
    if (threadIdx.x == 0) {
        unsigned* bar = b.bar;
        __builtin_amdgcn_s_waitcnt(0);
        unsigned nloc = b.st[0], nx = b.st[1];
        if (nloc == 0u) { xcd_barrier_complete(bar, b.x, nloc, nx); b.st[0] = nloc; b.st[1] = nx; }
        const unsigned old = xb_add(&bar[XB_XSUB(b.x)], 1u);
        const unsigned gen = old / nloc;
        if (old + 1u == (gen + 1u) * nloc) {
            __builtin_amdgcn_fence(__ATOMIC_RELEASE, "agent");
            asm volatile("s_waitcnt vmcnt(0)" ::: "memory");
            const unsigned og = xb_add(&bar[XB_TOP], 1u);
            const unsigned tg = og / nx;
            if (og + 1u == (tg + 1u) * nx) xb_add(&bar[XB_TOPGEN], 1u);
            else XB_SPIN(xb_ld(&bar[XB_TOPGEN]) == tg, bar);
            __builtin_amdgcn_fence(__ATOMIC_ACQUIRE, "agent");
            xb_add(&bar[XB_XGEN(b.x)], 1u);
            asm volatile("s_waitcnt vmcnt(0)" ::: "memory");
        } else {
            XB_SPIN(xb_ld(&bar[XB_XGEN(b.x)]) == gen, bar);
            __builtin_amdgcn_fence(__ATOMIC_ACQUIRE, "agent");
            asm volatile("s_waitcnt vmcnt(0)" ::: "memory");
        }
    }
    __syncthreads();
}

constexpr int N_SCAN = HB * 4 * 2;
constexpr int N_ATT = HB * 4 * (SEQ / 128);
constexpr int N_POOLU = (TH / 128) * 4;

#define T_BEGIN(id) do { if (PROBE == (id) && bid == 0 && threadIdx.x == 0) *(LAS unsigned long long*)(lds + LDS_ITEM_OFF + 128) = __builtin_amdgcn_s_memrealtime(); } while (0)
#define T_END(id) do { if (PROBE == (id) && bid == 0 && threadIdx.x == 0) *(LAS unsigned long long*)(lds + LDS_ITEM_OFF + 136) += __builtin_amdgcn_s_memrealtime() - *(LAS unsigned long long*)(lds + LDS_ITEM_OFF + 128); } while (0)
__global__ void __launch_bounds__(NT, 2) mega_fwd(Params p) {
    extern __shared__ __attribute__((aligned(16))) unsigned char smem[];
    cg::grid_group grid = cg::this_grid();
    LAS unsigned char* lds = (LAS unsigned char*)smem;
    const int G = gridDim.x, bid = blockIdx.x, NGW = G * NW;
#define GRID_SYNC_CG() do { asm volatile("s_waitcnt vmcnt(0) lgkmcnt(0)" ::: "memory"); grid.sync(); __builtin_amdgcn_fence(__ATOMIC_ACQUIRE, "agent"); asm volatile("s_waitcnt vmcnt(0)" ::: "memory"); } while (0)
#define GRID_SYNC() xcd_barrier(xbar)
#define OPAQUE_TID() int tid = threadIdx.x; asm volatile("" : "+v"(tid)); const int lane = tid & 63, wave = __builtin_amdgcn_readfirstlane(tid >> 6), gw = bid * NW + wave; (void)lane; (void)gw
    unsigned char* ws = p.ws;
    unsigned* ctl = (unsigned*)(ws + WS_CTL);
    bf16_t* proj = (bf16_t*)(ws + WS_PROJ); bf16_t* hbuf = (bf16_t*)(ws + WS_H); bf16_t* ycat = (bf16_t*)(ws + WS_Y); bf16_t* o2 = (bf16_t*)(ws + WS_O2);
    bf16_t* act = proj;

    { LAS unsigned* stw = (LAS unsigned*)(lds + LDS_ITEM_OFF + 64); if (threadIdx.x < 2) stw[threadIdx.x] = 0u; if (PROBE != 0 && threadIdx.x < 4) stw[16 + threadIdx.x] = 0u; }
    __syncthreads();
    const XcdBarrier xbar = xcd_barrier_post(ctl + 4096, (volatile LAS unsigned*)(lds + LDS_ITEM_OFF + 64));
    T_BEGIN(8);
    { OPAQUE_TID(); p0_prologue(p, lds, gw, NGW, wave, lane); }
    GRID_SYNC_CG();
    T_END(8);

    for (int half = 0; half < NHALF; ++half) {
        const float* xin = p.in[I_X] + (size_t)half * TH * D;
        float* xres = p.out + (size_t)half * TH * D;
        for (int l = 0; l < DEPTH; ++l) {
            unsigned char* wl = ws + WS_W + (size_t)l * W_LAYER;
            const float* xcur = (l == 0) ? xin : xres;
            T_BEGIN(7);
            { OPAQUE_TID(); norm_rows_bf16(xcur, p.in[I_N1G] + l * D, hbuf, TH, gw, NGW, lane); }
            GRID_SYNC();
            T_END(7);
            if (PROBE == 11) { T_BEGIN(11); GRID_SYNC(); T_END(11); }
            T_BEGIN(2);
            { pg8::Gemm g{hbuf, (const bf16_t*)(wl + WO_IN), TH, NPROJ, D}; pg8::StaticOrder S; S.init(TH, NPROJ, G, bid);
              pg8::EpiStore E{proj, INC, (bf16_t*)(ws + WS_GATE), INC / 256};
              pg8::gemm_phase<pg8::EpiStore, pg8::StaticOrder, true, true>(lds, g, S, E); }
            GRID_SYNC();
            T_END(2);
            T_BEGIN(1);
            {
                OPAQUE_TID();
                T_BEGIN(9); T_BEGIN(10);
                for (int u = bid; u < N_SCAN; u += G) hgrn_unit(lds, proj, p.in[I_HLB], l, o2, u, tid);
                T_END(9);
                unsigned* ctr = ctl + 64 * (1 + half * DEPTH + l);
                LAS unsigned* item_w = (LAS unsigned*)(lds + LDS_ITEM_OFF);
                for (;;) {
                    if (tid == 0) *item_w = atomicAdd(ctr, 1u);
                    BARRIER();
                    const int item = (int)*item_w;
                    BARRIER();
                    if (item >= N_ATT + N_POOLU) break;
                    asm volatile("" : "+v"(tid));
                    if (item < N_ATT) attn_unit(lds, proj, p.in[I_LQ1] + l * 64, p.in[I_LK1] + l * 64, p.in[I_LQ2] + l * 64, p.in[I_LK2] + l * 64, p.in[I_DNG] + l * 128, l, ycat + (size_t)TH * 512, item, tid);
                    else pool_unit(lds, proj, (const bf16_t*)(wl + WO_POOL), p.in[I_POOLS] + l * 512, ycat, item - N_ATT, tid);
                }
                T_END(10);
            }
            GRID_SYNC();
            T_END(1);
            T_BEGIN(7);
            { OPAQUE_TID(); hgrn_combine(o2, o2 + (size_t)TH * 512, proj, p.in[I_HNG] + l * 128, ycat + (size_t)2 * TH * 512, gw, NGW, lane); }
            GRID_SYNC();
            T_END(7);
            T_BEGIN(3);
            { pg8::Gemm g{ycat, (const bf16_t*)(wl + WO_UP), 3 * TH, 3 * D, 512}; pg8::MergeOrder S; S.init(TH, G, bid);
              pg8::EpiMerge2 E{(const bf16_t*)(ws + WS_GATE), hbuf, TH / 256};
              pg8::gemm_phase<pg8::EpiMerge2, pg8::MergeOrder, true, true>(lds, g, S, E); }
            GRID_SYNC();
            T_END(3);
            T_BEGIN(4);
            { pg8::Gemm g{hbuf, (const bf16_t*)(wl + WO_OUT), TH, D, D}; pg8::StaticOrder S; S.init(TH, D, G, bid);
              pg8::EpiResid E{xcur, xres, D};
              pg8::gemm_phase<pg8::EpiResid, pg8::StaticOrder, true, true>(lds, g, S, E); }
            GRID_SYNC();
            T_END(4);
            T_BEGIN(7);
            { OPAQUE_TID(); norm_rows_bf16(xres, p.in[I_N2G] + l * D, hbuf, TH, gw, NGW, lane); }
            GRID_SYNC();
            T_END(7);
            T_BEGIN(5);
            { pg8::Gemm g{hbuf, (const bf16_t*)(wl + WO_FFI), TH, 2 * FF, D}; pg8::StaticOrder S; S.init(TH, 2 * FF, G, bid);
              pg8::EpiSwiGLU E{act, FF};
              pg8::gemm_phase<pg8::EpiSwiGLU, pg8::StaticOrder, true, true>(lds, g, S, E); }
            GRID_SYNC();
            T_END(5);
            T_BEGIN(6);
            { pg8::Gemm g{act, (const bf16_t*)(wl + WO_FFO), TH, D, FF}; pg8::StaticOrder S; S.init(TH, D, G, bid);
              pg8::EpiResid E{xres, xres, D};
              pg8::gemm_phase<pg8::EpiResid, pg8::StaticOrder, true, true>(lds, g, S, E); }
            GRID_SYNC();
            T_END(6);
        }
    }
    int probe_rows = 0;
    if (PROBE != 0) { if (bid == 0 && threadIdx.x == 0) ctl[2048] = (unsigned)(*(LAS unsigned long long*)(lds + LDS_ITEM_OFF + 136) >> 8); GRID_SYNC(); probe_rows = (int)ctl[2048]; }
    { OPAQUE_TID(); norm_rows_f32_inplace(p.out, p.in[I_FNG], NHALF * TH, gw, NGW, lane, probe_rows); }
}

extern "C" void kernel_launch(void* const* d_in, const int* in_sizes, int n_in, void* d_out, int out_size, void* d_ws, size_t ws_size, hipStream_t stream) {
    static int grid = 0;
    if (grid == 0) {
        if (n_in != 20 || in_sizes[0] != NHALF * TH * D || out_size != NHALF * TH * D || ws_size < WS_END) {
            fprintf(stderr, "kernel_launch: unexpected shapes (n_in %d, in0 %d, out %d, ws %zu); nothing launched\n", n_in, n_in > 0 ? in_sizes[0] : -1, out_size, ws_size); grid = -1; return; }
        int dev = 0, cus = 0, per_cu = 0;
        if (hipGetDevice(&dev) != hipSuccess || hipDeviceGetAttribute(&cus, hipDeviceAttributeMultiprocessorCount, dev) != hipSuccess) { grid = -1; return; }
        if (hipFuncSetAttribute((const void*)mega_fwd, hipFuncAttributeMaxDynamicSharedMemorySize, LDS_BYTES) != hipSuccess) { fprintf(stderr, "kernel_launch: hipFuncSetAttribute failed\n"); grid = -1; return; }
        if (hipOccupancyMaxActiveBlocksPerMultiprocessor(&per_cu, (const void*)mega_fwd, NT, LDS_BYTES) != hipSuccess || per_cu < 1) { fprintf(stderr, "kernel_launch: occupancy query says %d\n", per_cu); per_cu = 1; }
        (void)hipGetLastError();
        grid = cus * 1;
    }
    if (grid < 0) return;
    (void)hipMemsetAsync((char*)d_ws + WS_CTL, 0, CTL_BYTES, stream);
    Params prm{};
    for (int i = 0; i < 20; ++i) prm.in[i] = (const float*)d_in[i];
    prm.out = (float*)d_out; prm.ws = (unsigned char*)d_ws;
    void* args[] = {&prm};
    hipError_t e = hipLaunchCooperativeKernel((const void*)mega_fwd, dim3(grid), dim3(NT), args, LDS_BYTES, stream);
    if (e != hipSuccess) fprintf(stderr, "cooperative launch failed: %s (grid %d)\n", hipGetErrorString(e), grid);
}
```

```cpp
#include <hip/hip_runtime.h>
#include <hip/hip_cooperative_groups.h>
#include <cstdio>
#include <cstdint>
namespace cg = cooperative_groups;
namespace pg8 {
#define PG8_LAS __attribute__((address_space(3)))
typedef unsigned short bf16_t;
typedef short bf16x8 __attribute__((ext_vector_type(8)));
typedef float f32x4 __attribute__((ext_vector_type(4)));
typedef unsigned u32x4 __attribute__((ext_vector_type(4)));
constexpr int BM = 256, BK = 64, HALF = 128, HTB = HALF * BK * 2  , STAGE_BYTES = 8 * HTB, NXCD = 8, WGM = 8;

__host__ __device__ __forceinline__ int lds_byte(int r, int c) { const int st = (r >> 4) * 2 + (c >> 5), rr = r & 15, cc = c & 31, ob = rr * 64 + cc * 2; return st * 1024 + (ob ^ (((ob >> 9) & 1) << 5)); }
__host__ __device__ __forceinline__ void stage_rc(int b, int& R, int& C) { const int st = b / 1024, sb = b % 1024, swz = sb ^ (((sb >> 9) & 1) << 5); R = (st >> 1) * 16 + swz / 64; C = (st & 1) * 32 + (swz % 64) / 2; }
__host__ __device__ __forceinline__ int perm32(int rho) { const int n = rho >> 4, i = rho & 15; return 8 * (i >> 2) + 4 * n + (i & 3); }

struct Unit { int pm, pn; };
struct Gemm { const bf16_t* A; const bf16_t* Bt; int M, N, K; };

struct StaticOrder {
    int nM, nN, nwg, G, c;
    __host__ __device__ void init(int M, int N, int G_, int c_) { nM = M / BM; nN = N / BM; nwg = nM * nN; G = G_; c = c_; }
    __host__ __device__ bool next(int i, Unit& u) const {
        const long L = (long)i * G + c; if (L >= nwg) return false;
        int wgid = (int)L; { const int q = nwg / NXCD, r = nwg % NXCD, xcd = wgid % NXCD, off = wgid / NXCD; wgid = (xcd < r ? xcd * (q + 1) : r * (q + 1) + (xcd - r) * q) + off; }
        const int nig = WGM * nN, gid = wgid / nig, fm = gid * WGM, gsz = (nM - fm) < WGM ? (nM - fm) : WGM;
        u.pm = fm + ((wgid % nig) % gsz); u.pn = (wgid % nig) / gsz; return true;
    }
    __device__ __forceinline__ void a_ready(const Unit&) const {}
    __device__ __forceinline__ void done(const Unit&) const {}
};

typedef float f32x2c_ __attribute__((ext_vector_type(2)));
typedef __bf16 bf16x2c_ __attribute__((ext_vector_type(2)));
__device__ __forceinline__ unsigned cvt_pk_bf16(float lo, float hi) { const f32x2c_ v = {lo, hi}; const bf16x2c_ b = __builtin_convertvector(v, bf16x2c_); return __builtin_bit_cast(unsigned, b); }
typedef float f32x2 __attribute__((ext_vector_type(2)));
__device__ __forceinline__ float fast_sigmoid(float x) { return __builtin_amdgcn_rcpf(1.0f + __expf(-x)); }
typedef unsigned u32x2v __attribute__((ext_vector_type(2)));
struct EpiStore {
    static constexpr bool PERM = true, AFTER_DRAIN = false, KEEP = false;
    bf16_t* O; int ldc; bf16_t* G; int nrm;
    __device__ __forceinline__ void operator()(const f32x4 (&acc)[2][2][4][2], const Unit& u, int wr, int wc, int fr, int fq) const {
        const int row0 = u.pm * BM + wr * 64 + fr; const int col0 = u.pn * BM + wc * 32 + 8 * fq;
        const bool dump = u.pn >= nrm;
        bf16_t* gt = G + ((size_t)(u.pm * 12 + (u.pn - nrm)) << 16) + (wr * 4 + wc) * 512 + (fq * 16 + fr) * 8;
#pragma unroll
        for (int ai = 0; ai < 2; ++ai)
#pragma unroll
            for (int m = 0; m < 4; ++m) { bf16_t* rowp = O + (size_t)(row0 + ai * HALF + m * 16) * ldc + col0;
#pragma unroll
                for (int bj = 0; bj < 2; ++bj) { const f32x4 v0 = acc[ai][bj][m][0], v1 = acc[ai][bj][m][1];
                    u32x4 w; w.x = cvt_pk_bf16(v0[0], v0[1]); w.y = cvt_pk_bf16(v0[2], v0[3]); w.z = cvt_pk_bf16(v1[0], v1[1]); w.w = cvt_pk_bf16(v1[2], v1[3]);
                    if (dump) *(u32x4*)(gt + ((ai * 4 + m) * 2 + bj) * 4096) = w; else *(u32x4*)(rowp + bj * HALF) = w; } }
    }
};
struct EpiMerge {
    static constexpr bool PERM = true, AFTER_DRAIN = false, KEEP = false;
    bf16_t* proj; int ldp; int gate_col0; bf16_t* merged; int MT;
    __device__ __forceinline__ void operator()(const f32x4 (&acc)[2][2][4][2], const Unit& u, int wr, int wc, int fr, int fq) const {
        const int br = u.pm / MT, pmt = u.pm - br * MT, pnt = u.pn & 3;
        const int row0 = pmt * BM + wr * 64 + fr; const int col0 = pnt * BM + wc * 32 + 8 * fq;
#pragma unroll
        for (int ai = 0; ai < 2; ++ai)
#pragma unroll
            for (int mp = 0; mp < 2; ++mp) {
                u32x4 gw[2][2]; f32x4 p0[2][2], p1[2][2];
#pragma unroll
                for (int mm = 0; mm < 2; ++mm)
#pragma unroll
                    for (int bj = 0; bj < 2; ++bj) { const size_t row = (size_t)(row0 + ai * HALF + (2 * mp + mm) * 16); bf16_t* prow = proj + row * ldp; const int col = col0 + bj * HALF;
                        gw[mm][bj] = *(const u32x4*)(prow + gate_col0 + br * 1024 + col);
                        if (br > 0) { const float* part = (const float*)prow + col; p0[mm][bj] = *(const f32x4*)part; p1[mm][bj] = *(const f32x4*)(part + 4); }
                        else { p0[mm][bj] = (f32x4){0.f, 0.f, 0.f, 0.f}; p1[mm][bj] = (f32x4){0.f, 0.f, 0.f, 0.f}; } }
#pragma unroll
                for (int mm = 0; mm < 2; ++mm)
#pragma unroll
                    for (int bj = 0; bj < 2; ++bj) { const int m = 2 * mp + mm; const size_t row = (size_t)(row0 + ai * HALF + m * 16); bf16_t* prow = proj + row * ldp; const int col = col0 + bj * HALF;
                        const u32x4 g = gw[mm][bj]; f32x4 g0, g1;
                        g0[0] = fast_sigmoid(__uint_as_float(g.x << 16)); g0[1] = fast_sigmoid(__uint_as_float(g.x & 0xffff0000u));
                        g0[2] = fast_sigmoid(__uint_as_float(g.y << 16)); g0[3] = fast_sigmoid(__uint_as_float(g.y & 0xffff0000u));
                        g1[0] = fast_sigmoid(__uint_as_float(g.z << 16)); g1[1] = fast_sigmoid(__uint_as_float(g.z & 0xffff0000u));
                        g1[2] = fast_sigmoid(__uint_as_float(g.w << 16)); g1[3] = fast_sigmoid(__uint_as_float(g.w & 0xffff0000u));
                        const f32x4 v0 = g0 * acc[ai][bj][m][0] + p0[mm][bj], v1 = g1 * acc[ai][bj][m][1] + p1[mm][bj];
                        if (br < 2) { float* part = (float*)prow + col; *(f32x4*)part = v0; *(f32x4*)(part + 4) = v1; }
                        else { u32x4 w; w.x = cvt_pk_bf16(v0[0], v0[1]); w.y = cvt_pk_bf16(v0[2], v0[3]); w.z = cvt_pk_bf16(v1[0], v1[1]); w.w = cvt_pk_bf16(v1[2], v1[3]);
                            *(u32x4*)(merged + row * 1024 + col) = w; } }
            }
    }
};
struct EpiMerge2 {
    static constexpr bool PERM = true, AFTER_DRAIN = false, KEEP = true;
    const bf16_t* G; bf16_t* merged; int MT;
    static __device__ __forceinline__ float epos(unsigned bits) { return 1.0f + __expf(-fminf(fmaxf(__uint_as_float(bits), -30.0f), 30.0f)); }
    __device__ __forceinline__ bool apply(f32x4 (&acc)[2][2][4][2], const Unit& u, int wr, int wc, int fr, int fq) const {
        const int br = u.pm / MT, pmt = u.pm - br * MT, pnt = u.pn & 3;
        const int row0 = pmt * BM + wr * 64 + fr; const int col0 = pnt * BM + wc * 32 + 8 * fq;
        const bf16_t* gt = G + ((size_t)(pmt * 12 + br * 4 + pnt) << 16) + (wr * 4 + wc) * 512 + (fq * 16 + fr) * 8;
#pragma unroll
        for (int ai = 0; ai < 2; ++ai)
#pragma unroll
            for (int m = 0; m < 4; ++m) { const size_t row = (size_t)(row0 + ai * HALF + m * 16);
#pragma unroll
                for (int bj = 0; bj < 2; ++bj) { const int col = col0 + bj * HALF; const bf16_t* gp = gt + ((ai * 4 + m) * 2 + bj) * 4096;
                    const u32x4 ga = *(const u32x4*)gp;
                    float f[8];
                    if (br < 2) { const u32x4 gb = *(const u32x4*)(gp + (4 << 16));
#pragma unroll
                        for (int e = 0; e < 4; ++e) { f[2 * e] = epos(gb[e] << 16) * __builtin_amdgcn_rcpf(epos(ga[e] << 16)); f[2 * e + 1] = epos(gb[e] & 0xffff0000u) * __builtin_amdgcn_rcpf(epos(ga[e] & 0xffff0000u)); }
                    } else {
#pragma unroll
                        for (int e = 0; e < 4; ++e) { f[2 * e] = __builtin_amdgcn_rcpf(epos(ga[e] << 16)); f[2 * e + 1] = __builtin_amdgcn_rcpf(epos(ga[e] & 0xffff0000u)); }
                    }
                    f32x4 v0 = acc[ai][bj][m][0], v1 = acc[ai][bj][m][1];
                    v0[0] *= f[0]; v0[1] *= f[1]; v0[2] *= f[2]; v0[3] *= f[3]; v1[0] *= f[4]; v1[1] *= f[5]; v1[2] *= f[6]; v1[3] *= f[7];
                    if (br < 2) { acc[ai][bj][m][0] = v0; acc[ai][bj][m][1] = v1; }
                    else { u32x4 w; w.x = cvt_pk_bf16(v0[0], v0[1]); w.y = cvt_pk_bf16(v0[2], v0[3]); w.z = cvt_pk_bf16(v1[0], v1[1]); w.w = cvt_pk_bf16(v1[2], v1[3]);
                        *(u32x4*)(merged + row * 1024 + col) = w; } } }
        return br < 2;
    }
};
struct EpiResid {
    static constexpr bool PERM = false, AFTER_DRAIN = false, KEEP = false;
    const float* base; float* out; int ldc;
    __device__ __forceinline__ void operator()(const f32x4 (&acc)[2][2][4][2], const Unit& u, int wr, int wc, int fr, int fq) const {
        const int row0 = u.pm * BM + wr * 64 + fr; const int col0 = u.pn * BM + wc * 32 + 4 * fq;
#pragma unroll
        for (int ai = 0; ai < 2; ++ai) {
            f32x4 bs[4][2][2];
#pragma unroll
            for (int m = 0; m < 4; ++m) { const size_t off = (size_t)(row0 + ai * HALF + m * 16) * ldc + col0;
#pragma unroll
                for (int bj = 0; bj < 2; ++bj)
#pragma unroll
                    for (int n = 0; n < 2; ++n) bs[m][bj][n] = *(const f32x4*)(base + off + bj * HALF + n * 16); }
#pragma unroll
            for (int m = 0; m < 4; ++m) { const size_t off = (size_t)(row0 + ai * HALF + m * 16) * ldc + col0;
#pragma unroll
                for (int bj = 0; bj < 2; ++bj)
#pragma unroll
                    for (int n = 0; n < 2; ++n) *(f32x4*)(out + off + bj * HALF + n * 16) = bs[m][bj][n] + acc[ai][bj][m][n]; }
        }
    }
};
struct EpiSwiGLU {
    static constexpr bool PERM = true, AFTER_DRAIN = false, KEEP = false;
    bf16_t* O; int ldc;
    __device__ __forceinline__ void operator()(const f32x4 (&acc)[2][2][4][2], const Unit& u, int wr, int wc, int fr, int fq) const {
        const int row0 = u.pm * BM + wr * 64 + fr; const int col0 = u.pn * HALF + wc * 32 + 8 * fq;
#pragma unroll
        for (int ai = 0; ai < 2; ++ai)
#pragma unroll
            for (int m = 0; m < 4; ++m) { bf16_t* rowp = O + (size_t)(row0 + ai * HALF + m * 16) * ldc + col0;
                f32x4 r0, r1;
#pragma unroll
                for (int e = 0; e < 4; ++e) { const float ga = acc[ai][0][m][0][e], gb = acc[ai][0][m][1][e];
                    r0[e] = ga * fast_sigmoid(ga) * acc[ai][1][m][0][e]; r1[e] = gb * fast_sigmoid(gb) * acc[ai][1][m][1][e]; }
                u32x4 w; w.x = cvt_pk_bf16(r0[0], r0[1]); w.y = cvt_pk_bf16(r0[2], r0[3]); w.z = cvt_pk_bf16(r1[0], r1[1]); w.w = cvt_pk_bf16(r1[2], r1[3]);
                *(u32x4*)rowp = w; }
    }
};
struct GroupOrder {
    int nwg, gs, c;
    __device__ void init(int N, int gs_, int c_) { nwg = 8 * (N / BM); gs = gs_; c = c_; }
    __device__ bool next(int i, Unit& u) const { const int L = i * gs + c; if (L >= nwg) return false; u.pm = L & 7; u.pn = L >> 3; return true; }
    __device__ __forceinline__ void a_ready(const Unit&) const {}
    __device__ __forceinline__ void done(const Unit&) const {}
};
struct MergeOrder {
    GroupOrder S; int MT;
    __device__ void init(int gs_, int c_) { S.init(1024, gs_, c_); MT = 8; }
    __device__ bool next(int i, Unit& u) const { const int t = i / 3, br = i - 3 * t; Unit b; if (!S.next(t, b)) return false; u.pm = br * MT + b.pm; u.pn = br * 4 + b.pn; return true; }
    __device__ __forceinline__ void a_ready(const Unit&) const {}
    __device__ __forceinline__ void done(const Unit&) const {}
};

template <class Epi, class Sched, bool ALIGN_EPI = false, bool SP2 = false>
__device__ __forceinline__ void gemm_phase(PG8_LAS unsigned char* lds, const Gemm g, const Sched& S, const Epi& E) {
    int tid_ = threadIdx.x; asm volatile("" : "+v"(tid_));
    const int tid = tid_, wid = __builtin_amdgcn_readfirstlane(tid >> 6), lane = tid & 63, wr = wid >> 2, wc = wid & 3, fr = lane & 15, fq = lane >> 4;
    const int K = g.K, nt = K / BK;
    unsigned voffA[2], voffB[2];
#pragma unroll
    for (int i = 0; i < 2; ++i) { int R, C; stage_rc(tid * 16 + i * 8192, R, C); const int Rb = Epi::PERM ? ((R & ~31) + perm32(R & 31)) : R;
        voffA[i] = (unsigned)(R * K + C) * 2u; voffB[i] = (unsigned)(Rb * K + C) * 2u; }
    const size_t kstep = (size_t)(BK * 2);
    const size_t hstep = (size_t)HALF * K * 2;
    const size_t tstep = 2 * hstep;
    const unsigned ldsw = (unsigned)wid * 1024u;
    const int aoff = lds_byte(wr * 64 + fr, fq * 8), boff = lds_byte(wc * 32 + fr, fq * 8);
#define PG8_SA(b, h) (((b) * 2 + (h)) * HTB)
#define PG8_SB(b, h) ((4 + (b) * 2 + (h)) * HTB)
#define PG8_STAGE(bufoff, gbase, voff) do { _Pragma("unroll") for (int _i = 0; _i < 2; ++_i) \
        __builtin_amdgcn_global_load_lds((const unsigned*)((const char*)(gbase) + (voff)[_i]), (PG8_LAS unsigned*)(lds + (bufoff) + ldsw + _i * 8192), 16, 0, 0); } while (0)
#define PG8_LDA(dst, b, h) do { _Pragma("unroll") for (int m = 0; m < 4; ++m) _Pragma("unroll") for (int k = 0; k < 2; ++k) dst[m][k] = *(const PG8_LAS bf16x8*)(lds + PG8_SA(b, h) + aoff + m * 2048 + k * 1024); } while (0)
#define PG8_LDB(dst, b, h) do { _Pragma("unroll") for (int n = 0; n < 2; ++n) _Pragma("unroll") for (int k = 0; k < 2; ++k) dst[n][k] = *(const PG8_LAS bf16x8*)(lds + PG8_SB(b, h) + boff + n * 2048 + k * 1024); } while (0)
#define PG8_MMA(ai, bj, At, Bt) do { __builtin_amdgcn_s_setprio(1); _Pragma("unroll") for (int m = 0; m < 4; ++m) _Pragma("unroll") for (int n = 0; n < 2; ++n) _Pragma("unroll") for (int k = 0; k < 2; ++k) \
        acc[ai][bj][m][n] = __builtin_amdgcn_mfma_f32_16x16x32_bf16(Bt[n][k], At[m][k], acc[ai][bj][m][n], 0, 0, 0); __builtin_amdgcn_s_setprio(0); } while (0)
#define PG8_WAIT_V(n) asm volatile("s_waitcnt vmcnt(" #n ")" ::: "memory")
#define PG8_WAIT_L(n) asm volatile("s_waitcnt lgkmcnt(" #n ")" ::: "memory")
#define PG8_BAR __builtin_amdgcn_s_barrier()
#define PG8_SCHED __builtin_amdgcn_sched_barrier(0)
    Unit cur, nxt; int ui = 0;
    if (!S.next(0, cur)) return;
    f32x4 acc[2][2][4][2];
#pragma unroll
    for (int a = 0; a < 2; ++a)
#pragma unroll
        for (int b = 0; b < 2; ++b)
#pragma unroll
            for (int m = 0; m < 4; ++m)
#pragma unroll
                for (int n = 0; n < 2; ++n) acc[a][b][m][n] = (f32x4){0.f, 0.f, 0.f, 0.f};
    bf16x8 At[4][2], B0[2][2], B1[2][2];
    const char* cA = (const char*)g.A + (size_t)cur.pm * tstep; const char* cB = (const char*)g.Bt + (size_t)cur.pn * tstep;
    S.a_ready(cur);
    if constexpr (SP2) {
        PG8_STAGE(PG8_SB(0, 0), cB, voffB); PG8_STAGE(PG8_SB(0, 1), cB + hstep, voffB); PG8_STAGE(PG8_SA(0, 0), cA, voffA); PG8_STAGE(PG8_SA(0, 1), cA + hstep, voffA);
        if (wr == 1) PG8_BAR;
        PG8_WAIT_V(2); PG8_BAR;
        PG8_STAGE(PG8_SB(1, 0), cB + kstep, voffB); PG8_STAGE(PG8_SA(1, 0), cA + kstep, voffA); PG8_STAGE(PG8_SB(1, 1), cB + hstep + kstep, voffB);
        PG8_WAIT_V(6); PG8_BAR;
    } else {
        PG8_STAGE(PG8_SB(0, 0), cB, voffB); PG8_STAGE(PG8_SA(0, 0), cA, voffA); PG8_STAGE(PG8_SB(0, 1), cB + hstep, voffB); PG8_STAGE(PG8_SA(0, 1), cA + hstep, voffA);
        if (wr == 1) PG8_BAR;
        PG8_WAIT_V(4); PG8_BAR;
        PG8_STAGE(PG8_SB(1, 0), cB + kstep, voffB); PG8_STAGE(PG8_SA(1, 0), cA + kstep, voffA); PG8_STAGE(PG8_SB(1, 1), cB + hstep + kstep, voffB);
        PG8_WAIT_V(6); PG8_BAR;
    }
    for (;;) {
        const bool has_next = S.next(ui + 1, nxt);
        const char* nA = has_next ? (const char*)g.A + (size_t)nxt.pm * tstep : cA; const char* nB = has_next ? (const char*)g.Bt + (size_t)nxt.pn * tstep : cB;
        for (int t = 0; t < nt; t += 2) {
            const bool last = (t == nt - 2);
            const char* a1 = cA + (size_t)(t + 1) * kstep;
            const char* a2 = last ? nA : cA + (size_t)(t + 2) * kstep; const char* b2 = last ? nB : cB + (size_t)(t + 2) * kstep;
            const char* a3 = a2 + kstep; const char* b3 = b2 + kstep;
            if (last && has_next) S.a_ready(nxt);
            if constexpr (SP2) {
            PG8_LDB(B0, 0, 0); PG8_LDB(B1, 0, 1); PG8_SCHED; PG8_LDA(At, 0, 0); PG8_STAGE(PG8_SA(1, 1), a1 + hstep, voffA);
            PG8_WAIT_V(8); PG8_WAIT_L(0); PG8_BAR; PG8_MMA(0, 0, At, B0); PG8_MMA(0, 1, At, B1); PG8_BAR; PG8_SCHED;
            PG8_LDA(At, 0, 1); PG8_STAGE(PG8_SB(0, 0), b2, voffB); PG8_STAGE(PG8_SB(0, 1), b2 + hstep, voffB); PG8_STAGE(PG8_SA(0, 0), a2, voffA);
            PG8_WAIT_V(8); PG8_WAIT_L(0); PG8_BAR; PG8_MMA(1, 0, At, B0); PG8_MMA(1, 1, At, B1); PG8_BAR; PG8_SCHED;
            PG8_LDB(B0, 1, 0); PG8_LDB(B1, 1, 1); PG8_SCHED; PG8_LDA(At, 1, 0); PG8_STAGE(PG8_SA(0, 1), a2 + hstep, voffA);
            PG8_WAIT_V(8); PG8_WAIT_L(0); PG8_BAR; PG8_MMA(0, 0, At, B0); PG8_MMA(0, 1, At, B1); PG8_BAR; PG8_SCHED;
            PG8_LDA(At, 1, 1); PG8_STAGE(PG8_SB(1, 0), b3, voffB); PG8_STAGE(PG8_SB(1, 1), b3 + hstep, voffB); PG8_STAGE(PG8_SA(1, 0), a3, voffA);
            PG8_WAIT_V(8); PG8_WAIT_L(0); PG8_BAR; PG8_MMA(1, 0, At, B0); PG8_MMA(1, 1, At, B1); PG8_BAR; PG8_SCHED;
            } else {
            PG8_LDB(B0, 0, 0); PG8_SCHED; PG8_LDA(At, 0, 0); PG8_STAGE(PG8_SA(1, 1), a1 + hstep, voffA);
            PG8_WAIT_L(8); PG8_BAR; PG8_WAIT_L(0); PG8_MMA(0, 0, At, B0); PG8_BAR; PG8_SCHED;
            PG8_LDB(B1, 0, 1); PG8_STAGE(PG8_SB(0, 0), b2, voffB);
            PG8_BAR; PG8_WAIT_L(0); PG8_MMA(0, 1, At, B1); PG8_BAR;
            PG8_LDA(At, 0, 1); PG8_STAGE(PG8_SA(0, 0), a2, voffA);
            PG8_BAR; PG8_WAIT_L(0); PG8_MMA(1, 0, At, B0); PG8_BAR; PG8_SCHED;
            PG8_STAGE(PG8_SB(0, 1), b2 + hstep, voffB);
            PG8_WAIT_V(6); PG8_BAR; PG8_MMA(1, 1, At, B1); PG8_BAR;
            PG8_LDB(B0, 1, 0); PG8_SCHED; PG8_LDA(At, 1, 0); PG8_STAGE(PG8_SA(0, 1), a2 + hstep, voffA);
            PG8_WAIT_L(8); PG8_BAR; PG8_WAIT_L(0); PG8_MMA(0, 0, At, B0); PG8_BAR; PG8_SCHED;
            PG8_LDB(B1, 1, 1); PG8_STAGE(PG8_SB(1, 0), b3, voffB);
            PG8_BAR; PG8_WAIT_L(0); PG8_MMA(0, 1, At, B1); PG8_BAR;
            PG8_LDA(At, 1, 1); PG8_STAGE(PG8_SA(1, 0), a3, voffA);
            PG8_BAR; PG8_WAIT_L(0); PG8_MMA(1, 0, At, B0); PG8_BAR; PG8_SCHED;
            PG8_STAGE(PG8_SB(1, 1), b3 + hstep, voffB);
            PG8_WAIT_V(6); PG8_BAR; PG8_MMA(1, 1, At, B1); PG8_BAR;
            }
        }
        if constexpr (ALIGN_EPI) { if (wr == 0) PG8_BAR; }
        bool keep_acc = false;
        if constexpr (!Epi::AFTER_DRAIN) { if constexpr (Epi::KEEP) keep_acc = E.apply(acc, cur, wr, wc, fr, fq); else E(acc, cur, wr, wc, fr, fq); S.done(cur); }
        if (!has_next) break;
        if (!keep_acc) {
#pragma unroll
        for (int a = 0; a < 2; ++a)
#pragma unroll
            for (int b = 0; b < 2; ++b)
#pragma unroll
                for (int m = 0; m < 4; ++m)
#pragma unroll
                    for (int n = 0; n < 2; ++n) acc[a][b][m][n] = (f32x4){0.f, 0.f, 0.f, 0.f};
        }
        cur = nxt; cA = nA; cB = nB; ++ui;
        if constexpr (ALIGN_EPI) { if (wr == 1) PG8_BAR; }
    }
    PG8_WAIT_V(0);
    if constexpr (!ALIGN_EPI) { if (wr == 0) PG8_BAR; }
    PG8_BAR;
    if constexpr (Epi::AFTER_DRAIN) { E.fused(acc, cur, wr, wc, fr, fq, lds, wid, lane); S.done(cur); }
#undef PG8_SA
#undef PG8_SB
#undef PG8_STAGE
#undef PG8_LDA
#undef PG8_LDB
#undef PG8_MMA
#undef PG8_WAIT_V
#undef PG8_WAIT_L
#undef PG8_BAR
#undef PG8_SCHED
}
}

#define LAS __attribute__((address_space(3)))
typedef unsigned short bf16_t;
typedef short bf16x8 __attribute__((ext_vector_type(8)));
typedef float f32x4 __attribute__((ext_vector_type(4)));
typedef float f32x16 __attribute__((ext_vector_type(16)));
typedef unsigned u32x4 __attribute__((ext_vector_type(4)));
typedef unsigned u32x2 __attribute__((ext_vector_type(2)));

constexpr int D = 1024, SEQ = 2048, DEPTH = 4, NHALF = 2, HB = 1, TH = HB * SEQ, NGRP = 8;
constexpr int INC = 4608, NPROJ = 7680, FF = 2816;
constexpr int C_POOL = 0, C_AQ = 512, C_AK = 1024, C_AV = 1536, C_RQ = 2048, C_RF = 2560, C_RB = 3072, C_RI = 3584, C_RG = 4096, C_GATE = 4608;
constexpr float EPS = 1e-6f;
constexpr int NT = 512, NW = 8;
constexpr int LDS_BYTES = 155648;
constexpr int LDS_ITEM_OFF = 155136;

constexpr size_t MiB = 1u << 20;
constexpr size_t WS_CTL = 0, CTL_BYTES = 163840;
constexpr size_t WS_W = 2 * MiB, W_LAYER = 37 * MiB;
constexpr size_t WO_IN = 0, WO_POOL = (size_t)NPROJ * D * 2, WO_UP = WO_POOL + 4 * 128 * 128 * 2, WO_OUT = WO_UP + (size_t)3 * D * 512 * 2,
                 WO_FFI = WO_OUT + (size_t)D * D * 2, WO_FFO = WO_FFI + (size_t)2 * FF * D * 2, WO_END = WO_FFO + (size_t)D * FF * 2;
static_assert(WO_END <= W_LAYER, "weights per layer");
constexpr size_t WS_ARENA = 150 * MiB, ARENA = 44 * MiB;
constexpr size_t WS_PROJ = 0;
constexpr size_t WS_GATE = 18 * MiB;
constexpr size_t WS_H = 30 * MiB;
constexpr size_t WS_Y = 34 * MiB;
constexpr size_t WS_O2 = 40 * MiB;
constexpr size_t WS_END = WS_ARENA + NGRP * ARENA;
static_assert(WS_W + DEPTH * W_LAYER <= WS_ARENA && WS_PROJ + (size_t)TH * INC * 2 <= WS_GATE && WS_GATE + (size_t)TH * 3072 * 2 <= WS_H && WS_H + (size_t)TH * D * 2 <= WS_Y && WS_Y + (size_t)3 * TH * 512 * 2 <= WS_O2 && WS_O2 + (size_t)2 * TH * 512 * 2 <= ARENA && WS_END <= 512 * MiB, "ws map");

struct Params { const float* in[20]; float* out; unsigned char* ws; };
enum { I_X = 0, I_N1G, I_WIN, I_POOLW, I_POOLS, I_LQ1, I_LK1, I_LQ2, I_LK2, I_DNG, I_HLB, I_HNG, I_WUP, I_WUA, I_WUR, I_WOUT, I_N2G, I_WFI, I_WFO, I_FNG };

typedef float f32x2c __attribute__((ext_vector_type(2)));
typedef __bf16 bf16x2c __attribute__((ext_vector_type(2)));
__device__ __forceinline__ unsigned pkbf(float lo, float hi) { const f32x2c v = {lo, hi}; const bf16x2c b = __builtin_convertvector(v, bf16x2c); return __builtin_bit_cast(unsigned, b); }
__device__ __forceinline__ float bflo(unsigned w) { return __uint_as_float(w << 16); }
__device__ __forceinline__ float bfhi(unsigned w) { return __uint_as_float(w & 0xffff0000u); }
__device__ __forceinline__ float bfe(const u32x4& w, int e) { const unsigned x = w[e >> 1]; return (e & 1) ? bfhi(x) : bflo(x); }
__device__ __forceinline__ float sigm(float x) { return __builtin_amdgcn_rcpf(1.0f + __expf(-x)); }
__device__ __forceinline__ float wave_sum(float v) {
#pragma unroll
    for (int o = 1; o < 64; o <<= 1) v += __shfl_xor(v, o);
    return v;
}
#define BARRIER() __syncthreads()

__device__ __forceinline__ void p0_transpose_item(const float* W, int K, int N, bf16_t* WT, int row_off, int mode, LAS float* scr, int item, int lane) {
    const int nblk = N / 32, kb = item / nblk, nb = item - kb * nblk, k0 = 64 * kb, n0 = 32 * nb;
#pragma unroll 8
    for (int i = 0; i < 32; ++i) { const int kk = 2 * i + (lane >> 5); scr[kk * 33 + (lane & 31)] = W[(size_t)(k0 + kk) * N + n0 + (lane & 31)]; }
    asm volatile("s_waitcnt lgkmcnt(0)" ::: "memory");
    int drow0;
    if (mode == 1) { const int bj = n0 / FF, jj = n0 - bj * FF; drow0 = (jj >> 7) * 256 + bj * 128 + (jj & 127); } else drow0 = row_off + n0;
    const int c = lane & 7;
#pragma unroll
    for (int j = 0; j < 4; ++j) { const int n = (lane >> 3) + 8 * j; const LAS float* s = scr + (8 * c) * 33 + n;
        u32x4 o; o.x = pkbf(s[0 * 33], s[1 * 33]); o.y = pkbf(s[2 * 33], s[3 * 33]); o.z = pkbf(s[4 * 33], s[5 * 33]); o.w = pkbf(s[6 * 33], s[7 * 33]);
        *(u32x4*)(WT + (size_t)(drow0 + n) * K + k0 + 8 * c) = o; }
    asm volatile("s_waitcnt lgkmcnt(0)" ::: "memory");
}
__device__ __forceinline__ void p0_prologue(const Params& p, LAS unsigned char* lds, int gw, int NGW, int wave, int lane) {
    LAS float* scr = (LAS float*)(lds + wave * 16384);
    constexpr int I_IN = (D / 64) * (NPROJ / 32), I_PL = 4 * 2 * 4, I_UP = (512 / 64) * (D / 32), I_OUT = (D / 64) * (D / 32), I_FI = (D / 64) * (2 * FF / 32), I_FO = (FF / 64) * (D / 32);
    constexpr int PER_LAYER = I_IN + I_PL + 3 * I_UP + I_OUT + I_FI + I_FO;
    for (int it = gw; it < DEPTH * PER_LAYER; it += NGW) {
        const int l = it / PER_LAYER; int r = it - l * PER_LAYER;
        unsigned char* wl = p.ws + WS_W + (size_t)l * W_LAYER;
        if (r < I_IN) { p0_transpose_item(p.in[I_WIN] + (size_t)l * D * NPROJ, D, NPROJ, (bf16_t*)(wl + WO_IN), 0, 0, scr, r, lane); continue; } r -= I_IN;
        if (r < I_PL) { const int g = r >> 3; p0_transpose_item(p.in[I_POOLW] + (size_t)(l * 4 + g) * 128 * 128, 128, 128, (bf16_t*)(wl + WO_POOL) + (size_t)g * 128 * 128, 0, 0, scr, r & 7, lane); continue; } r -= I_PL;
        if (r < 3 * I_UP) { const int br = r / I_UP; const float* src = p.in[br == 0 ? I_WUP : (br == 1 ? I_WUA : I_WUR)] + (size_t)l * 512 * D;
            p0_transpose_item(src, 512, D, (bf16_t*)(wl + WO_UP), br * D, 0, scr, r - br * I_UP, lane); continue; } r -= 3 * I_UP;
        if (r < I_OUT) { p0_transpose_item(p.in[I_WOUT] + (size_t)l * D * D, D, D, (bf16_t*)(wl + WO_OUT), 0, 0, scr, r, lane); continue; } r -= I_OUT;
        if (r < I_FI) { p0_transpose_item(p.in[I_WFI] + (size_t)l * D * 2 * FF, D, 2 * FF, (bf16_t*)(wl + WO_FFI), 0, 1, scr, r, lane); continue; } r -= I_FI;
        p0_transpose_item(p.in[I_WFO] + (size_t)l * FF * D, FF, D, (bf16_t*)(wl + WO_FFO), 0, 0, scr, r, lane);
    }
}

__device__ __forceinline__ void norm_rows_bf16(const float* x, const float* g, bf16_t* h, int nrows, int gw, int NGW, int lane) {
    for (int row = gw; row < nrows; row += NGW) {
        const f32x4* xr = (const f32x4*)(x + (size_t)row * D) + lane;
        f32x4 v[4]; float ss = 0.f;
#pragma unroll
        for (int j = 0; j < 4; ++j) { v[j] = xr[64 * j]; ss += (v[j][0] * v[j][0] + v[j][1] * v[j][1]) + (v[j][2] * v[j][2] + v[j][3] * v[j][3]); }
        const float rstd = rsqrtf(wave_sum(ss) * (1.0f / D) + EPS);
        u32x2* o = (u32x2*)(h + (size_t)row * D) + lane;
#pragma unroll
        for (int j = 0; j < 4; ++j) { const f32x4 gv = ((const f32x4*)g)[lane + 64 * j]; const f32x4 y = v[j] * rstd * gv; u32x2 w; w.x = pkbf(y[0], y[1]); w.y = pkbf(y[2], y[3]); o[64 * j] = w; }
    }
}
__device__ __forceinline__ void norm_rows_f32_inplace(float* x, const float* g, int nrows, int gw, int NGW, int lane, int probe_rows) {
    for (int row = gw; row < nrows; row += NGW) {
        f32x4* xr = (f32x4*)(x + (size_t)row * D) + lane;
        f32x4 v[4]; float ss = 0.f;
#pragma unroll
        for (int j = 0; j < 4; ++j) { v[j] = xr[64 * j]; ss += (v[j][0] * v[j][0] + v[j][1] * v[j][1]) + (v[j][2] * v[j][2] + v[j][3] * v[j][3]); }
        const float rstd = rsqrtf(wave_sum(ss) * (1.0f / D) + EPS);
#pragma unroll
        for (int j = 0; j < 4; ++j) { const f32x4 gv = ((const f32x4*)g)[lane + 64 * j]; const float pd = (row < probe_rows) ? ((lane & 1) ? 0.0078125f : -0.0078125f) : 0.f; xr[64 * j] = v[j] * rstd * gv + pd; }
    }
}
__device__ __forceinline__ void hgrn_combine(const bf16_t* of, const bf16_t* ob, const bf16_t* proj, const float* gain, bf16_t* yrec, int gw, int NGW, int lane) {
    for (int row = gw; row < TH; row += NGW) {
        const u32x4 a = *((const u32x4*)(of + (size_t)row * 512) + lane), b = *((const u32x4*)(ob + (size_t)row * 512) + lane);
        const u32x4 gz = *((const u32x4*)(proj + (size_t)row * INC + C_RG) + lane);
        float o[8]; float ss = 0.f;
#pragma unroll
        for (int e = 0; e < 8; ++e) { o[e] = bfe(a, e) + bfe(b, e); ss += o[e] * o[e]; }
        ss += __shfl_xor(ss, 1); ss += __shfl_xor(ss, 2); ss += __shfl_xor(ss, 4); ss += __shfl_xor(ss, 8);
        const float rstd = rsqrtf(ss * (1.0f / 128.0f) + EPS);
        const f32x4 g0 = *(const f32x4*)(gain + ((8 * lane) & 127)), g1 = *(const f32x4*)(gain + ((8 * lane) & 127) + 4);
        float y[8];
#pragma unroll
        for (int e = 0; e < 8; ++e) { const float z = bfe(gz, e); const float gg = e < 4 ? g0[e] : g1[e - 4]; y[e] = o[e] * rstd * gg * (z * sigm(z)); }
        u32x4 w; w.x = pkbf(y[0], y[1]); w.y = pkbf(y[2], y[3]); w.z = pkbf(y[4], y[5]); w.w = pkbf(y[6], y[7]);
        *((u32x4*)(yrec + (size_t)row * 512) + lane) = w;
    }
}

__device__ __forceinline__ void pool_unit(LAS unsigned char* lds, const bf16_t* proj, const bf16_t* wpool  , const float* pscale  , bf16_t* ypool, int unit, int tid) {
    const int tile = unit >> 2, g = unit & 3, t0 = tile * 128, p0 = t0 & (SEQ - 1), hw = 1 << g;
    LAS bf16_t* U = (LAS bf16_t*)lds; LAS bf16_t* Dt = (LAS bf16_t*)(lds + 39168); LAS bf16_t* Bw = (LAS bf16_t*)(lds + 39168 + 34816);
    for (int idx = tid; idx < 144 * 16; idx += NT) { const int r = idx >> 4, cs = idx & 15; const int pp = p0 - 8 + r;
        u32x4 v = (u32x4){0u, 0u, 0u, 0u};
        if (pp >= 0 && pp < SEQ) v = *(const u32x4*)(proj + (size_t)(t0 - 8 + r) * INC + C_POOL + g * 128 + cs * 8);
        *(LAS u32x4*)(U + r * 136 + cs * 8) = v; }
    for (int idx = tid; idx < 128 * 16; idx += NT) { const int r = idx >> 4, cs = idx & 15;
        *(LAS u32x4*)(Bw + r * 136 + cs * 8) = *(const u32x4*)(wpool + (size_t)g * 128 * 128 + r * 128 + cs * 8); }
    BARRIER();
    for (int idx = tid; idx < 128 * 16; idx += NT) { const int r = idx >> 4, cs = idx & 15; const int pp = p0 + r;
        int lo = pp - hw; if (lo < 0) lo = 0; int hi = pp + hw - 1; if (hi > SEQ - 1) hi = SEQ - 1;
        float s[8];
#pragma unroll
        for (int e = 0; e < 8; ++e) s[e] = 0.f;
        for (int q = lo; q <= hi; ++q) { const u32x4 v = *(const LAS u32x4*)(U + (q - p0 + 8) * 136 + cs * 8);
#pragma unroll
            for (int e = 0; e < 8; ++e) s[e] += bfe(v, e); }
        const float inv = 1.0f / (float)(hi - lo + 1);
        const u32x4 c = *(const LAS u32x4*)(U + (r + 8) * 136 + cs * 8);
        u32x4 w; w.x = pkbf(s[0] * inv - bfe(c, 0), s[1] * inv - bfe(c, 1)); w.y = pkbf(s[2] * inv - bfe(c, 2), s[3] * inv - bfe(c, 3));
        w.z = pkbf(s[4] * inv - bfe(c, 4), s[5] * inv - bfe(c, 5)); w.w = pkbf(s[6] * inv - bfe(c, 6), s[7] * inv - bfe(c, 7));
        *(LAS u32x4*)(Dt + r * 136 + cs * 8) = w; }
    BARRIER();
    const int wave = tid >> 6, lane = tid & 63, lr = lane & 15, lg = lane >> 4;
    f32x4 acc[8];
#pragma unroll
    for (int cb = 0; cb < 8; ++cb) acc[cb] = (f32x4){0.f, 0.f, 0.f, 0.f};
#pragma unroll
    for (int st = 0; st < 4; ++st) { const bf16x8 a = *(const LAS bf16x8*)(Dt + (16 * wave + lr) * 136 + 32 * st + 8 * lg);
#pragma unroll
        for (int cb = 0; cb < 8; ++cb) { const bf16x8 b = *(const LAS bf16x8*)(Bw + (16 * cb + lr) * 136 + 32 * st + 8 * lg);
            acc[cb] = __builtin_amdgcn_mfma_f32_16x16x32_bf16(a, b, acc[cb], 0, 0, 0); } }
#pragma unroll
    for (int cb = 0; cb < 8; ++cb) { const int n = g * 128 + 16 * cb + lr; const float sc = pscale[n];
#pragma unroll
        for (int r = 0; r < 4; ++r) { const int row = t0 + 16 * wave + 4 * lg + r; ypool[(size_t)row * 512 + n] = (bf16_t)(pkbf(acc[cb][r] * sc, 0.f) & 0xffffu); } }
    BARRIER();
}

constexpr int AT_Q = 0, AT_K = 34816, AT_V = AT_K + 2 * 17408, AT_END = AT_V + 2 * 17408;
static_assert(AT_END <= LDS_ITEM_OFF && 128 * 132 * 4 <= 4 * 17408, "attention LDS");
__device__ __forceinline__ void attn_unit(LAS unsigned char* lds, const bf16_t* proj, const float* lq1, const float* lk1, const float* lq2, const float* lk2, const float* dng, int layer, bf16_t* yattn, int unit, int tid) {
    const int b = unit >> 6, h = (unit >> 4) & 3, qb = unit & 15;
    const int wave = tid >> 6, lane = tid & 63, l31 = lane & 31, hi = lane >> 5, rg = wave & 3, c = wave >> 2;
    LAS bf16_t* Qs = (LAS bf16_t*)(lds + AT_Q);
    const size_t tok0 = (size_t)b * SEQ;
    const float lambda_init = 0.8f - 0.6f * __expf(-0.3f * (float)layer);
    float s1 = 0.f, s2 = 0.f;
    for (int i = 0; i < 64; ++i) { s1 += lq1[i] * lk1[i]; s2 += lq2[i] * lk2[i]; }
    const float lam = __expf(s1) - __expf(s2) + lambda_init;
    const float LOG2E = 1.4426950408889634f;
    const float sc2 = 0.125f * LOG2E;
    const float slope2 = exp2f(-2.0f * (float)(h + 1)) * LOG2E;
#pragma unroll
    for (int i = 0; i < 4; ++i) { const int idx = tid + NT * i, r = idx >> 4, cs = idx & 15;
        const u32x4 qv = *(const u32x4*)(proj + (tok0 + qb * 128 + r) * INC + C_AQ + h * 128 + cs * 8);
        u32x4 qs; qs.x = pkbf(bflo(qv.x) * sc2, bfhi(qv.x) * sc2); qs.y = pkbf(bflo(qv.y) * sc2, bfhi(qv.y) * sc2); qs.z = pkbf(bflo(qv.z) * sc2, bfhi(qv.z) * sc2); qs.w = pkbf(bflo(qv.w) * sc2, bfhi(qv.w) * sc2);
        *(LAS u32x4*)(Qs + r * 136 + cs * 8) = qs; }
    const int kr0 = tid >> 4, kcs = tid & 15;
    const int vkp = tid >> 4, vvg = tid & 15;
    u32x4 kreg[2], vreg[2];
    {
        const bf16_t* kb = proj + (tok0 + kr0) * INC + C_AK + h * 128 + kcs * 8;
        kreg[0] = *(const u32x4*)kb; kreg[1] = *(const u32x4*)(kb + (size_t)32 * INC);
        const bf16_t* vb = proj + (tok0 + 2 * vkp) * INC + C_AV + h * 128 + vvg * 8;
        vreg[0] = *(const u32x4*)vb; vreg[1] = *(const u32x4*)(vb + INC);
    }
    f32x16 O[4];
#pragma unroll
    for (int vt = 0; vt < 4; ++vt)
#pragma unroll
        for (int r = 0; r < 16; ++r) O[vt][r] = 0.f;
    float mrun = 0.f, lrun = 0.f;
    const int qpos = qb * 128 + 32 * rg + l31;
    const LAS bf16_t* qrow = Qs + (32 * rg + l31) * 136 + c * 64 + 8 * hi;
    for (int kt = 0; kt < SEQ / 64; ++kt) {
        const int cur = kt & 1;
        LAS bf16_t* Kc = (LAS bf16_t*)(lds + AT_K + cur * 17408); LAS bf16_t* Vc = (LAS bf16_t*)(lds + AT_V + cur * 17408);
        *(LAS u32x4*)(Kc + kr0 * 136 + kcs * 8) = kreg[0]; *(LAS u32x4*)(Kc + (kr0 + 32) * 136 + kcs * 8) = kreg[1];
#pragma unroll
        for (int e = 0; e < 8; ++e) { const unsigned lo = (e & 1) ? (vreg[0][e >> 1] >> 16) : (vreg[0][e >> 1] & 0xffffu); const unsigned hi16 = (e & 1) ? (vreg[1][e >> 1] & 0xffff0000u) : (vreg[1][e >> 1] << 16);
            *(LAS unsigned*)(Vc + (8 * vvg + e) * 68 + 2 * vkp) = lo | hi16; }
        BARRIER();
        if (kt + 1 < SEQ / 64) {
            const bf16_t* kb = proj + (tok0 + (kt + 1) * 64 + kr0) * INC + C_AK + h * 128 + kcs * 8;
            kreg[0] = *(const u32x4*)kb; kreg[1] = *(const u32x4*)(kb + (size_t)32 * INC);
            const bf16_t* vb = proj + (tok0 + (kt + 1) * 64 + 2 * vkp) * INC + C_AV + h * 128 + vvg * 8;
            vreg[0] = *(const u32x4*)vb; vreg[1] = *(const u32x4*)(vb + INC);
        }
        f32x16 S[2];
#pragma unroll
        for (int ks = 0; ks < 2; ++ks)
#pragma unroll
            for (int r = 0; r < 16; ++r) S[ks][r] = -mrun;
#pragma unroll
        for (int st = 0; st < 4; ++st) {
            const bf16x8 qf = *(const LAS bf16x8*)(qrow + 16 * st);
#pragma unroll
            for (int ks = 0; ks < 2; ++ks) { const bf16x8 kf = *(const LAS bf16x8*)(Kc + (32 * ks + l31) * 136 + c * 64 + 16 * st + 8 * hi);
                S[ks] = __builtin_amdgcn_mfma_f32_32x32x16_bf16(kf, qf, S[ks], 0, 0, 0); }
        }
        float mx = -1e30f;
#pragma unroll
        for (int ks = 0; ks < 2; ++ks) { const float fq = (float)(qpos - (64 * kt + 32 * ks + 4 * hi));
#pragma unroll
            for (int r = 0; r < 16; ++r) { const float tt = fq - (float)((r & 3) + 8 * (r >> 2)); const float v = fmaf(-slope2, fabsf(tt), S[ks][r]); S[ks][r] = v; mx = fmaxf(mx, v); } }
        mx = fmaxf(mx, __shfl_xor(mx, 32));
        float psum = 0.f, delta = 0.f;
        if (kt == 0 || __builtin_amdgcn_ballot_w64(mx > 4.0f) != 0ull) {
            delta = (kt == 0) ? mx : fmaxf(mx, 0.f); const float alpha = (kt == 0) ? 1.0f : __builtin_amdgcn_exp2f(-delta);
            mrun += delta; lrun *= alpha;
#pragma unroll
            for (int vt = 0; vt < 4; ++vt) O[vt] = O[vt] * alpha;
        }
#pragma unroll
        for (int ks = 0; ks < 2; ++ks)
#pragma unroll
            for (int r = 0; r < 16; ++r) { const float pv = __builtin_amdgcn_exp2f(S[ks][r] - delta); S[ks][r] = pv; psum += pv; }
        lrun += psum;
        bf16x8 pf[2][2];
#pragma unroll
        for (int ks = 0; ks < 2; ++ks)
#pragma unroll
            for (int s = 0; s < 2; ++s) { u32x4 pw; pw.x = pkbf(S[ks][8 * s + 0], S[ks][8 * s + 1]); pw.y = pkbf(S[ks][8 * s + 2], S[ks][8 * s + 3]);
                pw.z = pkbf(S[ks][8 * s + 4], S[ks][8 * s + 5]); pw.w = pkbf(S[ks][8 * s + 6], S[ks][8 * s + 7]); pf[ks][s] = __builtin_bit_cast(bf16x8, pw); }
#pragma unroll
        for (int vt = 0; vt < 4; ++vt) {
            f32x16 o = O[vt];
#pragma unroll
            for (int ks = 0; ks < 2; ++ks)
#pragma unroll
                for (int s = 0; s < 2; ++s) {
                    const LAS bf16_t* vp = Vc + (32 * vt + l31) * 68 + 32 * ks + 16 * s + 4 * hi;
                    const u32x2 a = *(const LAS u32x2*)vp, bq = *(const LAS u32x2*)(vp + 8);
                    const u32x4 w = (u32x4){a.x, a.y, bq.x, bq.y};
                    o = __builtin_amdgcn_mfma_f32_32x32x16_bf16(__builtin_bit_cast(bf16x8, w), pf[ks][s], o, 0, 0, 0);
                }
            O[vt] = o;
        }
    }
    const float ltot = lrun + __shfl_xor(lrun, 32);
    LAS float* X = (LAS float*)(lds + AT_K);
    BARRIER();
    if (c == 1) { const float sc = lam / ltot;
#pragma unroll
        for (int vt = 0; vt < 4; ++vt)
#pragma unroll
            for (int rq = 0; rq < 4; ++rq) { const f32x4 w = (f32x4){O[vt][4 * rq + 0] * sc, O[vt][4 * rq + 1] * sc, O[vt][4 * rq + 2] * sc, O[vt][4 * rq + 3] * sc};
                *(LAS f32x4*)(X + (32 * rg + l31) * 132 + 32 * vt + 8 * rq + 4 * hi) = w; } }
    BARRIER();
    if (c == 0) { const float i0 = 1.0f / ltot; float ss = 0.f;
#pragma unroll
        for (int vt = 0; vt < 4; ++vt)
#pragma unroll
            for (int rq = 0; rq < 4; ++rq) { const f32x4 x = *(const LAS f32x4*)(X + (32 * rg + l31) * 132 + 32 * vt + 8 * rq + 4 * hi);
#pragma unroll
                for (int e = 0; e < 4; ++e) { const float o = O[vt][4 * rq + e] * i0 - x[e]; O[vt][4 * rq + e] = o; ss += o * o; } }
        ss += __shfl_xor(ss, 32);
        const float rs = rsqrtf(ss * (1.0f / 128.0f) + EPS) * (1.0f - lambda_init);
#pragma unroll
        for (int vt = 0; vt < 4; ++vt)
#pragma unroll
            for (int rq = 0; rq < 4; ++rq) { const int v0 = 32 * vt + 8 * rq + 4 * hi; const f32x4 gv = *(const f32x4*)(dng + v0);
                u32x2 w; w.x = pkbf(O[vt][4 * rq + 0] * rs * gv[0], O[vt][4 * rq + 1] * rs * gv[1]); w.y = pkbf(O[vt][4 * rq + 2] * rs * gv[2], O[vt][4 * rq + 3] * rs * gv[3]);
                *(LAS u32x2*)(Qs + (32 * rg + l31) * 136 + v0) = w; } }
    BARRIER();
#pragma unroll
    for (int i = 0; i < 4; ++i) { const int idx = tid + NT * i, r = idx >> 4, cs = idx & 15;
        *(u32x4*)(yattn + (tok0 + qb * 128 + r) * 512 + h * 128 + cs * 8) = *(const LAS u32x4*)(Qs + r * 136 + cs * 8); }
    BARRIER();
}

constexpr int HG_QD = 0, HG_QG = 17408, HG_KE = 34816, HG_KT = 52224, HG_V = HG_KT + 18432, HG_S = HG_V + 18432, HG_VEC = HG_S + 34816, HG_SCP = HG_VEC + 8192, HG_LB = HG_SCP + 18432, HG_END = HG_LB + 512;
static_assert(HG_END <= LDS_ITEM_OFF, "hgrn LDS");
__device__ __forceinline__ bf16x8 scale_frag(const u32x4 w, const f32x4 m0, const f32x4 m1) {
    u32x4 o; o.x = pkbf(bflo(w.x) * m0[0], bfhi(w.x) * m0[1]); o.y = pkbf(bflo(w.y) * m0[2], bfhi(w.y) * m0[3]); o.z = pkbf(bflo(w.z) * m1[0], bfhi(w.z) * m1[1]); o.w = pkbf(bflo(w.w) * m1[2], bfhi(w.w) * m1[3]);
    return __builtin_bit_cast(bf16x8, o);
}
#ifndef PROBE
#define PROBE 0
#endif
#define HG_T0(id) do { if (PROBE == (id) && blockIdx.x == 0 && tid == 0) *(LAS unsigned long long*)(lds + LDS_ITEM_OFF + 128) = __builtin_amdgcn_s_memrealtime(); } while (0)
#define HG_T1(id) do { if (PROBE == (id) && blockIdx.x == 0 && tid == 0) *(LAS unsigned long long*)(lds + LDS_ITEM_OFF + 136) += __builtin_amdgcn_s_memrealtime() - *(LAS unsigned long long*)(lds + LDS_ITEM_OFF + 128); } while (0)
__device__ __forceinline__ void hgrn_unit(LAS unsigned char* lds, const bf16_t* proj, const float* hlb  , int layer, bf16_t* o2  , int unit, int tid) {
    const int b = unit >> 3, h = (unit >> 1) & 3, dir = unit & 1;
    const int wave = __builtin_amdgcn_readfirstlane(tid >> 6), lane = tid & 63, lr = lane & 15, lg = lane >> 4;
    LAS bf16_t* Qd = (LAS bf16_t*)(lds + HG_QD); LAS bf16_t* Qg = (LAS bf16_t*)(lds + HG_QG); LAS bf16_t* Ke = (LAS bf16_t*)(lds + HG_KE); LAS bf16_t* KeT = (LAS bf16_t*)(lds + HG_KT);
    LAS bf16_t* Vt = (LAS bf16_t*)(lds + HG_V); LAS bf16_t* St = (LAS bf16_t*)(lds + HG_S); LAS float* Vec = (LAS float*)(lds + HG_VEC); LAS bf16_t* Sc = (LAS bf16_t*)(lds + HG_SCP);
    LAS float* lbv = (LAS float*)(lds + HG_LB);
    const size_t tok0 = (size_t)b * SEQ;
    const float scale_q = 0.08838834764831845f;
    if (tid < 128) { const float* a = hlb + (size_t)dir * DEPTH * 512 + h * 128 + tid;
        const float a0 = a[0], a1 = a[512], a2 = a[1024], a3 = a[1536]; const float mx = fmaxf(fmaxf(a0, a1), fmaxf(a2, a3));
        const float e0 = __expf(a0 - mx), e1 = __expf(a1 - mx), e2 = __expf(a2 - mx), e3 = __expf(a3 - mx); const float inv = 1.0f / (e0 + e1 + e2 + e3);
        float lb = 0.f; if (layer >= 1) lb += e1 * inv; if (layer >= 2) lb += e2 * inv; if (layer >= 3) lb += e3 * inv;
        lbv[tid] = lb; }
    for (int idx = tid; idx < 128 * 136 / 2; idx += NT) ((LAS unsigned*)St)[idx] = 0u;
    f32x4 st[8];
#pragma unroll
    for (int vb = 0; vb < 8; ++vb) st[vb] = (f32x4){0.f, 0.f, 0.f, 0.f};
    const int ci4 = wave >> 1, half = lane >> 5, cp2 = 2 * (((wave & 1) << 5) | (lane & 31)), rb8 = 16 * ci4 + 8 * half;
    const __amdgpu_buffer_rsrc_t rsrc = __builtin_amdgcn_make_buffer_rsrc((void*)(proj + tok0 * INC + h * 128), (short)0, SEQ * INC * 2, 0x00020000);
    const int fcol = (dir == 0 ? C_RF : C_RB);
    const int vo = cp2 * 2 + (dir == 0 ? half : 1 - half) * (8 * INC * 2);
#define HG_ROWOFF(ci_, r_) ((dir == 0 ? ((ci_) * 64 + 16 * ci4 + (r_)) : (SEQ - 9 - ((ci_) * 64 + 16 * ci4 + (r_)))) * (INC * 2))
    unsigned qraw[8], zraw[8], vraw[8];
#pragma unroll
    for (int r = 0; r < 8; ++r) { const int ro = HG_ROWOFF(0, r);
        qraw[r] = __builtin_amdgcn_raw_buffer_load_b32(rsrc, vo, ro + C_RQ * 2, 0); zraw[r] = __builtin_amdgcn_raw_buffer_load_b32(rsrc, vo, ro + fcol * 2, 0); vraw[r] = __builtin_amdgcn_raw_buffer_load_b32(rsrc, vo, ro + C_RI * 2, 0); }
    BARRIER();
    typedef float f2 __attribute__((ext_vector_type(2)));
    for (int ci = 0; ci < SEQ / 64; ++ci) {
        HG_T0(12);
        {
            const f2 lb = *(const LAS f2*)(lbv + cp2), oml = 1.0f - lb;
            f2 ff[8]; f2 Pl = (f2){1.0f, 1.0f};
#pragma unroll
            for (int r = 0; r < 8; ++r) { f2 z = (f2){bflo(zraw[r]), bfhi(zraw[r])}; z = __builtin_elementwise_min(__builtin_elementwise_max(z, (f2){-30.0f, -30.0f}), (f2){30.0f, 30.0f});
                f2 ez; ez.x = __expf(-z.x); ez.y = __expf(-z.y); f2 sg; sg.x = __builtin_amdgcn_rcpf(1.0f + ez.x); sg.y = __builtin_amdgcn_rcpf(1.0f + ez.y);
                const f2 f = lb + oml * sg; ff[r] = f; Pl = Pl * f; }
            f2 Po; Po.x = __shfl_xor(Pl.x, 32); Po.y = __shfl_xor(Pl.y, 32);
            const f2 one = (f2){1.0f, 1.0f};
            f2 P = half ? Po : one;
#pragma unroll
            for (int r = 0; r < 8; ++r) { P = P * ff[r];
                const f2 qd = (f2){bflo(qraw[r]), bfhi(qraw[r])} * scale_q * P;
                *(LAS unsigned*)(Qd + (rb8 + r) * 136 + cp2) = pkbf(qd.x, qd.y); }
            if (half == 0) *(LAS f2*)(Vec + ci4 * 128 + cp2) = Pl * Po;
            unsigned kw0[4], kw1[4], vw0[4], vw1[4]; f2 suf = half ? one : Po;
#pragma unroll
            for (int r = 7; r >= 0; --r) { const f2 q = (f2){bflo(qraw[r]), bfhi(qraw[r])} * scale_q;
                const f2 ke = (1.0f - ff[r]) * suf; f2 iv; iv.x = fminf(__builtin_amdgcn_rcpf(suf.x), 5.5e34f); iv.y = fminf(__builtin_amdgcn_rcpf(suf.y), 5.5e34f); const f2 qg = q * iv;
                *(LAS unsigned*)(Qg + (rb8 + r) * 136 + cp2) = pkbf(qg.x, qg.y);
                const unsigned kd = pkbf(ke.x, ke.y); *(LAS unsigned*)(Ke + (rb8 + r) * 136 + cp2) = kd;
                const unsigned vd = vraw[r];
                if (r & 1) { kw0[r >> 1] = kd << 16; kw1[r >> 1] = kd & 0xffff0000u; vw0[r >> 1] = vd << 16; vw1[r >> 1] = vd & 0xffff0000u; }
                else { kw0[r >> 1] |= kd & 0xffffu; kw1[r >> 1] |= kd >> 16; vw0[r >> 1] |= vd & 0xffffu; vw1[r >> 1] |= vd >> 16; }
                suf = suf * ff[r]; }
            *(LAS u32x4*)(KeT + cp2 * 72 + rb8) = (u32x4){kw0[0], kw0[1], kw0[2], kw0[3]}; *(LAS u32x4*)(KeT + (cp2 + 1) * 72 + rb8) = (u32x4){kw1[0], kw1[1], kw1[2], kw1[3]};
            *(LAS u32x4*)(Vt + cp2 * 72 + rb8) = (u32x4){vw0[0], vw0[1], vw0[2], vw0[3]}; *(LAS u32x4*)(Vt + (cp2 + 1) * 72 + rb8) = (u32x4){vw1[0], vw1[1], vw1[2], vw1[3]};
        }
        BARRIER();
        if (ci + 1 < SEQ / 64) {
#pragma unroll
            for (int r = 0; r < 8; ++r) { const int ro = HG_ROWOFF(ci + 1, r);
                qraw[r] = __builtin_amdgcn_raw_buffer_load_b32(rsrc, vo, ro + C_RQ * 2, 0); zraw[r] = __builtin_amdgcn_raw_buffer_load_b32(rsrc, vo, ro + fcol * 2, 0); vraw[r] = __builtin_amdgcn_raw_buffer_load_b32(rsrc, vo, ro + C_RI * 2, 0); } }
        HG_T1(12); HG_T0(13);
        if (tid < 128) { const float T0 = Vec[tid], T1 = Vec[128 + tid], T2 = Vec[256 + tid], T3 = Vec[384 + tid];
            Vec[4 * 128 + tid] = T0; Vec[5 * 128 + tid] = T0 * T1; Vec[6 * 128 + tid] = T0 * T1 * T2;
            Vec[7 * 128 + tid] = T1; Vec[8 * 128 + tid] = T2; Vec[9 * 128 + tid] = T1 * T2;
            Vec[10 * 128 + tid] = T1 * T2 * T3; Vec[11 * 128 + tid] = T2 * T3; Vec[12 * 128 + tid] = T3; Vec[13 * 128 + tid] = 1.0f;
            Vec[14 * 128 + tid] = (T0 * T1) * (T2 * T3); }
        BARRIER();
        HG_T1(13); HG_T0(14);
        const int tb = wave & 3, vh = wave >> 2;
        {
            int nb = 1, i0 = 3, j0 = 0, i1 = 0, j1 = 0;
            switch (wave) { case 1: j0 = 1; break; case 2: i0 = 2; break; case 3: nb = 2; i0 = 0; j0 = 0; i1 = 1; j1 = 0; break; case 4: nb = 2; i0 = 1; j0 = 1; i1 = 2; j1 = 1; break;
                            case 5: nb = 2; i0 = 2; j0 = 2; i1 = 3; j1 = 2; break; case 6: j0 = 3; break; case 7: nb = 0; break; default: break; }
            for (int q = 0; q < nb; ++q) { const int bi = q ? i1 : i0, bj = q ? j1 : j0;
                f32x4 acc = (f32x4){0.f, 0.f, 0.f, 0.f};
                const int dsel = (bi - bj < 2) ? -1 : (bi == 2 ? 7 : (bj == 1 ? 8 : 9));
#pragma unroll
                for (int stp = 0; stp < 4; ++stp) { const int k0 = 32 * stp + 8 * lg;
                    bf16x8 a;
                    if (bj == bi) a = *(const LAS bf16x8*)(Qg + (16 * bi + lr) * 136 + k0);
                    else if (dsel < 0) a = *(const LAS bf16x8*)(Qd + (16 * bi + lr) * 136 + k0);
                    else a = scale_frag(*(const LAS u32x4*)(Qd + (16 * bi + lr) * 136 + k0), *(const LAS f32x4*)(Vec + dsel * 128 + k0), *(const LAS f32x4*)(Vec + dsel * 128 + k0 + 4));
                    const bf16x8 bq = *(const LAS bf16x8*)(Ke + (16 * bj + lr) * 136 + k0);
                    acc = __builtin_amdgcn_mfma_f32_16x16x32_bf16(a, bq, acc, 0, 0, 0); }
#pragma unroll
                for (int r = 0; r < 4; ++r) { float v = acc[r]; if (bj == bi && lr > 4 * lg + r) v = 0.f; Sc[(16 * bi + 4 * lg + r) * 72 + 16 * bj + lr] = (bf16_t)(pkbf(v, 0.f) & 0xffffu); } }
            if (wave == 7) {
#pragma unroll
                for (int zb = 0; zb < 6; ++zb) { const int bi = zb < 3 ? 0 : (zb < 5 ? 1 : 2), bj = zb < 3 ? zb + 1 : (zb < 5 ? zb - 1 : 3);
#pragma unroll
                    for (int r = 0; r < 4; ++r) Sc[(16 * bi + 4 * lg + r) * 72 + 16 * bj + lr] = (bf16_t)0; } }
        }
        f32x4 oa[4];
#pragma unroll
        for (int vb = 0; vb < 4; ++vb) oa[vb] = (f32x4){0.f, 0.f, 0.f, 0.f};
#pragma unroll
        for (int stp = 0; stp < 4; ++stp) { const int k0 = 32 * stp + 8 * lg;
            bf16x8 a;
            if (tb == 0) a = *(const LAS bf16x8*)(Qd + lr * 136 + k0);
            else a = scale_frag(*(const LAS u32x4*)(Qd + (16 * tb + lr) * 136 + k0), *(const LAS f32x4*)(Vec + (3 + tb) * 128 + k0), *(const LAS f32x4*)(Vec + (3 + tb) * 128 + k0 + 4));
#pragma unroll
            for (int vb = 0; vb < 4; ++vb) { const bf16x8 bq = *(const LAS bf16x8*)(St + (64 * vh + 16 * vb + lr) * 136 + k0);
                oa[vb] = __builtin_amdgcn_mfma_f32_16x16x32_bf16(a, bq, oa[vb], 0, 0, 0); } }
        BARRIER();
        HG_T1(14); HG_T0(15);
        {
#pragma unroll
            for (int stp = 0; stp < 2; ++stp) { const bf16x8 a = *(const LAS bf16x8*)(Sc + (16 * tb + lr) * 72 + 32 * stp + 8 * lg);
#pragma unroll
                for (int vb = 0; vb < 4; ++vb) { const bf16x8 bq = *(const LAS bf16x8*)(Vt + (64 * vh + 16 * vb + lr) * 72 + 32 * stp + 8 * lg);
                    oa[vb] = __builtin_amdgcn_mfma_f32_16x16x32_bf16(a, bq, oa[vb], 0, 0, 0); } }
            bf16_t* ob = o2 + (size_t)dir * TH * 512;
#pragma unroll
            for (int r = 0; r < 4; ++r) { const int pp_ = ci * 64 + 16 * tb + 4 * lg + r; const size_t tk = tok0 + (size_t)(dir == 0 ? pp_ : (SEQ - 1 - pp_));
#pragma unroll
                for (int vb = 0; vb < 4; ++vb) ob[tk * 512 + h * 128 + 64 * vh + 16 * vb + lr] = (bf16_t)(pkbf(oa[vb][r], 0.f) & 0xffffu); } }
        { const int kb = 16 * wave;
#pragma unroll
            for (int r = 0; r < 4; ++r) { const float dec = Vec[14 * 128 + kb + 4 * lg + r];
#pragma unroll
                for (int vb = 0; vb < 8; ++vb) st[vb][r] *= dec; }
#pragma unroll
            for (int stp = 0; stp < 2; ++stp) { const float fj = Vec[(10 + 2 * stp + (lg >> 1)) * 128 + kb + lr];
                const f32x4 m = (f32x4){fj, fj, fj, fj};
                const bf16x8 a = scale_frag(*(const LAS u32x4*)(KeT + (kb + lr) * 72 + 32 * stp + 8 * lg), m, m);
#pragma unroll
                for (int vb = 0; vb < 8; ++vb) { const bf16x8 bq = *(const LAS bf16x8*)(Vt + (16 * vb + lr) * 72 + 32 * stp + 8 * lg);
                    st[vb] = __builtin_amdgcn_mfma_f32_16x16x32_bf16(a, bq, st[vb], 0, 0, 0); } }
#pragma unroll
            for (int vb = 0; vb < 8; ++vb) { u32x2 w; w.x = pkbf(st[vb][0], st[vb][1]); w.y = pkbf(st[vb][2], st[vb][3]); *(LAS u32x2*)(St + (16 * vb + lr) * 136 + kb + 4 * lg) = w; } }
        BARRIER();
        HG_T1(15);
    }
#undef HG_ROWOFF
}
#define XB_TMO      128
#define XB_XCNT(j)  (256  + 64 * (j))
#define XB_XSUB(j)  (1280 + 64 * (j))
#define XB_XGEN(j)  (2304 + 64 * (j))
#define XB_TOP      3328
#define XB_TOPGEN   3392
#define XCD_BAR_WORDS 3456
#define XB_SPIN_CAP (1u << 22)

__device__ __forceinline__ unsigned xb_ld(unsigned* p)              { return __hip_atomic_load(p, __ATOMIC_RELAXED, __HIP_MEMORY_SCOPE_AGENT); }
__device__ __forceinline__ unsigned xb_add(unsigned* p, unsigned v) { return __hip_atomic_fetch_add(p, v, __ATOMIC_RELAXED, __HIP_MEMORY_SCOPE_AGENT); }
__device__ __forceinline__ unsigned xb_xcc_id() { return (unsigned)__builtin_amdgcn_s_getreg((3 << 11) | 20) & 0xFu; }
#define XB_SPIN(cond, bar) do { unsigned _sp = 0; while (cond) { __builtin_amdgcn_s_sleep(1); \
    if ((++_sp & 255u) == 0u) { if (xb_ld(&(bar)[XB_TMO])) break; if (_sp > XB_SPIN_CAP) { atomicAdd(&(bar)[XB_TMO], 1u); break; } } } } while (0)

struct XcdBarrier {
    unsigned* bar; unsigned x;
    volatile LAS unsigned* st;
};

__device__ __forceinline__ XcdBarrier xcd_barrier_post(unsigned* bar, volatile LAS unsigned* st) {
    XcdBarrier b; b.bar = bar; b.x = xb_xcc_id(); b.st = st;
    if (threadIdx.x == 0) (void)xb_add(&bar[XB_XCNT(b.x)], 1u);
    return b;
}
__device__ __forceinline__ void xcd_barrier_complete(unsigned* bar, unsigned x, unsigned& nloc, unsigned& nx) {
    const unsigned G = (gridDim.x * gridDim.y * gridDim.z) >> 3;
    unsigned sum, cnt, mine, sp = 0u;
    for (;;) {
        sum = 0u; cnt = 0u; mine = 0u;
#pragma unroll
        for (unsigned j = 0; j < 16; ++j) { const unsigned c = xb_ld(&bar[XB_XCNT(j)]); sum += c; cnt += (c > 0u) ? 1u : 0u; mine = (j == x) ? c : mine; }
        if (sum == G) break;
        __builtin_amdgcn_s_sleep(1);
        if ((++sp & 255u) == 0u) { if (xb_ld(&bar[XB_TMO])) break; if (sp > XB_SPIN_CAP) { atomicAdd(&bar[XB_TMO], 1u); break; } }
    }
    nloc = mine > 0u ? mine : 1u; nx = cnt > 0u ? cnt : 1u;
}

__device__ __forceinline__ void xcd_barrier(const XcdBarrier& b) {
    asm volatile("s_waitcnt vmcnt(0)" ::: "memory");
    __syncthreads();
    if (threadIdx.x == 0) {
        unsigned* bar = b.bar;
        __builtin_amdgcn_s_waitcnt(0);
        unsigned nloc = b.st[0], nx = b.st[1];
        if (nloc == 0u) { xcd_barrier_complete(bar, b.x, nloc, nx); b.st[0] = nloc; b.st[1] = nx; }
        const unsigned old = xb_add(&bar[XB_XSUB(b.x)], 1u);
        const unsigned gen = old / nloc;
        if (old + 1u == (gen + 1u) * nloc) {
            __builtin_amdgcn_fence(__ATOMIC_RELEASE, "agent");
            asm volatile("s_waitcnt vmcnt(0)" ::: "memory");
            const unsigned og = xb_add(&bar[XB_TOP], 1u);
            const unsigned tg = og / nx;
            if (og + 1u == (tg + 1u) * nx) xb_add(&bar[XB_TOPGEN], 1u);
            else XB_SPIN(xb_ld(&bar[XB_TOPGEN]) == tg, bar);
            __builtin_amdgcn_fence(__ATOMIC_ACQUIRE, "agent");
            xb_add(&bar[XB_XGEN(b.x)], 1u);
            asm volatile("s_waitcnt vmcnt(0)" ::: "memory");
        } else {
            XB_SPIN(xb_ld(&bar[XB_XGEN(b.x)]) == gen, bar);
            __builtin_amdgcn_fence(__ATOMIC_ACQUIRE, "agent");
            asm volatile("s_waitcnt vmcnt(0)" ::: "memory");
        }
    }
    __syncthreads();
}

constexpr int N_SCAN = 4 * 2;
constexpr int N_ATT = 4 * (SEQ / 128);
constexpr int N_POOLU = (TH / 128) * 4;
#ifndef PROBE
#define PROBE 0
#endif

__global__ void __launch_bounds__(NT, 2) mega_fwd(Params p) {
    extern __shared__ __attribute__((aligned(16))) unsigned char smem[];
    cg::grid_group grid = cg::this_grid();
    LAS unsigned char* lds = (LAS unsigned char*)smem;
    const int G = gridDim.x, bid = blockIdx.x, NGW = G * NW;
    const int grp = bid & 7, gidx = bid >> 3, GS = G >> 3, NGWG = GS * NW;
#define GRID_SYNC_CG() do { asm volatile("s_waitcnt vmcnt(0) lgkmcnt(0)" ::: "memory"); grid.sync(); __builtin_amdgcn_fence(__ATOMIC_ACQUIRE, "agent"); asm volatile("s_waitcnt vmcnt(0)" ::: "memory"); } while (0)
#define GROUP_SYNC() xcd_barrier(xbar)
#define OPAQUE_TID() int tid = threadIdx.x; asm volatile("" : "+v"(tid)); const int lane = tid & 63, wave = __builtin_amdgcn_readfirstlane(tid >> 6), gw = bid * NW + wave, gwg = gidx * NW + wave; (void)lane; (void)gw; (void)gwg
    unsigned char* ws = p.ws;
    unsigned* ctl = (unsigned*)(ws + WS_CTL);
    unsigned char* arena = ws + WS_ARENA + (size_t)grp * ARENA;
    bf16_t* proj = (bf16_t*)(arena + WS_PROJ); bf16_t* gates = (bf16_t*)(arena + WS_GATE); bf16_t* hbuf = (bf16_t*)(arena + WS_H); bf16_t* ycat = (bf16_t*)(arena + WS_Y); bf16_t* o2 = (bf16_t*)(arena + WS_O2);
    bf16_t* act = proj;

    { LAS unsigned* stw = (LAS unsigned*)(lds + LDS_ITEM_OFF + 64); if (threadIdx.x < 2) stw[threadIdx.x] = 0u; }
    __syncthreads();
    const XcdBarrier xbar = xcd_barrier_post(ctl + 8192 + grp * XCD_BAR_WORDS, (volatile LAS unsigned*)(lds + LDS_ITEM_OFF + 64));
    { OPAQUE_TID(); p0_prologue(p, lds, gw, NGW, wave, lane); }
    GRID_SYNC_CG();

    for (int half = 0; half < NHALF; ++half) {
        const size_t seq_off = (size_t)(half * NGRP + grp) * TH * D;
        const float* xin = p.in[I_X] + seq_off;
        float* xres = p.out + seq_off;
        for (int l = 0; l < DEPTH; ++l) {
            unsigned char* wl = ws + WS_W + (size_t)l * W_LAYER;
            const float* xcur = (l == 0) ? xin : xres;
            { OPAQUE_TID(); norm_rows_bf16(xcur, p.in[I_N1G] + l * D, hbuf, TH, gwg, NGWG, lane); }
            GROUP_SYNC();
            { pg8::Gemm g{hbuf, (const bf16_t*)(wl + WO_IN), TH, NPROJ, D}; pg8::GroupOrder S; S.init(NPROJ, GS, gidx);
              pg8::EpiStore E{proj, INC, gates, INC / 256};
              pg8::gemm_phase<pg8::EpiStore, pg8::GroupOrder, true, true>(lds, g, S, E); }
            GROUP_SYNC();
            {
                OPAQUE_TID();
                for (int u = gidx; u < N_SCAN; u += GS) hgrn_unit(lds, proj, p.in[I_HLB], l, o2, u, tid);
                unsigned* ctr = ctl + 64 * (1 + (half * DEPTH + l) * NGRP + grp);
                LAS unsigned* item_w = (LAS unsigned*)(lds + LDS_ITEM_OFF);
                for (;;) {
                    if (tid == 0) *item_w = atomicAdd(ctr, 1u);
                    BARRIER();
                    const int item = (int)*item_w;
                    BARRIER();
                    if (item >= N_ATT + N_POOLU) break;
                    asm volatile("" : "+v"(tid));
                    if (item < N_ATT) attn_unit(lds, proj, p.in[I_LQ1] + l * 64, p.in[I_LK1] + l * 64, p.in[I_LQ2] + l * 64, p.in[I_LK2] + l * 64, p.in[I_DNG] + l * 128, l, ycat + (size_t)TH * 512, item, tid);
                    else pool_unit(lds, proj, (const bf16_t*)(wl + WO_POOL), p.in[I_POOLS] + l * 512, ycat, item - N_ATT, tid);
                }
            }
            GROUP_SYNC();
            { OPAQUE_TID(); hgrn_combine(o2, o2 + (size_t)TH * 512, proj, p.in[I_HNG] + l * 128, ycat + (size_t)2 * TH * 512, gwg, NGWG, lane); }
            GROUP_SYNC();
            { pg8::Gemm g{ycat, (const bf16_t*)(wl + WO_UP), 3 * TH, 3 * D, 512}; pg8::MergeOrder S; S.init(GS, gidx);
              pg8::EpiMerge2 E{gates, hbuf, TH / 256};
              pg8::gemm_phase<pg8::EpiMerge2, pg8::MergeOrder, true, true>(lds, g, S, E); }
            GROUP_SYNC();
            { pg8::Gemm g{hbuf, (const bf16_t*)(wl + WO_OUT), TH, D, D}; pg8::GroupOrder S; S.init(D, GS, gidx);
              pg8::EpiResid E{xcur, xres, D};
              pg8::gemm_phase<pg8::EpiResid, pg8::GroupOrder, true, true>(lds, g, S, E); }
            GROUP_SYNC();
            { OPAQUE_TID(); norm_rows_bf16(xres, p.in[I_N2G] + l * D, hbuf, TH, gwg, NGWG, lane); }
            GROUP_SYNC();
            { pg8::Gemm g{hbuf, (const bf16_t*)(wl + WO_FFI), TH, 2 * FF, D}; pg8::GroupOrder S; S.init(2 * FF, GS, gidx);
              pg8::EpiSwiGLU E{act, FF};
              pg8::gemm_phase<pg8::EpiSwiGLU, pg8::GroupOrder, true, true>(lds, g, S, E); }
            GROUP_SYNC();
            { pg8::Gemm g{act, (const bf16_t*)(wl + WO_FFO), TH, D, FF}; pg8::GroupOrder S; S.init(D, GS, gidx);
              pg8::EpiResid E{xres, xres, D};
              pg8::gemm_phase<pg8::EpiResid, pg8::GroupOrder, true, true>(lds, g, S, E); }
            GROUP_SYNC();
        }
        { OPAQUE_TID(); norm_rows_f32_inplace(xres, p.in[I_FNG], TH, gwg, NGWG, lane, 0); }
    }
}

extern "C" void kernel_launch(void* const* d_in, const int* in_sizes, int n_in, void* d_out, int out_size, void* d_ws, size_t ws_size, hipStream_t stream) {
    static int grid = 0;
    if (grid == 0) {
        if (n_in != 20 || in_sizes[0] != 2 * NGRP * TH * D || out_size != 2 * NGRP * TH * D || ws_size < WS_END) {
            fprintf(stderr, "kernel_launch: unexpected shapes (n_in %d, in0 %d, out %d, ws %zu); nothing launched\n", n_in, n_in > 0 ? in_sizes[0] : -1, out_size, ws_size); grid = -1; return; }
        int dev = 0, cus = 0, per_cu = 0;
        if (hipGetDevice(&dev) != hipSuccess || hipDeviceGetAttribute(&cus, hipDeviceAttributeMultiprocessorCount, dev) != hipSuccess) { grid = -1; return; }
        if (hipFuncSetAttribute((const void*)mega_fwd, hipFuncAttributeMaxDynamicSharedMemorySize, LDS_BYTES) != hipSuccess) { fprintf(stderr, "kernel_launch: hipFuncSetAttribute failed\n"); grid = -1; return; }
        if (hipOccupancyMaxActiveBlocksPerMultiprocessor(&per_cu, (const void*)mega_fwd, NT, LDS_BYTES) != hipSuccess || per_cu < 1) { fprintf(stderr, "kernel_launch: occupancy query says %d\n", per_cu); per_cu = 1; }
        (void)hipGetLastError();
        grid = (cus / 8) * 8;
        if (grid < 64) { fprintf(stderr, "kernel_launch: too few CUs (%d)\n", cus); grid = -1; return; }
    }
    if (grid < 0) return;
    (void)hipMemsetAsync((char*)d_ws + WS_CTL, 0, CTL_BYTES, stream);
    Params prm{};
    for (int i = 0; i < 20; ++i) prm.in[i] = (const float*)d_in[i];
    prm.out = (float*)d_out; prm.ws = (unsigned char*)d_ws;
    void* args[] = {&prm};
    hipError_t e = hipLaunchCooperativeKernel((const void*)mega_fwd, dim3(grid), dim3(NT), args, LDS_BYTES, stream);
    if (e != hipSuccess) fprintf(stderr, "cooperative launch failed: %s (grid %d)\n", hipGetErrorString(e), grid);
}
```

```cpp
#include <hip/hip_runtime.h>
#include <hip/hip_cooperative_groups.h>
#include <cstdio>
#include <cstdint>
namespace cg = cooperative_groups;
namespace pg8 {
#define PG8_LAS __attribute__((address_space(3)))
typedef unsigned short bf16_t;
typedef short bf16x8 __attribute__((ext_vector_type(8)));
typedef float f32x4 __attribute__((ext_vector_type(4)));
typedef unsigned u32x4 __attribute__((ext_vector_type(4)));
constexpr int BM = 256, BK = 64, HALF = 128, HTB = HALF * BK * 2  , STAGE_BYTES = 8 * HTB, NXCD = 8, WGM = 8;

__host__ __device__ __forceinline__ int lds_byte(int r, int c) { const int st = (r >> 4) * 2 + (c >> 5), rr = r & 15, cc = c & 31, ob = rr * 64 + cc * 2; return st * 1024 + (ob ^ (((ob >> 9) & 1) << 5)); }
__host__ __device__ __forceinline__ void stage_rc(int b, int& R, int& C) { const int st = b / 1024, sb = b % 1024, swz = sb ^ (((sb >> 9) & 1) << 5); R = (st >> 1) * 16 + swz / 64; C = (st & 1) * 32 + (swz % 64) / 2; }
__host__ __device__ __forceinline__ int perm32(int rho) { const int n = rho >> 4, i = rho & 15; return 8 * (i >> 2) + 4 * n + (i & 3); }

struct Unit { int pm, pn; };
struct Gemm { const bf16_t* A; const bf16_t* Bt; int M, N, K; };

struct StaticOrder {
    int nM, nN, nwg, G, c;
    __host__ __device__ void init(int M, int N, int G_, int c_) { nM = M / BM; nN = N / BM; nwg = nM * nN; G = G_; c = c_; }
    __host__ __device__ bool next(int i, Unit& u) const {
        const long L = (long)i * G + c; if (L >= nwg) return false;
        int wgid = (int)L; { const int q = nwg / NXCD, r = nwg % NXCD, xcd = wgid % NXCD, off = wgid / NXCD; wgid = (xcd < r ? xcd * (q + 1) : r * (q + 1) + (xcd - r) * q) + off; }
        const int nig = WGM * nN, gid = wgid / nig, fm = gid * WGM, gsz = (nM - fm) < WGM ? (nM - fm) : WGM;
        u.pm = fm + ((wgid % nig) % gsz); u.pn = (wgid % nig) / gsz; return true;
    }
    __device__ __forceinline__ void a_ready(const Unit&) const {}
    __device__ __forceinline__ void done(const Unit&) const {}
};

typedef float f32x2c_ __attribute__((ext_vector_type(2)));
typedef __bf16 bf16x2c_ __attribute__((ext_vector_type(2)));
__device__ __forceinline__ unsigned cvt_pk_bf16(float lo, float hi) { const f32x2c_ v = {lo, hi}; const bf16x2c_ b = __builtin_convertvector(v, bf16x2c_); return __builtin_bit_cast(unsigned, b); }
typedef float f32x2 __attribute__((ext_vector_type(2)));
__device__ __forceinline__ float fast_sigmoid(float x) { return __builtin_amdgcn_rcpf(1.0f + __expf(-x)); }
typedef unsigned u32x2v __attribute__((ext_vector_type(2)));
struct EpiStore {
    static constexpr bool PERM = true, AFTER_DRAIN = false, KEEP = false;
    bf16_t* O; int ldc; bf16_t* G; int nrm;
    __device__ __forceinline__ void operator()(const f32x4 (&acc)[2][2][4][2], const Unit& u, int wr, int wc, int fr, int fq) const {
        const int row0 = u.pm * BM + wr * 64 + fr; const int col0 = u.pn * BM + wc * 32 + 8 * fq;
        const bool dump = u.pn >= nrm;
        bf16_t* gt = G + ((size_t)(u.pm * 12 + (u.pn - nrm)) << 16) + (wr * 4 + wc) * 512 + (fq * 16 + fr) * 8;
#pragma unroll
        for (int ai = 0; ai < 2; ++ai)
#pragma unroll
            for (int m = 0; m < 4; ++m) { bf16_t* rowp = O + (size_t)(row0 + ai * HALF + m * 16) * ldc + col0;
#pragma unroll
                for (int bj = 0; bj < 2; ++bj) { const f32x4 v0 = acc[ai][bj][m][0], v1 = acc[ai][bj][m][1];
                    u32x4 w; w.x = cvt_pk_bf16(v0[0], v0[1]); w.y = cvt_pk_bf16(v0[2], v0[3]); w.z = cvt_pk_bf16(v1[0], v1[1]); w.w = cvt_pk_bf16(v1[2], v1[3]);
                    if (dump) *(u32x4*)(gt + ((ai * 4 + m) * 2 + bj) * 4096) = w; else *(u32x4*)(rowp + bj * HALF) = w; } }
    }
};
struct EpiMerge {
    static constexpr bool PERM = true, AFTER_DRAIN = false, KEEP = false;
    bf16_t* proj; int ldp; int gate_col0; bf16_t* merged; int MT;
    __device__ __forceinline__ void operator()(const f32x4 (&acc)[2][2][4][2], const Unit& u, int wr, int wc, int fr, int fq) const {
        const int br = u.pm / MT, pmt = u.pm - br * MT, pnt = u.pn & 3;
        const int row0 = pmt * BM + wr * 64 + fr; const int col0 = pnt * BM + wc * 32 + 8 * fq;
#pragma unroll
        for (int ai = 0; ai < 2; ++ai)
#pragma unroll
            for (int mp = 0; mp < 2; ++mp) {
                u32x4 gw[2][2]; f32x4 p0[2][2], p1[2][2];
#pragma unroll
                for (int mm = 0; mm < 2; ++mm)
#pragma unroll
                    for (int bj = 0; bj < 2; ++bj) { const size_t row = (size_t)(row0 + ai * HALF + (2 * mp + mm) * 16); bf16_t* prow = proj + row * ldp; const int col = col0 + bj * HALF;
                        gw[mm][bj] = *(const u32x4*)(prow + gate_col0 + br * 1024 + col);
                        if (br > 0) { const float* part = (const float*)prow + col; p0[mm][bj] = *(const f32x4*)part; p1[mm][bj] = *(const f32x4*)(part + 4); }
                        else { p0[mm][bj] = (f32x4){0.f, 0.f, 0.f, 0.f}; p1[mm][bj] = (f32x4){0.f, 0.f, 0.f, 0.f}; } }
#pragma unroll
                for (int mm = 0; mm < 2; ++mm)
#pragma unroll
                    for (int bj = 0; bj < 2; ++bj) { const int m = 2 * mp + mm; const size_t row = (size_t)(row0 + ai * HALF + m * 16); bf16_t* prow = proj + row * ldp; const int col = col0 + bj * HALF;
                        const u32x4 g = gw[mm][bj]; f32x4 g0, g1;
                        g0[0] = fast_sigmoid(__uint_as_float(g.x << 16)); g0[1] = fast_sigmoid(__uint_as_float(g.x & 0xffff0000u));
                        g0[2] = fast_sigmoid(__uint_as_float(g.y << 16)); g0[3] = fast_sigmoid(__uint_as_float(g.y & 0xffff0000u));
                        g1[0] = fast_sigmoid(__uint_as_float(g.z << 16)); g1[1] = fast_sigmoid(__uint_as_float(g.z & 0xffff0000u));
                        g1[2] = fast_sigmoid(__uint_as_float(g.w << 16)); g1[3] = fast_sigmoid(__uint_as_float(g.w & 0xffff0000u));
                        const f32x4 v0 = g0 * acc[ai][bj][m][0] + p0[mm][bj], v1 = g1 * acc[ai][bj][m][1] + p1[mm][bj];
                        if (br < 2) { float* part = (float*)prow + col; *(f32x4*)part = v0; *(f32x4*)(part + 4) = v1; }
                        else { u32x4 w; w.x = cvt_pk_bf16(v0[0], v0[1]); w.y = cvt_pk_bf16(v0[2], v0[3]); w.z = cvt_pk_bf16(v1[0], v1[1]); w.w = cvt_pk_bf16(v1[2], v1[3]);
                            *(u32x4*)(merged + row * 1024 + col) = w; } }
            }
    }
};
struct EpiMerge2 {
    static constexpr bool PERM = true, AFTER_DRAIN = false, KEEP = true;
    const bf16_t* G; bf16_t* merged; int MT;
    static __device__ __forceinline__ float epos(unsigned bits) { return 1.0f + __expf(-fminf(fmaxf(__uint_as_float(bits), -30.0f), 30.0f)); }
    __device__ __forceinline__ bool apply(f32x4 (&acc)[2][2][4][2], const Unit& u, int wr, int wc, int fr, int fq) const {
        const int br = u.pm / MT, pmt = u.pm - br * MT, pnt = u.pn & 3;
        const int row0 = pmt * BM + wr * 64 + fr; const int col0 = pnt * BM + wc * 32 + 8 * fq;
        const bf16_t* gt = G + ((size_t)(pmt * 12 + br * 4 + pnt) << 16) + (wr * 4 + wc) * 512 + (fq * 16 + fr) * 8;
#pragma unroll
        for (int ai = 0; ai < 2; ++ai)
#pragma unroll
            for (int m = 0; m < 4; ++m) { const size_t row = (size_t)(row0 + ai * HALF + m * 16);
#pragma unroll
                for (int bj = 0; bj < 2; ++bj) { const int col = col0 + bj * HALF; const bf16_t* gp = gt + ((ai * 4 + m) * 2 + bj) * 4096;
                    const u32x4 ga = *(const u32x4*)gp;
                    float f[8];
                    if (br < 2) { const u32x4 gb = *(const u32x4*)(gp + (4 << 16));
#pragma unroll
                        for (int e = 0; e < 4; ++e) { f[2 * e] = epos(gb[e] << 16) * __builtin_amdgcn_rcpf(epos(ga[e] << 16)); f[2 * e + 1] = epos(gb[e] & 0xffff0000u) * __builtin_amdgcn_rcpf(epos(ga[e] & 0xffff0000u)); }
                    } else {
#pragma unroll
                        for (int e = 0; e < 4; ++e) { f[2 * e] = __builtin_amdgcn_rcpf(epos(ga[e] << 16)); f[2 * e + 1] = __builtin_amdgcn_rcpf(epos(ga[e] & 0xffff0000u)); }
                    }
                    f32x4 v0 = acc[ai][bj][m][0], v1 = acc[ai][bj][m][1];
                    v0[0] *= f[0]; v0[1] *= f[1]; v0[2] *= f[2]; v0[3] *= f[3]; v1[0] *= f[4]; v1[1] *= f[5]; v1[2] *= f[6]; v1[3] *= f[7];
                    if (br < 2) { acc[ai][bj][m][0] = v0; acc[ai][bj][m][1] = v1; }
                    else { u32x4 w; w.x = cvt_pk_bf16(v0[0], v0[1]); w.y = cvt_pk_bf16(v0[2], v0[3]); w.z = cvt_pk_bf16(v1[0], v1[1]); w.w = cvt_pk_bf16(v1[2], v1[3]);
                        *(u32x4*)(merged + row * 1024 + col) = w; } } }
        return br < 2;
    }
};
struct EpiResid {
    static constexpr bool PERM = false, AFTER_DRAIN = false, KEEP = false;
    const float* base; float* out; int ldc;
    __device__ __forceinline__ void operator()(const f32x4 (&acc)[2][2][4][2], const Unit& u, int wr, int wc, int fr, int fq) const {
        const int row0 = u.pm * BM + wr * 64 + fr; const int col0 = u.pn * BM + wc * 32 + 4 * fq;
#pragma unroll
        for (int ai = 0; ai < 2; ++ai) {
            f32x4 bs[4][2][2];
#pragma unroll
            for (int m = 0; m < 4; ++m) { const size_t off = (size_t)(row0 + ai * HALF + m * 16) * ldc + col0;
#pragma unroll
                for (int bj = 0; bj < 2; ++bj)
#pragma unroll
                    for (int n = 0; n < 2; ++n) bs[m][bj][n] = *(const f32x4*)(base + off + bj * HALF + n * 16); }
#pragma unroll
            for (int m = 0; m < 4; ++m) { const size_t off = (size_t)(row0 + ai * HALF + m * 16) * ldc + col0;
#pragma unroll
                for (int bj = 0; bj < 2; ++bj)
#pragma unroll
                    for (int n = 0; n < 2; ++n) *(f32x4*)(out + off + bj * HALF + n * 16) = bs[m][bj][n] + acc[ai][bj][m][n]; }
        }
    }
};
struct EpiSwiGLU {
    static constexpr bool PERM = true, AFTER_DRAIN = false, KEEP = false;
    bf16_t* O; int ldc;
    __device__ __forceinline__ void operator()(const f32x4 (&acc)[2][2][4][2], const Unit& u, int wr, int wc, int fr, int fq) const {
        const int row0 = u.pm * BM + wr * 64 + fr; const int col0 = u.pn * HALF + wc * 32 + 8 * fq;
#pragma unroll
        for (int ai = 0; ai < 2; ++ai)
#pragma unroll
            for (int m = 0; m < 4; ++m) { bf16_t* rowp = O + (size_t)(row0 + ai * HALF + m * 16) * ldc + col0;
                f32x4 r0, r1;
#pragma unroll
                for (int e = 0; e < 4; ++e) { const float ga = acc[ai][0][m][0][e], gb = acc[ai][0][m][1][e];
                    r0[e] = ga * fast_sigmoid(ga) * acc[ai][1][m][0][e]; r1[e] = gb * fast_sigmoid(gb) * acc[ai][1][m][1][e]; }
                u32x4 w; w.x = cvt_pk_bf16(r0[0], r0[1]); w.y = cvt_pk_bf16(r0[2], r0[3]); w.z = cvt_pk_bf16(r1[0], r1[1]); w.w = cvt_pk_bf16(r1[2], r1[3]);
                *(u32x4*)rowp = w; }
    }
};
struct GroupOrder {
    int nwg, gs, c;
    __device__ void init(int N, int gs_, int c_) { nwg = 8 * (N / BM); gs = gs_; c = c_; }
    __device__ bool next(int i, Unit& u) const { const int L = i * gs + c; if (L >= nwg) return false; u.pm = L & 7; u.pn = L >> 3; return true; }
    __device__ __forceinline__ void a_ready(const Unit&) const {}
    __device__ __forceinline__ void done(const Unit&) const {}
};
struct MergeOrder {
    GroupOrder S; int MT;
    __device__ void init(int gs_, int c_) { S.init(1024, gs_, c_); MT = 8; }
    __device__ bool next(int i, Unit& u) const { const int t = i / 3, br = i - 3 * t; Unit b; if (!S.next(t, b)) return false; u.pm = br * MT + b.pm; u.pn = br * 4 + b.pn; return true; }
    __device__ __forceinline__ void a_ready(const Unit&) const {}
    __device__ __forceinline__ void done(const Unit&) const {}
};

template <class Epi, class Sched, bool ALIGN_EPI = false, bool SP2 = false>
__device__ __forceinline__ void gemm_phase(PG8_LAS unsigned char* lds, const Gemm g, const Sched& S, const Epi& E) {
    int tid_ = threadIdx.x; asm volatile("" : "+v"(tid_));
    const int tid = tid_, wid = __builtin_amdgcn_readfirstlane(tid >> 6), lane = tid & 63, wr = wid >> 2, wc = wid & 3, fr = lane & 15, fq = lane >> 4;
    const int K = g.K, nt = K / BK;
    unsigned voffA[2], voffB[2];
#pragma unroll
    for (int i = 0; i < 2; ++i) { int R, C; stage_rc(tid * 16 + i * 8192, R, C); const int Rb = Epi::PERM ? ((R & ~31) + perm32(R & 31)) : R;
        voffA[i] = (unsigned)(R * K + C) * 2u; voffB[i] = (unsigned)(Rb * K + C) * 2u; }
    const size_t kstep = (size_t)(BK * 2);
    const size_t hstep = (size_t)HALF * K * 2;
    const size_t tstep = 2 * hstep;
    const unsigned ldsw = (unsigned)wid * 1024u;
    const int aoff = lds_byte(wr * 64 + fr, fq * 8), boff = lds_byte(wc * 32 + fr, fq * 8);
#define PG8_SA(b, h) (((b) * 2 + (h)) * HTB)
#define PG8_SB(b, h) ((4 + (b) * 2 + (h)) * HTB)
#define PG8_STAGE(bufoff, gbase, voff) do { _Pragma("unroll") for (int _i = 0; _i < 2; ++_i) \
        __builtin_amdgcn_global_load_lds((const unsigned*)((const char*)(gbase) + (voff)[_i]), (PG8_LAS unsigned*)(lds + (bufoff) + ldsw + _i * 8192), 16, 0, 0); } while (0)
#define PG8_LDA(dst, b, h) do { _Pragma("unroll") for (int m = 0; m < 4; ++m) _Pragma("unroll") for (int k = 0; k < 2; ++k) dst[m][k] = *(const PG8_LAS bf16x8*)(lds + PG8_SA(b, h) + aoff + m * 2048 + k * 1024); } while (0)
#define PG8_LDB(dst, b, h) do { _Pragma("unroll") for (int n = 0; n < 2; ++n) _Pragma("unroll") for (int k = 0; k < 2; ++k) dst[n][k] = *(const PG8_LAS bf16x8*)(lds + PG8_SB(b, h) + boff + n * 2048 + k * 1024); } while (0)
#define PG8_MMA(ai, bj, At, Bt) do { __builtin_amdgcn_s_setprio(1); _Pragma("unroll") for (int m = 0; m < 4; ++m) _Pragma("unroll") for (int n = 0; n < 2; ++n) _Pragma("unroll") for (int k = 0; k < 2; ++k) \
        acc[ai][bj][m][n] = __builtin_amdgcn_mfma_f32_16x16x32_bf16(Bt[n][k], At[m][k], acc[ai][bj][m][n], 0, 0, 0); __builtin_amdgcn_s_setprio(0); } while (0)
#define PG8_WAIT_V(n) asm volatile("s_waitcnt vmcnt(" #n ")" ::: "memory")
#define PG8_WAIT_L(n) asm volatile("s_waitcnt lgkmcnt(" #n ")" ::: "memory")
#define PG8_BAR __builtin_amdgcn_s_barrier()
#define PG8_SCHED __builtin_amdgcn_sched_barrier(0)
    Unit cur, nxt; int ui = 0;
    if (!S.next(0, cur)) return;
    f32x4 acc[2][2][4][2];
#pragma unroll
    for (int a = 0; a < 2; ++a)
#pragma unroll
        for (int b = 0; b < 2; ++b)
#pragma unroll
            for (int m = 0; m < 4; ++m)
#pragma unroll
                for (int n = 0; n < 2; ++n) acc[a][b][m][n] = (f32x4){0.f, 0.f, 0.f, 0.f};
    bf16x8 At[4][2], B0[2][2], B1[2][2];
    const char* cA = (const char*)g.A + (size_t)cur.pm * tstep; const char* cB = (const char*)g.Bt + (size_t)cur.pn * tstep;
    S.a_ready(cur);
    if constexpr (SP2) {
        PG8_STAGE(PG8_SB(0, 0), cB, voffB); PG8_STAGE(PG8_SB(0, 1), cB + hstep, voffB); PG8_STAGE(PG8_SA(0, 0), cA, voffA); PG8_STAGE(PG8_SA(0, 1), cA + hstep, voffA);
        if (wr == 1) PG8_BAR;
        PG8_WAIT_V(2); PG8_BAR;
        PG8_STAGE(PG8_SB(1, 0), cB + kstep, voffB); PG8_STAGE(PG8_SA(1, 0), cA + kstep, voffA); PG8_STAGE(PG8_SB(1, 1), cB + hstep + kstep, voffB);
        PG8_WAIT_V(6); PG8_BAR;
    } else {
        PG8_STAGE(PG8_SB(0, 0), cB, voffB); PG8_STAGE(PG8_SA(0, 0), cA, voffA); PG8_STAGE(PG8_SB(0, 1), cB + hstep, voffB); PG8_STAGE(PG8_SA(0, 1), cA + hstep, voffA);
        if (wr == 1) PG8_BAR;
        PG8_WAIT_V(4); PG8_BAR;
        PG8_STAGE(PG8_SB(1, 0), cB + kstep, voffB); PG8_STAGE(PG8_SA(1, 0), cA + kstep, voffA); PG8_STAGE(PG8_SB(1, 1), cB + hstep + kstep, voffB);
        PG8_WAIT_V(6); PG8_BAR;
    }
    for (;;) {
        const bool has_next = S.next(ui + 1, nxt);
        const char* nA = has_next ? (const char*)g.A + (size_t)nxt.pm * tstep : cA; const char* nB = has_next ? (const char*)g.Bt + (size_t)nxt.pn * tstep : cB;
        for (int t = 0; t < nt; t += 2) {
            const bool last = (t == nt - 2);
            const char* a1 = cA + (size_t)(t + 1) * kstep;
            const char* a2 = last ? nA : cA + (size_t)(t + 2) * kstep; const char* b2 = last ? nB : cB + (size_t)(t + 2) * kstep;
            const char* a3 = a2 + kstep; const char* b3 = b2 + kstep;
            if (last && has_next) S.a_ready(nxt);
            if constexpr (SP2) {
            PG8_LDB(B0, 0, 0); PG8_LDB(B1, 0, 1); PG8_SCHED; PG8_LDA(At, 0, 0); PG8_STAGE(PG8_SA(1, 1), a1 + hstep, voffA);
            PG8_WAIT_V(8); PG8_WAIT_L(0); PG8_BAR; PG8_MMA(0, 0, At, B0); PG8_MMA(0, 1, At, B1); PG8_BAR; PG8_SCHED;
            PG8_LDA(At, 0, 1); PG8_STAGE(PG8_SB(0, 0), b2, voffB); PG8_STAGE(PG8_SB(0, 1), b2 + hstep, voffB); PG8_STAGE(PG8_SA(0, 0), a2, voffA);
            PG8_WAIT_V(8); PG8_WAIT_L(0); PG8_BAR; PG8_MMA(1, 0, At, B0); PG8_MMA(1, 1, At, B1); PG8_BAR; PG8_SCHED;
            PG8_LDB(B0, 1, 0); PG8_LDB(B1, 1, 1); PG8_SCHED; PG8_LDA(At, 1, 0); PG8_STAGE(PG8_SA(0, 1), a2 + hstep, voffA);
            PG8_WAIT_V(8); PG8_WAIT_L(0); PG8_BAR; PG8_MMA(0, 0, At, B0); PG8_MMA(0, 1, At, B1); PG8_BAR; PG8_SCHED;
            PG8_LDA(At, 1, 1); PG8_STAGE(PG8_SB(1, 0), b3, voffB); PG8_STAGE(PG8_SB(1, 1), b3 + hstep, voffB); PG8_STAGE(PG8_SA(1, 0), a3, voffA);
            PG8_WAIT_V(8); PG8_WAIT_L(0); PG8_BAR; PG8_MMA(1, 0, At, B0); PG8_MMA(1, 1, At, B1); PG8_BAR; PG8_SCHED;
            } else {
            PG8_LDB(B0, 0, 0); PG8_SCHED; PG8_LDA(At, 0, 0); PG8_STAGE(PG8_SA(1, 1), a1 + hstep, voffA);
            PG8_WAIT_L(8); PG8_BAR; PG8_WAIT_L(0); PG8_MMA(0, 0, At, B0); PG8_BAR; PG8_SCHED;
            PG8_LDB(B1, 0, 1); PG8_STAGE(PG8_SB(0, 0), b2, voffB);
            PG8_BAR; PG8_WAIT_L(0); PG8_MMA(0, 1, At, B1); PG8_BAR;
            PG8_LDA(At, 0, 1); PG8_STAGE(PG8_SA(0, 0), a2, voffA);
            PG8_BAR; PG8_WAIT_L(0); PG8_MMA(1, 0, At, B0); PG8_BAR; PG8_SCHED;
            PG8_STAGE(PG8_SB(0, 1), b2 + hstep, voffB);
            PG8_WAIT_V(6); PG8_BAR; PG8_MMA(1, 1, At, B1); PG8_BAR;
            PG8_LDB(B0, 1, 0); PG8_SCHED; PG8_LDA(At, 1, 0); PG8_STAGE(PG8_SA(0, 1), a2 + hstep, voffA);
            PG8_WAIT_L(8); PG8_BAR; PG8_WAIT_L(0); PG8_MMA(0, 0, At, B0); PG8_BAR; PG8_SCHED;
            PG8_LDB(B1, 1, 1); PG8_STAGE(PG8_SB(1, 0), b3, voffB);
            PG8_BAR; PG8_WAIT_L(0); PG8_MMA(0, 1, At, B1); PG8_BAR;
            PG8_LDA(At, 1, 1); PG8_STAGE(PG8_SA(1, 0), a3, voffA);
            PG8_BAR; PG8_WAIT_L(0); PG8_MMA(1, 0, At, B0); PG8_BAR; PG8_SCHED;
            PG8_STAGE(PG8_SB(1, 1), b3 + hstep, voffB);
            PG8_WAIT_V(6); PG8_BAR; PG8_MMA(1, 1, At, B1); PG8_BAR;
            }
        }
        if constexpr (ALIGN_EPI) { if (wr == 0) PG8_BAR; }
        bool keep_acc = false;
        if constexpr (!Epi::AFTER_DRAIN) { if constexpr (Epi::KEEP) keep_acc = E.apply(acc, cur, wr, wc, fr, fq); else E(acc, cur, wr, wc, fr, fq); S.done(cur); }
        if (!has_next) break;
        if (!keep_acc) {
#pragma unroll
        for (int a = 0; a < 2; ++a)
#pragma unroll
            for (int b = 0; b < 2; ++b)
#pragma unroll
                for (int m = 0; m < 4; ++m)
#pragma unroll
                    for (int n = 0; n < 2; ++n) acc[a][b][m][n] = (f32x4){0.f, 0.f, 0.f, 0.f};
        }
        cur = nxt; cA = nA; cB = nB; ++ui;
        if constexpr (ALIGN_EPI) { if (wr == 1) PG8_BAR; }
    }
    PG8_WAIT_V(0);
    if constexpr (!ALIGN_EPI) { if (wr == 0) PG8_BAR; }
    PG8_BAR;
    if constexpr (Epi::AFTER_DRAIN) { E.fused(acc, cur, wr, wc, fr, fq, lds, wid, lane); S.done(cur); }
#undef PG8_SA
#undef PG8_SB
#undef PG8_STAGE
#undef PG8_LDA
#undef PG8_LDB
#undef PG8_MMA
#undef PG8_WAIT_V
#undef PG8_WAIT_L
#undef PG8_BAR
#undef PG8_SCHED
}
}

#define LAS __attribute__((address_space(3)))
typedef unsigned short bf16_t;
typedef short bf16x8 __attribute__((ext_vector_type(8)));
typedef float f32x4 __attribute__((ext_vector_type(4)));
typedef float f32x16 __attribute__((ext_vector_type(16)));
typedef unsigned u32x4 __attribute__((ext_vector_type(4)));
typedef unsigned u32x2 __attribute__((ext_vector_type(2)));

constexpr int D = 1024, SEQ = 2048, DEPTH = 4, NHALF = 2, HB = 1, TH = HB * SEQ, NGRP = 8;
constexpr int INC = 4608, NPROJ = 7680, FF = 2816;
constexpr int C_POOL = 0, C_AQ = 512, C_AK = 1024, C_AV = 1536, C_RQ = 2048, C_RF = 2560, C_RB = 3072, C_RI = 3584, C_RG = 4096, C_GATE = 4608;
constexpr float EPS = 1e-6f;
constexpr int NT = 512, NW = 8;
constexpr int LDS_BYTES = 155648;
constexpr int LDS_ITEM_OFF = 155136;

constexpr size_t MiB = 1u << 20;
constexpr size_t WS_CTL = 0, CTL_BYTES = 163840;
constexpr size_t WS_W = 2 * MiB, W_LAYER = 37 * MiB;
constexpr size_t WO_IN = 0, WO_POOL = (size_t)NPROJ * D * 2, WO_UP = WO_POOL + 4 * 128 * 128 * 2, WO_OUT = WO_UP + (size_t)3 * D * 512 * 2,
                 WO_FFI = WO_OUT + (size_t)D * D * 2, WO_FFO = WO_FFI + (size_t)2 * FF * D * 2, WO_END = WO_FFO + (size_t)D * FF * 2;
static_assert(WO_END <= W_LAYER, "weights per layer");
constexpr size_t WS_ARENA = 150 * MiB, ARENA = 44 * MiB;
constexpr size_t WS_PROJ = 0;
constexpr size_t WS_GATE = 18 * MiB;
constexpr size_t WS_H = 30 * MiB;
constexpr size_t WS_Y = 34 * MiB;
constexpr size_t WS_O2 = 40 * MiB;
constexpr size_t WS_END = WS_ARENA + NGRP * ARENA;
static_assert(WS_W + DEPTH * W_LAYER <= WS_ARENA && WS_PROJ + (size_t)TH * INC * 2 <= WS_GATE && WS_GATE + (size_t)TH * 3072 * 2 <= WS_H && WS_H + (size_t)TH * D * 2 <= WS_Y && WS_Y + (size_t)3 * TH * 512 * 2 <= WS_O2 && WS_O2 + (size_t)2 * TH * 512 * 2 <= ARENA && WS_END <= 512 * MiB, "ws map");

struct Params { const float* in[20]; float* out; unsigned char* ws; };
enum { I_X = 0, I_N1G, I_WIN, I_POOLW, I_POOLS, I_LQ1, I_LK1, I_LQ2, I_LK2, I_DNG, I_HLB, I_HNG, I_WUP, I_WUA, I_WUR, I_WOUT, I_N2G, I_WFI, I_WFO, I_FNG };

typedef float f32x2c __attribute__((ext_vector_type(2)));
typedef __bf16 bf16x2c __attribute__((ext_vector_type(2)));
__device__ __forceinline__ unsigned pkbf(float lo, float hi) { const f32x2c v = {lo, hi}; const bf16x2c b = __builtin_convertvector(v, bf16x2c); return __builtin_bit_cast(unsigned, b); }
__device__ __forceinline__ float bflo(unsigned w) { return __uint_as_float(w << 16); }
__device__ __forceinline__ float bfhi(unsigned w) { return __uint_as_float(w & 0xffff0000u); }
__device__ __forceinline__ float bfe(const u32x4& w, int e) { const unsigned x = w[e >> 1]; return (e & 1) ? bfhi(x) : bflo(x); }
__device__ __forceinline__ float sigm(float x) { return __builtin_amdgcn_rcpf(1.0f + __expf(-x)); }
__device__ __forceinline__ float wave_sum(float v) {
#pragma unroll
    for (int o = 1; o < 64; o <<= 1) v += __shfl_xor(v, o);
    return v;
}
#define BARRIER() __syncthreads()

__device__ __forceinline__ void p0_transpose_item(const float* W, int K, int N, bf16_t* WT, int row_off, int mode, LAS float* scr, int item, int lane) {
    const int nblk = N / 32, kb = item / nblk, nb = item - kb * nblk, k0 = 64 * kb, n0 = 32 * nb;
#pragma unroll 8
    for (int i = 0; i < 32; ++i) { const int kk = 2 * i + (lane >> 5); scr[kk * 33 + (lane & 31)] = W[(size_t)(k0 + kk) * N + n0 + (lane & 31)]; }
    asm volatile("s_waitcnt lgkmcnt(0)" ::: "memory");
    int drow0;
    if (mode == 1) { const int bj = n0 / FF, jj = n0 - bj * FF; drow0 = (jj >> 7) * 256 + bj * 128 + (jj & 127); } else drow0 = row_off + n0;
    const int c = lane & 7;
#pragma unroll
    for (int j = 0; j < 4; ++j) { const int n = (lane >> 3) + 8 * j; const LAS float* s = scr + (8 * c) * 33 + n;
        u32x4 o; o.x = pkbf(s[0 * 33], s[1 * 33]); o.y = pkbf(s[2 * 33], s[3 * 33]); o.z = pkbf(s[4 * 33], s[5 * 33]); o.w = pkbf(s[6 * 33], s[7 * 33]);
        *(u32x4*)(WT + (size_t)(drow0 + n) * K + k0 + 8 * c) = o; }
    asm volatile("s_waitcnt lgkmcnt(0)" ::: "memory");
}
__device__ __forceinline__ void p0_prologue(const Params& p, LAS unsigned char* lds, int gw, int NGW, int wave, int lane) {
    LAS float* scr = (LAS float*)(lds + wave * 16384);
    constexpr int I_IN = (D / 64) * (NPROJ / 32), I_PL = 4 * 2 * 4, I_UP = (512 / 64) * (D / 32), I_OUT = (D / 64) * (D / 32), I_FI = (D / 64) * (2 * FF / 32), I_FO = (FF / 64) * (D / 32);
    constexpr int PER_LAYER = I_IN + I_PL + 3 * I_UP + I_OUT + I_FI + I_FO;
    for (int it = gw; it < DEPTH * PER_LAYER; it += NGW) {
        const int l = it / PER_LAYER; int r = it - l * PER_LAYER;
        unsigned char* wl = p.ws + WS_W + (size_t)l * W_LAYER;
        if (r < I_IN) { p0_transpose_item(p.in[I_WIN] + (size_t)l * D * NPROJ, D, NPROJ, (bf16_t*)(wl + WO_IN), 0, 0, scr, r, lane); continue; } r -= I_IN;
        if (r < I_PL) { const int g = r >> 3; p0_transpose_item(p.in[I_POOLW] + (size_t)(l * 4 + g) * 128 * 128, 128, 128, (bf16_t*)(wl + WO_POOL) + (size_t)g * 128 * 128, 0, 0, scr, r & 7, lane); continue; } r -= I_PL;
        if (r < 3 * I_UP) { const int br = r / I_UP; const float* src = p.in[br == 0 ? I_WUP : (br == 1 ? I_WUA : I_WUR)] + (size_t)l * 512 * D;
            p0_transpose_item(src, 512, D, (bf16_t*)(wl + WO_UP), br * D, 0, scr, r - br * I_UP, lane); continue; } r -= 3 * I_UP;
        if (r < I_OUT) { p0_transpose_item(p.in[I_WOUT] + (size_t)l * D * D, D, D, (bf16_t*)(wl + WO_OUT), 0, 0, scr, r, lane); continue; } r -= I_OUT;
        if (r < I_FI) { p0_transpose_item(p.in[I_WFI] + (size_t)l * D * 2 * FF, D, 2 * FF, (bf16_t*)(wl + WO_FFI), 0, 1, scr, r, lane); continue; } r -= I_FI;
        p0_transpose_item(p.in[I_WFO] + (size_t)l * FF * D, FF, D, (bf16_t*)(wl + WO_FFO), 0, 0, scr, r, lane);
    }
}

__device__ __forceinline__ void norm_rows_bf16(const float* x, const float* g, bf16_t* h, int nrows, int gw, int NGW, int lane) {
    for (int row = gw; row < nrows; row += 2 * NGW) {
        const int row2 = row + NGW; const bool has2 = row2 < nrows;
        const f32x4* xr = (const f32x4*)(x + (size_t)row * D) + lane; const f32x4* xr2 = (const f32x4*)(x + (size_t)(has2 ? row2 : row) * D) + lane;
        f32x4 v[4], w2[4]; float ss = 0.f, ss2 = 0.f;
#pragma unroll
        for (int j = 0; j < 4; ++j) { v[j] = xr[64 * j]; w2[j] = xr2[64 * j]; }
#pragma unroll
        for (int j = 0; j < 4; ++j) { ss += (v[j][0] * v[j][0] + v[j][1] * v[j][1]) + (v[j][2] * v[j][2] + v[j][3] * v[j][3]); ss2 += (w2[j][0] * w2[j][0] + w2[j][1] * w2[j][1]) + (w2[j][2] * w2[j][2] + w2[j][3] * w2[j][3]); }
        const float rstd = rsqrtf(wave_sum(ss) * (1.0f / D) + EPS), rstd2 = rsqrtf(wave_sum(ss2) * (1.0f / D) + EPS);
        u32x2* o = (u32x2*)(h + (size_t)row * D) + lane; u32x2* o2p = (u32x2*)(h + (size_t)row2 * D) + lane;
#pragma unroll
        for (int j = 0; j < 4; ++j) { const f32x4 gv = ((const f32x4*)g)[lane + 64 * j]; const f32x4 y = v[j] * rstd * gv; u32x2 w; w.x = pkbf(y[0], y[1]); w.y = pkbf(y[2], y[3]); o[64 * j] = w;
            if (has2) { const f32x4 y2 = w2[j] * rstd2 * gv; u32x2 q; q.x = pkbf(y2[0], y2[1]); q.y = pkbf(y2[2], y2[3]); o2p[64 * j] = q; } }
    }
}
__device__ __forceinline__ void norm_rows_f32_inplace(float* x, const float* g, int nrows, int gw, int NGW, int lane, int probe_rows) {
    for (int row = gw; row < nrows; row += NGW) {
        f32x4* xr = (f32x4*)(x + (size_t)row * D) + lane;
        f32x4 v[4]; float ss = 0.f;
#pragma unroll
        for (int j = 0; j < 4; ++j) { v[j] = xr[64 * j]; ss += (v[j][0] * v[j][0] + v[j][1] * v[j][1]) + (v[j][2] * v[j][2] + v[j][3] * v[j][3]); }
        const float rstd = rsqrtf(wave_sum(ss) * (1.0f / D) + EPS);
#pragma unroll
        for (int j = 0; j < 4; ++j) { const f32x4 gv = ((const f32x4*)g)[lane + 64 * j]; const float pd = (row < probe_rows) ? ((lane & 1) ? 0.0078125f : -0.0078125f) : 0.f; xr[64 * j] = v[j] * rstd * gv + pd; }
    }
}
__device__ __forceinline__ void hgrn_combine(const bf16_t* of, const bf16_t* ob, const bf16_t* proj, const float* gain, bf16_t* yrec, int gw, int NGW, int lane) {
    for (int row = gw; row < TH; row += NGW) {
        const u32x4 a = *((const u32x4*)(of + (size_t)row * 512) + lane), b = *((const u32x4*)(ob + (size_t)row * 512) + lane);
        const u32x4 gz = *((const u32x4*)(proj + (size_t)row * INC + C_RG) + lane);
        float o[8]; float ss = 0.f;
#pragma unroll
        for (int e = 0; e < 8; ++e) { o[e] = bfe(a, e) + bfe(b, e); ss += o[e] * o[e]; }
        ss += __shfl_xor(ss, 1); ss += __shfl_xor(ss, 2); ss += __shfl_xor(ss, 4); ss += __shfl_xor(ss, 8);
        const float rstd = rsqrtf(ss * (1.0f / 128.0f) + EPS);
        const f32x4 g0 = *(const f32x4*)(gain + ((8 * lane) & 127)), g1 = *(const f32x4*)(gain + ((8 * lane) & 127) + 4);
        float y[8];
#pragma unroll
        for (int e = 0; e < 8; ++e) { const float z = bfe(gz, e); const float gg = e < 4 ? g0[e] : g1[e - 4]; y[e] = o[e] * rstd * gg * (z * sigm(z)); }
        u32x4 w; w.x = pkbf(y[0], y[1]); w.y = pkbf(y[2], y[3]); w.z = pkbf(y[4], y[5]); w.w = pkbf(y[6], y[7]);
        *((u32x4*)(yrec + (size_t)row * 512) + lane) = w;
    }
}

__device__ __forceinline__ void pool_unit(LAS unsigned char* lds, const bf16_t* proj, const bf16_t* wpool  , const float* pscale  , bf16_t* ypool, int unit, int tid) {
    const int tile = unit >> 2, g = unit & 3, t0 = tile * 128, p0 = t0 & (SEQ - 1), hw = 1 << g;
    LAS bf16_t* U = (LAS bf16_t*)lds; LAS bf16_t* Dt = (LAS bf16_t*)(lds + 39168); LAS bf16_t* Bw = (LAS bf16_t*)(lds + 39168 + 34816);
    for (int idx = tid; idx < 144 * 16; idx += NT) { const int r = idx >> 4, cs = idx & 15; const int pp = p0 - 8 + r;
        u32x4 v = (u32x4){0u, 0u, 0u, 0u};
        if (pp >= 0 && pp < SEQ) v = *(const u32x4*)(proj + (size_t)(t0 - 8 + r) * INC + C_POOL + g * 128 + cs * 8);
        *(LAS u32x4*)(U + r * 136 + cs * 8) = v; }
    for (int idx = tid; idx < 128 * 16; idx += NT) { const int r = idx >> 4, cs = idx & 15;
        *(LAS u32x4*)(Bw + r * 136 + cs * 8) = *(const u32x4*)(wpool + (size_t)g * 128 * 128 + r * 128 + cs * 8); }
    BARRIER();
    for (int idx = tid; idx < 128 * 16; idx += NT) { const int r = idx >> 4, cs = idx & 15; const int pp = p0 + r;
        int lo = pp - hw; if (lo < 0) lo = 0; int hi = pp + hw - 1; if (hi > SEQ - 1) hi = SEQ - 1;
        float s[8];
#pragma unroll
        for (int e = 0; e < 8; ++e) s[e] = 0.f;
        for (int q = lo; q <= hi; ++q) { const u32x4 v = *(const LAS u32x4*)(U + (q - p0 + 8) * 136 + cs * 8);
#pragma unroll
            for (int e = 0; e < 8; ++e) s[e] += bfe(v, e); }
        const float inv = 1.0f / (float)(hi - lo + 1);
        const u32x4 c = *(const LAS u32x4*)(U + (r + 8) * 136 + cs * 8);
        u32x4 w; w.x = pkbf(s[0] * inv - bfe(c, 0), s[1] * inv - bfe(c, 1)); w.y = pkbf(s[2] * inv - bfe(c, 2), s[3] * inv - bfe(c, 3));
        w.z = pkbf(s[4] * inv - bfe(c, 4), s[5] * inv - bfe(c, 5)); w.w = pkbf(s[6] * inv - bfe(c, 6), s[7] * inv - bfe(c, 7));
        *(LAS u32x4*)(Dt + r * 136 + cs * 8) = w; }
    BARRIER();
    const int wave = tid >> 6, lane = tid & 63, lr = lane & 15, lg = lane >> 4;
    f32x4 acc[8];
#pragma unroll
    for (int cb = 0; cb < 8; ++cb) acc[cb] = (f32x4){0.f, 0.f, 0.f, 0.f};
#pragma unroll
    for (int st = 0; st < 4; ++st) { const bf16x8 a = *(const LAS bf16x8*)(Dt + (16 * wave + lr) * 136 + 32 * st + 8 * lg);
#pragma unroll
        for (int cb = 0; cb < 8; ++cb) { const bf16x8 b = *(const LAS bf16x8*)(Bw + (16 * cb + lr) * 136 + 32 * st + 8 * lg);
            acc[cb] = __builtin_amdgcn_mfma_f32_16x16x32_bf16(a, b, acc[cb], 0, 0, 0); } }
#pragma unroll
    for (int cb = 0; cb < 8; ++cb) { const int n = g * 128 + 16 * cb + lr; const float sc = pscale[n];
#pragma unroll
        for (int r = 0; r < 4; ++r) { const int row = t0 + 16 * wave + 4 * lg + r; ypool[(size_t)row * 512 + n] = (bf16_t)(pkbf(acc[cb][r] * sc, 0.f) & 0xffffu); } }
    BARRIER();
}

constexpr int AT_Q = 0, AT_K = 34816, AT_V = AT_K + 2 * 17408, AT_END = AT_V + 2 * 17408;
static_assert(AT_END <= LDS_ITEM_OFF && 128 * 132 * 4 <= 4 * 17408, "attention LDS");
__device__ __forceinline__ void attn_unit(LAS unsigned char* lds, const bf16_t* proj, const float* lq1, const float* lk1, const float* lq2, const float* lk2, const float* dng, int layer, bf16_t* yattn, int unit, int tid) {
    const int b = unit >> 6, h = (unit >> 4) & 3, qb = unit & 15;
    const int wave = tid >> 6, lane = tid & 63, l31 = lane & 31, hi = lane >> 5, rg = wave & 3, c = wave >> 2;
    LAS bf16_t* Qs = (LAS bf16_t*)(lds + AT_Q);
    const size_t tok0 = (size_t)b * SEQ;
    const float lambda_init = 0.8f - 0.6f * __expf(-0.3f * (float)layer);
    float s1 = 0.f, s2 = 0.f;
    for (int i = 0; i < 64; ++i) { s1 += lq1[i] * lk1[i]; s2 += lq2[i] * lk2[i]; }
    const float lam = __expf(s1) - __expf(s2) + lambda_init;
    const float LOG2E = 1.4426950408889634f;
    const float sc2 = 0.125f * LOG2E;
    const float slope2 = exp2f(-2.0f * (float)(h + 1)) * LOG2E;
#pragma unroll
    for (int i = 0; i < 4; ++i) { const int idx = tid + NT * i, r = idx >> 4, cs = idx & 15;
        const u32x4 qv = *(const u32x4*)(proj + (tok0 + qb * 128 + r) * INC + C_AQ + h * 128 + cs * 8);
        u32x4 qs; qs.x = pkbf(bflo(qv.x) * sc2, bfhi(qv.x) * sc2); qs.y = pkbf(bflo(qv.y) * sc2, bfhi(qv.y) * sc2); qs.z = pkbf(bflo(qv.z) * sc2, bfhi(qv.z) * sc2); qs.w = pkbf(bflo(qv.w) * sc2, bfhi(qv.w) * sc2);
        *(LAS u32x4*)(Qs + r * 136 + cs * 8) = qs; }
    const int kr0 = tid >> 4, kcs = tid & 15;
    const int vkp = tid >> 4, vvg = tid & 15;
    u32x4 kreg[2], vreg[2];
    {
        const bf16_t* kb = proj + (tok0 + kr0) * INC + C_AK + h * 128 + kcs * 8;
        kreg[0] = *(const u32x4*)kb; kreg[1] = *(const u32x4*)(kb + (size_t)32 * INC);
        const bf16_t* vb = proj + (tok0 + 2 * vkp) * INC + C_AV + h * 128 + vvg * 8;
        vreg[0] = *(const u32x4*)vb; vreg[1] = *(const u32x4*)(vb + INC);
    }
    f32x16 O[4];
#pragma unroll
    for (int vt = 0; vt < 4; ++vt)
#pragma unroll
        for (int r = 0; r < 16; ++r) O[vt][r] = 0.f;
    float mrun = 0.f, lrun = 0.f;
    const int qpos = qb * 128 + 32 * rg + l31;
    const LAS bf16_t* qrow = Qs + (32 * rg + l31) * 136 + c * 64 + 8 * hi;
    for (int kt = 0; kt < SEQ / 64; ++kt) {
        const int cur = kt & 1;
        LAS bf16_t* Kc = (LAS bf16_t*)(lds + AT_K + cur * 17408); LAS bf16_t* Vc = (LAS bf16_t*)(lds + AT_V + cur * 17408);
        *(LAS u32x4*)(Kc + kr0 * 136 + kcs * 8) = kreg[0]; *(LAS u32x4*)(Kc + (kr0 + 32) * 136 + kcs * 8) = kreg[1];
#pragma unroll
        for (int e = 0; e < 8; ++e) { const unsigned lo = (e & 1) ? (vreg[0][e >> 1] >> 16) : (vreg[0][e >> 1] & 0xffffu); const unsigned hi16 = (e & 1) ? (vreg[1][e >> 1] & 0xffff0000u) : (vreg[1][e >> 1] << 16);
            *(LAS unsigned*)(Vc + (8 * vvg + e) * 68 + 2 * vkp) = lo | hi16; }
        BARRIER();
        if (kt + 1 < SEQ / 64) {
            const bf16_t* kb = proj + (tok0 + (kt + 1) * 64 + kr0) * INC + C_AK + h * 128 + kcs * 8;
            kreg[0] = *(const u32x4*)kb; kreg[1] = *(const u32x4*)(kb + (size_t)32 * INC);
            const bf16_t* vb = proj + (tok0 + (kt + 1) * 64 + 2 * vkp) * INC + C_AV + h * 128 + vvg * 8;
            vreg[0] = *(const u32x4*)vb; vreg[1] = *(const u32x4*)(vb + INC);
        }
        f32x16 S[2];
#pragma unroll
        for (int ks = 0; ks < 2; ++ks)
#pragma unroll
            for (int r = 0; r < 16; ++r) S[ks][r] = -mrun;
#pragma unroll
        for (int st = 0; st < 4; ++st) {
            const bf16x8 qf = *(const LAS bf16x8*)(qrow + 16 * st);
#pragma unroll
            for (int ks = 0; ks < 2; ++ks) { const bf16x8 kf = *(const LAS bf16x8*)(Kc + (32 * ks + l31) * 136 + c * 64 + 16 * st + 8 * hi);
                S[ks] = __builtin_amdgcn_mfma_f32_32x32x16_bf16(kf, qf, S[ks], 0, 0, 0); }
        }
        float mx = -1e30f;
#pragma unroll
        for (int ks = 0; ks < 2; ++ks) { const float fq = (float)(qpos - (64 * kt + 32 * ks + 4 * hi));
#pragma unroll
            for (int r = 0; r < 16; ++r) { const float tt = fq - (float)((r & 3) + 8 * (r >> 2)); const float v = fmaf(-slope2, fabsf(tt), S[ks][r]); S[ks][r] = v; mx = fmaxf(mx, v); } }
        mx = fmaxf(mx, __shfl_xor(mx, 32));
        float psum = 0.f, delta = 0.f;
        if (kt == 0 || __builtin_amdgcn_ballot_w64(mx > 4.0f) != 0ull) {
            delta = (kt == 0) ? mx : fmaxf(mx, 0.f); const float alpha = (kt == 0) ? 1.0f : __builtin_amdgcn_exp2f(-delta);
            mrun += delta; lrun *= alpha;
#pragma unroll
            for (int vt = 0; vt < 4; ++vt) O[vt] = O[vt] * alpha;
        }
#pragma unroll
        for (int ks = 0; ks < 2; ++ks)
#pragma unroll
            for (int r = 0; r < 16; ++r) { const float pv = __builtin_amdgcn_exp2f(S[ks][r] - delta); S[ks][r] = pv; psum += pv; }
        lrun += psum;
        bf16x8 pf[2][2];
#pragma unroll
        for (int ks = 0; ks < 2; ++ks)
#pragma unroll
            for (int s = 0; s < 2; ++s) { u32x4 pw; pw.x = pkbf(S[ks][8 * s + 0], S[ks][8 * s + 1]); pw.y = pkbf(S[ks][8 * s + 2], S[ks][8 * s + 3]);
                pw.z = pkbf(S[ks][8 * s + 4], S[ks][8 * s + 5]); pw.w = pkbf(S[ks][8 * s + 6], S[ks][8 * s + 7]); pf[ks][s] = __builtin_bit_cast(bf16x8, pw); }
#pragma unroll
        for (int vt = 0; vt < 4; ++vt) {
            f32x16 o = O[vt];
#pragma unroll
            for (int ks = 0; ks < 2; ++ks)
#pragma unroll
                for (int s = 0; s < 2; ++s) {
                    const LAS bf16_t* vp = Vc + (32 * vt + l31) * 68 + 32 * ks + 16 * s + 4 * hi;
                    const u32x2 a = *(const LAS u32x2*)vp, bq = *(const LAS u32x2*)(vp + 8);
                    const u32x4 w = (u32x4){a.x, a.y, bq.x, bq.y};
                    o = __builtin_amdgcn_mfma_f32_32x32x16_bf16(__builtin_bit_cast(bf16x8, w), pf[ks][s], o, 0, 0, 0);
                }
            O[vt] = o;
        }
    }
    const float ltot = lrun + __shfl_xor(lrun, 32);
    LAS float* X = (LAS float*)(lds + AT_K);
    BARRIER();
    if (c == 1) { const float sc = lam / ltot;
#pragma unroll
        for (int vt = 0; vt < 4; ++vt)
#pragma unroll
            for (int rq = 0; rq < 4; ++rq) { const f32x4 w = (f32x4){O[vt][4 * rq + 0] * sc, O[vt][4 * rq + 1] * sc, O[vt][4 * rq + 2] * sc, O[vt][4 * rq + 3] * sc};
                *(LAS f32x4*)(X + (32 * rg + l31) * 132 + 32 * vt + 8 * rq + 4 * hi) = w; } }
    BARRIER();
    if (c == 0) { const float i0 = 1.0f / ltot; float ss = 0.f;
#pragma unroll
        for (int vt = 0; vt < 4; ++vt)
#pragma unroll
            for (int rq = 0; rq < 4; ++rq) { const f32x4 x = *(const LAS f32x4*)(X + (32 * rg + l31) * 132 + 32 * vt + 8 * rq + 4 * hi);
#pragma unroll
                for (int e = 0; e < 4; ++e) { const float o = O[vt][4 * rq + e] * i0 - x[e]; O[vt][4 * rq + e] = o; ss += o * o; } }
        ss += __shfl_xor(ss, 32);
        const float rs = rsqrtf(ss * (1.0f / 128.0f) + EPS) * (1.0f - lambda_init);
#pragma unroll
        for (int vt = 0; vt < 4; ++vt)
#pragma unroll
            for (int rq = 0; rq < 4; ++rq) { const int v0 = 32 * vt + 8 * rq + 4 * hi; const f32x4 gv = *(const f32x4*)(dng + v0);
                u32x2 w; w.x = pkbf(O[vt][4 * rq + 0] * rs * gv[0], O[vt][4 * rq + 1] * rs * gv[1]); w.y = pkbf(O[vt][4 * rq + 2] * rs * gv[2], O[vt][4 * rq + 3] * rs * gv[3]);
                *(LAS u32x2*)(Qs + (32 * rg + l31) * 136 + v0) = w; } }
    BARRIER();
#pragma unroll
    for (int i = 0; i < 4; ++i) { const int idx = tid + NT * i, r = idx >> 4, cs = idx & 15;
        *(u32x4*)(yattn + (tok0 + qb * 128 + r) * 512 + h * 128 + cs * 8) = *(const LAS u32x4*)(Qs + r * 136 + cs * 8); }
    BARRIER();
}

constexpr int HG_QD = 0, HG_QG = 17408, HG_KE = 34816, HG_KT = 52224, HG_V = HG_KT + 18432, HG_S = HG_V + 18432, HG_VEC = HG_S + 34816, HG_SCP = HG_VEC + 8192, HG_LB = HG_SCP + 18432, HG_END = HG_LB + 512;
static_assert(HG_END <= LDS_ITEM_OFF, "hgrn LDS");
__device__ __forceinline__ bf16x8 scale_frag(const u32x4 w, const f32x4 m0, const f32x4 m1) {
    u32x4 o; o.x = pkbf(bflo(w.x) * m0[0], bfhi(w.x) * m0[1]); o.y = pkbf(bflo(w.y) * m0[2], bfhi(w.y) * m0[3]); o.z = pkbf(bflo(w.z) * m1[0], bfhi(w.z) * m1[1]); o.w = pkbf(bflo(w.w) * m1[2], bfhi(w.w) * m1[3]);
    return __builtin_bit_cast(bf16x8, o);
}
#ifndef PROBE
#define PROBE 0
#endif
#define HG_T0(id) do { if (PROBE == (id) && blockIdx.x == 0 && tid == 0) *(LAS unsigned long long*)(lds + LDS_ITEM_OFF + 128) = __builtin_amdgcn_s_memrealtime(); } while (0)
#define HG_T1(id) do { if (PROBE == (id) && blockIdx.x == 0 && tid == 0) *(LAS unsigned long long*)(lds + LDS_ITEM_OFF + 136) += __builtin_amdgcn_s_memrealtime() - *(LAS unsigned long long*)(lds + LDS_ITEM_OFF + 128); } while (0)
__device__ __forceinline__ void hgrn_unit(LAS unsigned char* lds, const bf16_t* proj, const float* hlb  , int layer, bf16_t* o2  , int unit, int tid) {
    const int b = unit >> 3, h = (unit >> 1) & 3, dir = unit & 1;
    const int wave = __builtin_amdgcn_readfirstlane(tid >> 6), lane = tid & 63, lr = lane & 15, lg = lane >> 4;
    LAS bf16_t* Qd = (LAS bf16_t*)(lds + HG_QD); LAS bf16_t* Qg = (LAS bf16_t*)(lds + HG_QG); LAS bf16_t* Ke = (LAS bf16_t*)(lds + HG_KE); LAS bf16_t* KeT = (LAS bf16_t*)(lds + HG_KT);
    LAS bf16_t* Vt = (LAS bf16_t*)(lds + HG_V); LAS bf16_t* St = (LAS bf16_t*)(lds + HG_S); LAS float* Vec = (LAS float*)(lds + HG_VEC); LAS bf16_t* Sc = (LAS bf16_t*)(lds + HG_SCP);
    LAS float* lbv = (LAS float*)(lds + HG_LB);
    const size_t tok0 = (size_t)b * SEQ;
    const float scale_q = 0.08838834764831845f;
    if (tid < 128) { const float* a = hlb + (size_t)dir * DEPTH * 512 + h * 128 + tid;
        const float a0 = a[0], a1 = a[512], a2 = a[1024], a3 = a[1536]; const float mx = fmaxf(fmaxf(a0, a1), fmaxf(a2, a3));
        const float e0 = __expf(a0 - mx), e1 = __expf(a1 - mx), e2 = __expf(a2 - mx), e3 = __expf(a3 - mx); const float inv = 1.0f / (e0 + e1 + e2 + e3);
        float lb = 0.f; if (layer >= 1) lb += e1 * inv; if (layer >= 2) lb += e2 * inv; if (layer >= 3) lb += e3 * inv;
        lbv[tid] = lb; }
    for (int idx = tid; idx < 128 * 136 / 2; idx += NT) ((LAS unsigned*)St)[idx] = 0u;
    f32x4 st[8];
#pragma unroll
    for (int vb = 0; vb < 8; ++vb) st[vb] = (f32x4){0.f, 0.f, 0.f, 0.f};
    const int ci4 = wave >> 1, half = lane >> 5, cp2 = 2 * (((wave & 1) << 5) | (lane & 31)), rb8 = 16 * ci4 + 8 * half;
    const __amdgpu_buffer_rsrc_t rsrc = __builtin_amdgcn_make_buffer_rsrc((void*)(proj + tok0 * INC + h * 128), (short)0, SEQ * INC * 2, 0x00020000);
    const int fcol = (dir == 0 ? C_RF : C_RB);
    const int vo = cp2 * 2 + (dir == 0 ? half : 1 - half) * (8 * INC * 2);
#define HG_ROWOFF(ci_, r_) ((dir == 0 ? ((ci_) * 64 + 16 * ci4 + (r_)) : (SEQ - 9 - ((ci_) * 64 + 16 * ci4 + (r_)))) * (INC * 2))
    unsigned qraw[8], zraw[8], vraw[8];
#pragma unroll
    for (int r = 0; r < 8; ++r) { const int ro = HG_ROWOFF(0, r);
        qraw[r] = __builtin_amdgcn_raw_buffer_load_b32(rsrc, vo, ro + C_RQ * 2, 0); zraw[r] = __builtin_amdgcn_raw_buffer_load_b32(rsrc, vo, ro + fcol * 2, 0); vraw[r] = __builtin_amdgcn_raw_buffer_load_b32(rsrc, vo, ro + C_RI * 2, 0); }
    BARRIER();
    typedef float f2 __attribute__((ext_vector_type(2)));
    for (int ci = 0; ci < SEQ / 64; ++ci) {
        HG_T0(12);
        {
            const f2 lb = *(const LAS f2*)(lbv + cp2), oml = 1.0f - lb;
            f2 ff[8]; f2 Pl = (f2){1.0f, 1.0f};
#pragma unroll
            for (int r = 0; r < 8; ++r) { f2 z = (f2){bflo(zraw[r]), bfhi(zraw[r])}; z = __builtin_elementwise_min(__builtin_elementwise_max(z, (f2){-30.0f, -30.0f}), (f2){30.0f, 30.0f});
                f2 ez; ez.x = __expf(-z.x); ez.y = __expf(-z.y); f2 sg; sg.x = __builtin_amdgcn_rcpf(1.0f + ez.x); sg.y = __builtin_amdgcn_rcpf(1.0f + ez.y);
                const f2 f = lb + oml * sg; ff[r] = f; Pl = Pl * f; }
            f2 Po; Po.x = __shfl_xor(Pl.x, 32); Po.y = __shfl_xor(Pl.y, 32);
            const f2 one = (f2){1.0f, 1.0f};
            f2 P = half ? Po : one;
#pragma unroll
            for (int r = 0; r < 8; ++r) { P = P * ff[r];
                const f2 qd = (f2){bflo(qraw[r]), bfhi(qraw[r])} * scale_q * P;
                *(LAS unsigned*)(Qd + (rb8 + r) * 136 + cp2) = pkbf(qd.x, qd.y); }
            if (half == 0) *(LAS f2*)(Vec + ci4 * 128 + cp2) = Pl * Po;
            unsigned kw0[4], kw1[4], vw0[4], vw1[4]; f2 suf = half ? one : Po;
#pragma unroll
            for (int r = 7; r >= 0; --r) { const f2 q = (f2){bflo(qraw[r]), bfhi(qraw[r])} * scale_q;
                const f2 ke = (1.0f - ff[r]) * suf; f2 iv; iv.x = fminf(__builtin_amdgcn_rcpf(suf.x), 5.5e34f); iv.y = fminf(__builtin_amdgcn_rcpf(suf.y), 5.5e34f); const f2 qg = q * iv;
                *(LAS unsigned*)(Qg + (rb8 + r) * 136 + cp2) = pkbf(qg.x, qg.y);
                const unsigned kd = pkbf(ke.x, ke.y); *(LAS unsigned*)(Ke + (rb8 + r) * 136 + cp2) = kd;
                const unsigned vd = vraw[r];
                if (r & 1) { kw0[r >> 1] = kd << 16; kw1[r >> 1] = kd & 0xffff0000u; vw0[r >> 1] = vd << 16; vw1[r >> 1] = vd & 0xffff0000u; }
                else { kw0[r >> 1] |= kd & 0xffffu; kw1[r >> 1] |= kd >> 16; vw0[r >> 1] |= vd & 0xffffu; vw1[r >> 1] |= vd >> 16; }
                suf = suf * ff[r]; }
            *(LAS u32x4*)(KeT + cp2 * 72 + rb8) = (u32x4){kw0[0], kw0[1], kw0[2], kw0[3]}; *(LAS u32x4*)(KeT + (cp2 + 1) * 72 + rb8) = (u32x4){kw1[0], kw1[1], kw1[2], kw1[3]};
            *(LAS u32x4*)(Vt + cp2 * 72 + rb8) = (u32x4){vw0[0], vw0[1], vw0[2], vw0[3]}; *(LAS u32x4*)(Vt + (cp2 + 1) * 72 + rb8) = (u32x4){vw1[0], vw1[1], vw1[2], vw1[3]};
        }
        BARRIER();
        if (ci + 1 < SEQ / 64) {
#pragma unroll
            for (int r = 0; r < 8; ++r) { const int ro = HG_ROWOFF(ci + 1, r);
                qraw[r] = __builtin_amdgcn_raw_buffer_load_b32(rsrc, vo, ro + C_RQ * 2, 0); zraw[r] = __builtin_amdgcn_raw_buffer_load_b32(rsrc, vo, ro + fcol * 2, 0); vraw[r] = __builtin_amdgcn_raw_buffer_load_b32(rsrc, vo, ro + C_RI * 2, 0); } }
        HG_T1(12); HG_T0(13);
        if (tid < 128) { const float T0 = Vec[tid], T1 = Vec[128 + tid], T2 = Vec[256 + tid], T3 = Vec[384 + tid];
            Vec[4 * 128 + tid] = T0; Vec[5 * 128 + tid] = T0 * T1; Vec[6 * 128 + tid] = T0 * T1 * T2;
            Vec[7 * 128 + tid] = T1; Vec[8 * 128 + tid] = T2; Vec[9 * 128 + tid] = T1 * T2;
            Vec[10 * 128 + tid] = T1 * T2 * T3; Vec[11 * 128 + tid] = T2 * T3; Vec[12 * 128 + tid] = T3; Vec[13 * 128 + tid] = 1.0f;
            Vec[14 * 128 + tid] = (T0 * T1) * (T2 * T3); }
        BARRIER();
        HG_T1(13); HG_T0(14);
        const int tb = wave & 3, vh = wave >> 2;
        {
            int nb = 1, i0 = 3, j0 = 0, i1 = 0, j1 = 0;
            switch (wave) { case 1: j0 = 1; break; case 2: i0 = 2; break; case 3: nb = 2; i0 = 0; j0 = 0; i1 = 1; j1 = 0; break; case 4: nb = 2; i0 = 1; j0 = 1; i1 = 2; j1 = 1; break;
                            case 5: nb = 2; i0 = 2; j0 = 2; i1 = 3; j1 = 2; break; case 6: j0 = 3; break; case 7: nb = 0; break; default: break; }
            for (int q = 0; q < nb; ++q) { const int bi = q ? i1 : i0, bj = q ? j1 : j0;
                f32x4 acc = (f32x4){0.f, 0.f, 0.f, 0.f};
                const int dsel = (bi - bj < 2) ? -1 : (bi == 2 ? 7 : (bj == 1 ? 8 : 9));
#pragma unroll
                for (int stp = 0; stp < 4; ++stp) { const int k0 = 32 * stp + 8 * lg;
                    bf16x8 a;
                    if (bj == bi) a = *(const LAS bf16x8*)(Qg + (16 * bi + lr) * 136 + k0);
                    else if (dsel < 0) a = *(const LAS bf16x8*)(Qd + (16 * bi + lr) * 136 + k0);
                    else a = scale_frag(*(const LAS u32x4*)(Qd + (16 * bi + lr) * 136 + k0), *(const LAS f32x4*)(Vec + dsel * 128 + k0), *(const LAS f32x4*)(Vec + dsel * 128 + k0 + 4));
                    const bf16x8 bq = *(const LAS bf16x8*)(Ke + (16 * bj + lr) * 136 + k0);
                    acc = __builtin_amdgcn_mfma_f32_16x16x32_bf16(a, bq, acc, 0, 0, 0); }
#pragma unroll
                for (int r = 0; r < 4; ++r) { float v = acc[r]; if (bj == bi && lr > 4 * lg + r) v = 0.f; Sc[(16 * bi + 4 * lg + r) * 72 + 16 * bj + lr] = (bf16_t)(pkbf(v, 0.f) & 0xffffu); } }
            if (wave == 7) {
#pragma unroll
                for (int zb = 0; zb < 6; ++zb) { const int bi = zb < 3 ? 0 : (zb < 5 ? 1 : 2), bj = zb < 3 ? zb + 1 : (zb < 5 ? zb - 1 : 3);
#pragma unroll
                    for (int r = 0; r < 4; ++r) Sc[(16 * bi + 4 * lg + r) * 72 + 16 * bj + lr] = (bf16_t)0; } }
        }
        f32x4 oa[4];
#pragma unroll
        for (int vb = 0; vb < 4; ++vb) oa[vb] = (f32x4){0.f, 0.f, 0.f, 0.f};
#pragma unroll
        for (int stp = 0; stp < 4; ++stp) { const int k0 = 32 * stp + 8 * lg;
            bf16x8 a;
            if (tb == 0) a = *(const LAS bf16x8*)(Qd + lr * 136 + k0);
            else a = scale_frag(*(const LAS u32x4*)(Qd + (16 * tb + lr) * 136 + k0), *(const LAS f32x4*)(Vec + (3 + tb) * 128 + k0), *(const LAS f32x4*)(Vec + (3 + tb) * 128 + k0 + 4));
#pragma unroll
            for (int vb = 0; vb < 4; ++vb) { const bf16x8 bq = *(const LAS bf16x8*)(St + (64 * vh + 16 * vb + lr) * 136 + k0);
                oa[vb] = __builtin_amdgcn_mfma_f32_16x16x32_bf16(a, bq, oa[vb], 0, 0, 0); } }
        BARRIER();
        HG_T1(14); HG_T0(15);
        {
#pragma unroll
            for (int stp = 0; stp < 2; ++stp) { const bf16x8 a = *(const LAS bf16x8*)(Sc + (16 * tb + lr) * 72 + 32 * stp + 8 * lg);
#pragma unroll
                for (int vb = 0; vb < 4; ++vb) { const bf16x8 bq = *(const LAS bf16x8*)(Vt + (64 * vh + 16 * vb + lr) * 72 + 32 * stp + 8 * lg);
                    oa[vb] = __builtin_amdgcn_mfma_f32_16x16x32_bf16(a, bq, oa[vb], 0, 0, 0); } }
            bf16_t* ob = o2 + (size_t)dir * TH * 512;
#pragma unroll
            for (int r = 0; r < 4; ++r) { const int pp_ = ci * 64 + 16 * tb + 4 * lg + r; const size_t tk = tok0 + (size_t)(dir == 0 ? pp_ : (SEQ - 1 - pp_));
#pragma unroll
                for (int vb = 0; vb < 4; ++vb) ob[tk * 512 + h * 128 + 64 * vh + 16 * vb + lr] = (bf16_t)(pkbf(oa[vb][r], 0.f) & 0xffffu); } }
        { const int kb = 16 * wave;
#pragma unroll
            for (int r = 0; r < 4; ++r) { const float dec = Vec[14 * 128 + kb + 4 * lg + r];
#pragma unroll
                for (int vb = 0; vb < 8; ++vb) st[vb][r] *= dec; }
#pragma unroll
            for (int stp = 0; stp < 2; ++stp) { const float fj = Vec[(10 + 2 * stp + (lg >> 1)) * 128 + kb + lr];
                const f32x4 m = (f32x4){fj, fj, fj, fj};
                const bf16x8 a = scale_frag(*(const LAS u32x4*)(KeT + (kb + lr) * 72 + 32 * stp + 8 * lg), m, m);
#pragma unroll
                for (int vb = 0; vb < 8; ++vb) { const bf16x8 bq = *(const LAS bf16x8*)(Vt + (16 * vb + lr) * 72 + 32 * stp + 8 * lg);
                    st[vb] = __builtin_amdgcn_mfma_f32_16x16x32_bf16(a, bq, st[vb], 0, 0, 0); } }
#pragma unroll
            for (int vb = 0; vb < 8; ++vb) { u32x2 w; w.x = pkbf(st[vb][0], st[vb][1]); w.y = pkbf(st[vb][2], st[vb][3]); *(LAS u32x2*)(St + (16 * vb + lr) * 136 + kb + 4 * lg) = w; } }
        BARRIER();
        HG_T1(15);
    }
#undef HG_ROWOFF
}
#define XB_TMO      128
#define XB_XCNT(j)  (256  + 64 * (j))
#define XB_XSUB(j)  (1280 + 64 * (j))
#define XB_XGEN(j)  (2304 + 64 * (j))
#define XB_TOP      3328
#define XB_TOPGEN   3392
#define XCD_BAR_WORDS 3456
#define XB_SPIN_CAP (1u << 22)

__device__ __forceinline__ unsigned xb_ld(unsigned* p)              { return __hip_atomic_load(p, __ATOMIC_RELAXED, __HIP_MEMORY_SCOPE_AGENT); }
__device__ __forceinline__ unsigned xb_add(unsigned* p, unsigned v) { return __hip_atomic_fetch_add(p, v, __ATOMIC_RELAXED, __HIP_MEMORY_SCOPE_AGENT); }
__device__ __forceinline__ unsigned xb_xcc_id() { return (unsigned)__builtin_amdgcn_s_getreg((3 << 11) | 20) & 0xFu; }
#define XB_SPIN(cond, bar) do { unsigned _sp = 0; while (cond) { __builtin_amdgcn_s_sleep(1); \
    if ((++_sp & 255u) == 0u) { if (xb_ld(&(bar)[XB_TMO])) break; if (_sp > XB_SPIN_CAP) { atomicAdd(&(bar)[XB_TMO], 1u); break; } } } } while (0)

struct XcdBarrier {
    unsigned* bar; unsigned x;
    volatile LAS unsigned* st;
};

__device__ __forceinline__ XcdBarrier xcd_barrier_post(unsigned* bar, volatile LAS unsigned* st) {
    XcdBarrier b; b.bar = bar; b.x = xb_xcc_id(); b.st = st;
    if (threadIdx.x == 0) (void)xb_add(&bar[XB_XCNT(b.x)], 1u);
    return b;
}
__device__ __forceinline__ void xcd_barrier_complete(unsigned* bar, unsigned x, unsigned& nloc, unsigned& nx) {
    const unsigned G = (gridDim.x * gridDim.y * gridDim.z) >> 3;
    unsigned sum, cnt, mine, sp = 0u;
    for (;;) {
        sum = 0u; cnt = 0u; mine = 0u;
#pragma unroll
        for (unsigned j = 0; j < 16; ++j) { const unsigned c = xb_ld(&bar[XB_XCNT(j)]); sum += c; cnt += (c > 0u) ? 1u : 0u; mine = (j == x) ? c : mine; }
        if (sum == G) break;
        __builtin_amdgcn_s_sleep(1);
        if ((++sp & 255u) == 0u) { if (xb_ld(&bar[XB_TMO])) break; if (sp > XB_SPIN_CAP) { atomicAdd(&bar[XB_TMO], 1u); break; } }
    }
    nloc = mine > 0u ? mine : 1u; nx = cnt > 0u ? cnt : 1u;
}

__device__ __forceinline__ void xcd_barrier(const XcdBarrier& b) {
    asm volatile("s_waitcnt vmcnt(0)" ::: "memory");
    __syncthreads();
    if (threadIdx.x == 0) {
        unsigned* bar = b.bar;
        __builtin_amdgcn_s_waitcnt(0);
        unsigned nloc = b.st[0], nx = b.st[1];
        if (nloc == 0u) { xcd_barrier_complete(bar, b.x, nloc, nx); b.st[0] = nloc; b.st[1] = nx; }
        const unsigned old = xb_add(&bar[XB_XSUB(b.x)], 1u);
        const unsigned gen = old / nloc;
        if (old + 1u == (gen + 1u) * nloc) {
            __builtin_amdgcn_fence(__ATOMIC_RELEASE, "agent");
            asm volatile("s_waitcnt vmcnt(0)" ::: "memory");
            const unsigned og = xb_add(&bar[XB_TOP], 1u);
            const unsigned tg = og / nx;
            if (og + 1u == (tg + 1u) * nx) xb_add(&bar[XB_TOPGEN], 1u);
            else XB_SPIN(xb_ld(&bar[XB_TOPGEN]) == tg, bar);
            __builtin_amdgcn_fence(__ATOMIC_ACQUIRE, "agent");
            xb_add(&bar[XB_XGEN(b.x)], 1u);
            asm volatile("s_waitcnt vmcnt(0)" ::: "memory");
        } else {
            XB_SPIN(xb_ld(&bar[XB_XGEN(b.x)]) == gen, bar);
            __builtin_amdgcn_fence(__ATOMIC_ACQUIRE, "agent");
            asm volatile("s_waitcnt vmcnt(0)" ::: "memory");
        }
    }
    __syncthreads();
}

constexpr int N_SCAN = 4 * 2;
constexpr int N_ATT = 4 * (SEQ / 128);
constexpr int N_POOLU = (TH / 128) * 4;
#ifndef PROBE
#define PROBE 0
#endif

__global__ void __launch_bounds__(NT, 2) mega_fwd(Params p) {
    extern __shared__ __attribute__((aligned(16))) unsigned char smem[];
    cg::grid_group grid = cg::this_grid();
    LAS unsigned char* lds = (LAS unsigned char*)smem;
    const int G = gridDim.x, bid = blockIdx.x, NGW = G * NW;
    const int grp = bid & 7, gidx = bid >> 3, GS = G >> 3, NGWG = GS * NW;
#define GRID_SYNC_CG() do { asm volatile("s_waitcnt vmcnt(0) lgkmcnt(0)" ::: "memory"); grid.sync(); __builtin_amdgcn_fence(__ATOMIC_ACQUIRE, "agent"); asm volatile("s_waitcnt vmcnt(0)" ::: "memory"); } while (0)
#define GROUP_SYNC() xcd_barrier(xbar)
#define OPAQUE_TID() int tid = threadIdx.x; asm volatile("" : "+v"(tid)); const int lane = tid & 63, wave = __builtin_amdgcn_readfirstlane(tid >> 6), gw = bid * NW + wave, gwg = gidx * NW + wave; (void)lane; (void)gw; (void)gwg
    unsigned char* ws = p.ws;
    unsigned* ctl = (unsigned*)(ws + WS_CTL);
    unsigned char* arena = ws + WS_ARENA + (size_t)grp * ARENA;
    bf16_t* proj = (bf16_t*)(arena + WS_PROJ); bf16_t* gates = (bf16_t*)(arena + WS_GATE); bf16_t* hbuf = (bf16_t*)(arena + WS_H); bf16_t* ycat = (bf16_t*)(arena + WS_Y); bf16_t* o2 = (bf16_t*)(arena + WS_O2);
    bf16_t* act = proj;

    { LAS unsigned* stw = (LAS unsigned*)(lds + LDS_ITEM_OFF + 64); if (threadIdx.x < 2) stw[threadIdx.x] = 0u; }
    __syncthreads();
    const XcdBarrier xbar = xcd_barrier_post(ctl + 8192 + grp * XCD_BAR_WORDS, (volatile LAS unsigned*)(lds + LDS_ITEM_OFF + 64));
    { OPAQUE_TID(); p0_prologue(p, lds, gw, NGW, wave, lane);
      norm_rows_bf16(p.in[I_X] + (size_t)grp * TH * D, p.in[I_N1G], hbuf, TH, gwg, NGWG, lane); }
    GRID_SYNC_CG();

    for (int half = 0; half < NHALF; ++half) {
        const size_t seq_off = (size_t)(half * NGRP + grp) * TH * D;
        const float* xin = p.in[I_X] + seq_off;
        float* xres = p.out + seq_off;
        for (int l = 0; l < DEPTH; ++l) {
            unsigned char* wl = ws + WS_W + (size_t)l * W_LAYER;
            const float* xcur = (l == 0) ? xin : xres;
            if (half + l > 0) { { OPAQUE_TID(); norm_rows_bf16(xcur, p.in[I_N1G] + l * D, hbuf, TH, gwg, NGWG, lane); }
                GROUP_SYNC(); }
            { pg8::Gemm g{hbuf, (const bf16_t*)(wl + WO_IN), TH, NPROJ, D}; pg8::GroupOrder S; S.init(NPROJ, GS, gidx);
              pg8::EpiStore E{proj, INC, gates, INC / 256};
              pg8::gemm_phase<pg8::EpiStore, pg8::GroupOrder, true, true>(lds, g, S, E); }
            GROUP_SYNC();
            {
                OPAQUE_TID();
                for (int u = gidx; u < N_SCAN; u += GS) hgrn_unit(lds, proj, p.in[I_HLB], l, o2, u, tid);
                unsigned* ctr = ctl + 64 * (1 + (half * DEPTH + l) * NGRP + grp);
                LAS unsigned* item_w = (LAS unsigned*)(lds + LDS_ITEM_OFF);
                for (;;) {
                    if (tid == 0) *item_w = atomicAdd(ctr, 1u);
                    BARRIER();
                    const int item = (int)*item_w;
                    BARRIER();
                    if (item >= N_ATT + N_POOLU) break;
                    asm volatile("" : "+v"(tid));
                    if (item < N_ATT) attn_unit(lds, proj, p.in[I_LQ1] + l * 64, p.in[I_LK1] + l * 64, p.in[I_LQ2] + l * 64, p.in[I_LK2] + l * 64, p.in[I_DNG] + l * 128, l, ycat + (size_t)TH * 512, item, tid);
                    else pool_unit(lds, proj, (const bf16_t*)(wl + WO_POOL), p.in[I_POOLS] + l * 512, ycat, item - N_ATT, tid);
                }
            }
            GROUP_SYNC();
            { OPAQUE_TID(); hgrn_combine(o2, o2 + (size_t)TH * 512, proj, p.in[I_HNG] + l * 128, ycat + (size_t)2 * TH * 512, gwg, NGWG, lane); }
            GROUP_SYNC();
            { pg8::Gemm g{ycat, (const bf16_t*)(wl + WO_UP), 3 * TH, 3 * D, 512}; pg8::MergeOrder S; S.init(GS, gidx);
              pg8::EpiMerge2 E{gates, hbuf, TH / 256};
              pg8::gemm_phase<pg8::EpiMerge2, pg8::MergeOrder, true, true>(lds, g, S, E); }
            GROUP_SYNC();
            { pg8::Gemm g{hbuf, (const bf16_t*)(wl + WO_OUT), TH, D, D}; pg8::GroupOrder S; S.init(D, GS, gidx);
              pg8::EpiResid E{xcur, xres, D};
              pg8::gemm_phase<pg8::EpiResid, pg8::GroupOrder, true, true>(lds, g, S, E); }
            GROUP_SYNC();
            { OPAQUE_TID(); norm_rows_bf16(xres, p.in[I_N2G] + l * D, hbuf, TH, gwg, NGWG, lane); }
            GROUP_SYNC();
            { pg8::Gemm g{hbuf, (const bf16_t*)(wl + WO_FFI), TH, 2 * FF, D}; pg8::GroupOrder S; S.init(2 * FF, GS, gidx);
              pg8::EpiSwiGLU E{act, FF};
              pg8::gemm_phase<pg8::EpiSwiGLU, pg8::GroupOrder, true, true>(lds, g, S, E); }
            GROUP_SYNC();
            { pg8::Gemm g{act, (const bf16_t*)(wl + WO_FFO), TH, D, FF}; pg8::GroupOrder S; S.init(D, GS, gidx);
              pg8::EpiResid E{xres, xres, D};
              pg8::gemm_phase<pg8::EpiResid, pg8::GroupOrder, true, true>(lds, g, S, E); }
            GROUP_SYNC();
        }
        { OPAQUE_TID(); norm_rows_f32_inplace(xres, p.in[I_FNG], TH, gwg, NGWG, lane, 0); }
    }
}

extern "C" void kernel_launch(void* const* d_in, const int* in_sizes, int n_in, void* d_out, int out_size, void* d_ws, size_t ws_size, hipStream_t stream) {
    static int grid = 0;
    if (grid == 0) {
        if (n_in != 20 || in_sizes[0] != 2 * NGRP * TH * D || out_size != 2 * NGRP * TH * D || ws_size < WS_END) {
            fprintf(stderr, "kernel_launch: unexpected shapes (n_in %d, in0 %d, out %d, ws %zu); nothing launched\n", n_in, n_in > 0 ? in_sizes[0] : -1, out_size, ws_size); grid = -1; return; }
        int dev = 0, cus = 0, per_cu = 0;
        if (hipGetDevice(&dev) != hipSuccess || hipDeviceGetAttribute(&cus, hipDeviceAttributeMultiprocessorCount, dev) != hipSuccess) { grid = -1; return; }
        if (hipFuncSetAttribute((const void*)mega_fwd, hipFuncAttributeMaxDynamicSharedMemorySize, LDS_BYTES) != hipSuccess) { fprintf(stderr, "kernel_launch: hipFuncSetAttribute failed\n"); grid = -1; return; }
        if (hipOccupancyMaxActiveBlocksPerMultiprocessor(&per_cu, (const void*)mega_fwd, NT, LDS_BYTES) != hipSuccess || per_cu < 1) { fprintf(stderr, "kernel_launch: occupancy query says %d\n", per_cu); per_cu = 1; }
        (void)hipGetLastError();
        grid = (cus / 8) * 8;
        if (grid < 64) { fprintf(stderr, "kernel_launch: too few CUs (%d)\n", cus); grid = -1; return; }
    }
    if (grid < 0) return;
    (void)hipMemsetAsync((char*)d_ws + WS_CTL, 0, CTL_BYTES, stream);
    Params prm{};
    for (int i = 0; i < 20; ++i) prm.in[i] = (const float*)d_in[i];
    prm.out = (float*)d_out; prm.ws = (unsigned char*)d_ws;
    void* args[] = {&prm};
    hipError_t e = hipLaunchCooperativeKernel((const void*)mega_fwd, dim3(grid), dim3(NT), args, LDS_BYTES, stream);
    if (e != hipSuccess) fprintf(stderr, "cooperative launch failed: %s (grid %d)\n", hipGetErrorString(e), grid);
}
```

```cpp
#include <hip/hip_runtime.h>
#include <hip/hip_cooperative_groups.h>
#include <cstdio>
#include <cstdint>
namespace cg = cooperative_groups;
namespace pg8 {
#define PG8_LAS __attribute__((address_space(3)))
typedef unsigned short bf16_t;
typedef short bf16x8 __attribute__((ext_vector_type(8)));
typedef float f32x4 __attribute__((ext_vector_type(4)));
typedef unsigned u32x4 __attribute__((ext_vector_type(4)));
constexpr int BM = 256, BK = 64, HALF = 128, HTB = HALF * BK * 2  , STAGE_BYTES = 8 * HTB, NXCD = 8, WGM = 8;

__host__ __device__ __forceinline__ int lds_byte(int r, int c) { const int st = (r >> 4) * 2 + (c >> 5), rr = r & 15, cc = c & 31, ob = rr * 64 + cc * 2; return st * 1024 + (ob ^ (((ob >> 9) & 1) << 5)); }
__host__ __device__ __forceinline__ void stage_rc(int b, int& R, int& C) { const int st = b / 1024, sb = b % 1024, swz = sb ^ (((sb >> 9) & 1) << 5); R = (st >> 1) * 16 + swz / 64; C = (st & 1) * 32 + (swz % 64) / 2; }
__host__ __device__ __forceinline__ int perm32(int rho) { const int n = rho >> 4, i = rho & 15; return 8 * (i >> 2) + 4 * n + (i & 3); }

struct Unit { int pm, pn; };
struct Gemm { const bf16_t* A; const bf16_t* Bt; int M, N, K; };

struct StaticOrder {
    int nM, nN, nwg, G, c;
    __host__ __device__ void init(int M, int N, int G_, int c_) { nM = M / BM; nN = N / BM; nwg = nM * nN; G = G_; c = c_; }
    __host__ __device__ bool next(int i, Unit& u) const {
        const long L = (long)i * G + c; if (L >= nwg) return false;
        int wgid = (int)L; { const int q = nwg / NXCD, r = nwg % NXCD, xcd = wgid % NXCD, off = wgid / NXCD; wgid = (xcd < r ? xcd * (q + 1) : r * (q + 1) + (xcd - r) * q) + off; }
        const int nig = WGM * nN, gid = wgid / nig, fm = gid * WGM, gsz = (nM - fm) < WGM ? (nM - fm) : WGM;
        u.pm = fm + ((wgid % nig) % gsz); u.pn = (wgid % nig) / gsz; return true;
    }
    __device__ __forceinline__ void a_ready(const Unit&) const {}
    __device__ __forceinline__ void done(const Unit&) const {}
};

typedef float f32x2c_ __attribute__((ext_vector_type(2)));
typedef __bf16 bf16x2c_ __attribute__((ext_vector_type(2)));
__device__ __forceinline__ unsigned cvt_pk_bf16(float lo, float hi) { const f32x2c_ v = {lo, hi}; const bf16x2c_ b = __builtin_convertvector(v, bf16x2c_); return __builtin_bit_cast(unsigned, b); }
typedef float f32x2 __attribute__((ext_vector_type(2)));
__device__ __forceinline__ float fast_sigmoid(float x) { return __builtin_amdgcn_rcpf(1.0f + __expf(-x)); }
typedef unsigned u32x2v __attribute__((ext_vector_type(2)));
struct EpiStore {
    static constexpr bool PERM = true, AFTER_DRAIN = false, KEEP = false;
    bf16_t* O; int ldc; bf16_t* G; int nrm;
    __device__ __forceinline__ void operator()(const f32x4 (&acc)[2][2][4][2], const Unit& u, int wr, int wc, int fr, int fq) const {
        const int row0 = u.pm * BM + wr * 64 + fr; const int col0 = u.pn * BM + wc * 32 + 8 * fq;
        const bool dump = u.pn >= nrm;
        bf16_t* gt = G + ((size_t)(u.pm * 12 + (u.pn - nrm)) << 16) + (wr * 4 + wc) * 512 + (fq * 16 + fr) * 8;
#pragma unroll
        for (int ai = 0; ai < 2; ++ai)
#pragma unroll
            for (int m = 0; m < 4; ++m) { bf16_t* rowp = O + (size_t)(row0 + ai * HALF + m * 16) * ldc + col0;
#pragma unroll
                for (int bj = 0; bj < 2; ++bj) { const f32x4 v0 = acc[ai][bj][m][0], v1 = acc[ai][bj][m][1];
                    u32x4 w; w.x = cvt_pk_bf16(v0[0], v0[1]); w.y = cvt_pk_bf16(v0[2], v0[3]); w.z = cvt_pk_bf16(v1[0], v1[1]); w.w = cvt_pk_bf16(v1[2], v1[3]);
                    if (dump) *(u32x4*)(gt + ((ai * 4 + m) * 2 + bj) * 4096) = w; else *(u32x4*)(rowp + bj * HALF) = w; } }
    }
};
struct EpiMerge {
    static constexpr bool PERM = true, AFTER_DRAIN = false, KEEP = false;
    bf16_t* proj; int ldp; int gate_col0; bf16_t* merged; int MT;
    __device__ __forceinline__ void operator()(const f32x4 (&acc)[2][2][4][2], const Unit& u, int wr, int wc, int fr, int fq) const {
        const int br = u.pm / MT, pmt = u.pm - br * MT, pnt = u.pn & 3;
        const int row0 = pmt * BM + wr * 64 + fr; const int col0 = pnt * BM + wc * 32 + 8 * fq;
#pragma unroll
        for (int ai = 0; ai < 2; ++ai)
#pragma unroll
            for (int mp = 0; mp < 2; ++mp) {
                u32x4 gw[2][2]; f32x4 p0[2][2], p1[2][2];
#pragma unroll
                for (int mm = 0; mm < 2; ++mm)
#pragma unroll
                    for (int bj = 0; bj < 2; ++bj) { const size_t row = (size_t)(row0 + ai * HALF + (2 * mp + mm) * 16); bf16_t* prow = proj + row * ldp; const int col = col0 + bj * HALF;
                        gw[mm][bj] = *(const u32x4*)(prow + gate_col0 + br * 1024 + col);
                        if (br > 0) { const float* part = (const float*)prow + col; p0[mm][bj] = *(const f32x4*)part; p1[mm][bj] = *(const f32x4*)(part + 4); }
                        else { p0[mm][bj] = (f32x4){0.f, 0.f, 0.f, 0.f}; p1[mm][bj] = (f32x4){0.f, 0.f, 0.f, 0.f}; } }
#pragma unroll
                for (int mm = 0; mm < 2; ++mm)
#pragma unroll
                    for (int bj = 0; bj < 2; ++bj) { const int m = 2 * mp + mm; const size_t row = (size_t)(row0 + ai * HALF + m * 16); bf16_t* prow = proj + row * ldp; const int col = col0 + bj * HALF;
                        const u32x4 g = gw[mm][bj]; f32x4 g0, g1;
                        g0[0] = fast_sigmoid(__uint_as_float(g.x << 16)); g0[1] = fast_sigmoid(__uint_as_float(g.x & 0xffff0000u));
                        g0[2] = fast_sigmoid(__uint_as_float(g.y << 16)); g0[3] = fast_sigmoid(__uint_as_float(g.y & 0xffff0000u));
                        g1[0] = fast_sigmoid(__uint_as_float(g.z << 16)); g1[1] = fast_sigmoid(__uint_as_float(g.z & 0xffff0000u));
                        g1[2] = fast_sigmoid(__uint_as_float(g.w << 16)); g1[3] = fast_sigmoid(__uint_as_float(g.w & 0xffff0000u));
                        const f32x4 v0 = g0 * acc[ai][bj][m][0] + p0[mm][bj], v1 = g1 * acc[ai][bj][m][1] + p1[mm][bj];
                        if (br < 2) { float* part = (float*)prow + col; *(f32x4*)part = v0; *(f32x4*)(part + 4) = v1; }
                        else { u32x4 w; w.x = cvt_pk_bf16(v0[0], v0[1]); w.y = cvt_pk_bf16(v0[2], v0[3]); w.z = cvt_pk_bf16(v1[0], v1[1]); w.w = cvt_pk_bf16(v1[2], v1[3]);
                            *(u32x4*)(merged + row * 1024 + col) = w; } }
            }
    }
};
struct EpiMerge2 {
    static constexpr bool PERM = true, AFTER_DRAIN = false, KEEP = true;
    const bf16_t* G; bf16_t* merged; int MT;
    static __device__ __forceinline__ float epos(unsigned bits) { return 1.0f + __expf(-fminf(fmaxf(__uint_as_float(bits), -30.0f), 30.0f)); }
    __device__ __forceinline__ bool apply(f32x4 (&acc)[2][2][4][2], const Unit& u, int wr, int wc, int fr, int fq) const {
        const int br = u.pm / MT, pmt = u.pm - br * MT, pnt = u.pn & 3;
        const int row0 = pmt * BM + wr * 64 + fr; const int col0 = pnt * BM + wc * 32 + 8 * fq;
        const bf16_t* gt = G + ((size_t)(pmt * 12 + br * 4 + pnt) << 16) + (wr * 4 + wc) * 512 + (fq * 16 + fr) * 8;
#pragma unroll
        for (int ai = 0; ai < 2; ++ai)
#pragma unroll
            for (int m = 0; m < 4; ++m) { const size_t row = (size_t)(row0 + ai * HALF + m * 16);
#pragma unroll
                for (int bj = 0; bj < 2; ++bj) { const int col = col0 + bj * HALF; const bf16_t* gp = gt + ((ai * 4 + m) * 2 + bj) * 4096;
                    const u32x4 ga = *(const u32x4*)gp;
                    float f[8];
                    if (br < 2) { const u32x4 gb = *(const u32x4*)(gp + (4 << 16));
#pragma unroll
                        for (int e = 0; e < 4; ++e) { f[2 * e] = epos(gb[e] << 16) * __builtin_amdgcn_rcpf(epos(ga[e] << 16)); f[2 * e + 1] = epos(gb[e] & 0xffff0000u) * __builtin_amdgcn_rcpf(epos(ga[e] & 0xffff0000u)); }
                    } else {
#pragma unroll
                        for (int e = 0; e < 4; ++e) { f[2 * e] = __builtin_amdgcn_rcpf(epos(ga[e] << 16)); f[2 * e + 1] = __builtin_amdgcn_rcpf(epos(ga[e] & 0xffff0000u)); }
                    }
                    f32x4 v0 = acc[ai][bj][m][0], v1 = acc[ai][bj][m][1];
                    v0[0] *= f[0]; v0[1] *= f[1]; v0[2] *= f[2]; v0[3] *= f[3]; v1[0] *= f[4]; v1[1] *= f[5]; v1[2] *= f[6]; v1[3] *= f[7];
                    if (br < 2) { acc[ai][bj][m][0] = v0; acc[ai][bj][m][1] = v1; }
                    else { u32x4 w; w.x = cvt_pk_bf16(v0[0], v0[1]); w.y = cvt_pk_bf16(v0[2], v0[3]); w.z = cvt_pk_bf16(v1[0], v1[1]); w.w = cvt_pk_bf16(v1[2], v1[3]);
                        *(u32x4*)(merged + row * 1024 + col) = w; } } }
        return br < 2;
    }
};
struct EpiResid {
    static constexpr bool PERM = false, AFTER_DRAIN = false, KEEP = false;
    const float* base; float* out; int ldc;
    __device__ __forceinline__ void operator()(const f32x4 (&acc)[2][2][4][2], const Unit& u, int wr, int wc, int fr, int fq) const {
        const int row0 = u.pm * BM + wr * 64 + fr; const int col0 = u.pn * BM + wc * 32 + 4 * fq;
#pragma unroll
        for (int ai = 0; ai < 2; ++ai) {
            f32x4 bs[4][2][2];
#pragma unroll
            for (int m = 0; m < 4; ++m) { const size_t off = (size_t)(row0 + ai * HALF + m * 16) * ldc + col0;
#pragma unroll
                for (int bj = 0; bj < 2; ++bj)
#pragma unroll
                    for (int n = 0; n < 2; ++n) bs[m][bj][n] = *(const f32x4*)(base + off + bj * HALF + n * 16); }
#pragma unroll
            for (int m = 0; m < 4; ++m) { const size_t off = (size_t)(row0 + ai * HALF + m * 16) * ldc + col0;
#pragma unroll
                for (int bj = 0; bj < 2; ++bj)
#pragma unroll
                    for (int n = 0; n < 2; ++n) *(f32x4*)(out + off + bj * HALF + n * 16) = bs[m][bj][n] + acc[ai][bj][m][n]; }
        }
    }
};
struct EpiSwiGLU {
    static constexpr bool PERM = true, AFTER_DRAIN = false, KEEP = false;
    bf16_t* O; int ldc;
    __device__ __forceinline__ void operator()(const f32x4 (&acc)[2][2][4][2], const Unit& u, int wr, int wc, int fr, int fq) const {
        const int row0 = u.pm * BM + wr * 64 + fr; const int col0 = u.pn * HALF + wc * 32 + 8 * fq;
#pragma unroll
        for (int ai = 0; ai < 2; ++ai)
#pragma unroll
            for (int m = 0; m < 4; ++m) { bf16_t* rowp = O + (size_t)(row0 + ai * HALF + m * 16) * ldc + col0;
                f32x4 r0, r1;
#pragma unroll
                for (int e = 0; e < 4; ++e) { const float ga = acc[ai][0][m][0][e], gb = acc[ai][0][m][1][e];
                    r0[e] = ga * fast_sigmoid(ga) * acc[ai][1][m][0][e]; r1[e] = gb * fast_sigmoid(gb) * acc[ai][1][m][1][e]; }
                u32x4 w; w.x = cvt_pk_bf16(r0[0], r0[1]); w.y = cvt_pk_bf16(r0[2], r0[3]); w.z = cvt_pk_bf16(r1[0], r1[1]); w.w = cvt_pk_bf16(r1[2], r1[3]);
                *(u32x4*)rowp = w; }
    }
};
struct GroupOrder {
    int nwg, gs, c;
    __device__ void init(int N, int gs_, int c_) { nwg = 8 * (N / BM); gs = gs_; c = c_; }
    __device__ bool next(int i, Unit& u) const { const int L = i * gs + c; if (L >= nwg) return false; u.pm = L & 7; u.pn = L >> 3; return true; }
    __device__ __forceinline__ void a_ready(const Unit&) const {}
    __device__ __forceinline__ void done(const Unit&) const {}
};
struct GroupOrderWin {
    int nwg, gs, c, pn0;
    __device__ void init(int pn0_, int ntn, int gs_, int c_) { nwg = 8 * ntn; gs = gs_; c = c_; pn0 = pn0_; }
    __device__ bool next(int i, Unit& u) const { const int L = i * gs + c; if (c < 0 || L >= nwg) return false; u.pm = L & 7; u.pn = pn0 + (L >> 3); return true; }
    __device__ __forceinline__ void a_ready(const Unit&) const {}
    __device__ __forceinline__ void done(const Unit&) const {}
};
struct MergeOrder {
    GroupOrder S; int MT;
    __device__ void init(int gs_, int c_) { S.init(1024, gs_, c_); MT = 8; }
    __device__ bool next(int i, Unit& u) const { const int t = i / 3, br = i - 3 * t; Unit b; if (!S.next(t, b)) return false; u.pm = br * MT + b.pm; u.pn = br * 4 + b.pn; return true; }
    __device__ __forceinline__ void a_ready(const Unit&) const {}
    __device__ __forceinline__ void done(const Unit&) const {}
};

template <class Epi, class Sched, bool ALIGN_EPI = false, bool SP2 = false>
__device__ __forceinline__ void gemm_phase(PG8_LAS unsigned char* lds, const Gemm g, const Sched& S, const Epi& E) {
    int tid_ = threadIdx.x; asm volatile("" : "+v"(tid_));
    const int tid = tid_, wid = __builtin_amdgcn_readfirstlane(tid >> 6), lane = tid & 63, wr = wid >> 2, wc = wid & 3, fr = lane & 15, fq = lane >> 4;
    const int K = g.K, nt = K / BK;
    unsigned voffA[2], voffB[2];
#pragma unroll
    for (int i = 0; i < 2; ++i) { int R, C; stage_rc(tid * 16 + i * 8192, R, C); const int Rb = Epi::PERM ? ((R & ~31) + perm32(R & 31)) : R;
        voffA[i] = (unsigned)(R * K + C) * 2u; voffB[i] = (unsigned)(Rb * K + C) * 2u; }
    const size_t kstep = (size_t)(BK * 2);
    const size_t hstep = (size_t)HALF * K * 2;
    const size_t tstep = 2 * hstep;
    const unsigned ldsw = (unsigned)wid * 1024u;
    const int aoff = lds_byte(wr * 64 + fr, fq * 8), boff = lds_byte(wc * 32 + fr, fq * 8);
#define PG8_SA(b, h) (((b) * 2 + (h)) * HTB)
#define PG8_SB(b, h) ((4 + (b) * 2 + (h)) * HTB)
#define PG8_STAGE(bufoff, gbase, voff) do { _Pragma("unroll") for (int _i = 0; _i < 2; ++_i) \
        __builtin_amdgcn_global_load_lds((const unsigned*)((const char*)(gbase) + (voff)[_i]), (PG8_LAS unsigned*)(lds + (bufoff) + ldsw + _i * 8192), 16, 0, 0); } while (0)
#define PG8_LDA(dst, b, h) do { _Pragma("unroll") for (int m = 0; m < 4; ++m) _Pragma("unroll") for (int k = 0; k < 2; ++k) dst[m][k] = *(const PG8_LAS bf16x8*)(lds + PG8_SA(b, h) + aoff + m * 2048 + k * 1024); } while (0)
#define PG8_LDB(dst, b, h) do { _Pragma("unroll") for (int n = 0; n < 2; ++n) _Pragma("unroll") for (int k = 0; k < 2; ++k) dst[n][k] = *(const PG8_LAS bf16x8*)(lds + PG8_SB(b, h) + boff + n * 2048 + k * 1024); } while (0)
#define PG8_MMA(ai, bj, At, Bt) do { __builtin_amdgcn_s_setprio(1); _Pragma("unroll") for (int m = 0; m < 4; ++m) _Pragma("unroll") for (int n = 0; n < 2; ++n) _Pragma("unroll") for (int k = 0; k < 2; ++k) \
        acc[ai][bj][m][n] = __builtin_amdgcn_mfma_f32_16x16x32_bf16(Bt[n][k], At[m][k], acc[ai][bj][m][n], 0, 0, 0); __builtin_amdgcn_s_setprio(0); } while (0)
#define PG8_WAIT_V(n) asm volatile("s_waitcnt vmcnt(" #n ")" ::: "memory")
#define PG8_WAIT_L(n) asm volatile("s_waitcnt lgkmcnt(" #n ")" ::: "memory")
#define PG8_BAR __builtin_amdgcn_s_barrier()
#define PG8_SCHED __builtin_amdgcn_sched_barrier(0)
    Unit cur, nxt; int ui = 0;
    if (!S.next(0, cur)) return;
    f32x4 acc[2][2][4][2];
#pragma unroll
    for (int a = 0; a < 2; ++a)
#pragma unroll
        for (int b = 0; b < 2; ++b)
#pragma unroll
            for (int m = 0; m < 4; ++m)
#pragma unroll
                for (int n = 0; n < 2; ++n) acc[a][b][m][n] = (f32x4){0.f, 0.f, 0.f, 0.f};
    bf16x8 At[4][2], B0[2][2], B1[2][2];
    const char* cA = (const char*)g.A + (size_t)cur.pm * tstep; const char* cB = (const char*)g.Bt + (size_t)cur.pn * tstep;
    S.a_ready(cur);
    if constexpr (SP2) {
        PG8_STAGE(PG8_SB(0, 0), cB, voffB); PG8_STAGE(PG8_SB(0, 1), cB + hstep, voffB); PG8_STAGE(PG8_SA(0, 0), cA, voffA); PG8_STAGE(PG8_SA(0, 1), cA + hstep, voffA);
        if (wr == 1) PG8_BAR;
        PG8_WAIT_V(2); PG8_BAR;
        PG8_STAGE(PG8_SB(1, 0), cB + kstep, voffB); PG8_STAGE(PG8_SA(1, 0), cA + kstep, voffA); PG8_STAGE(PG8_SB(1, 1), cB + hstep + kstep, voffB);
        PG8_WAIT_V(6); PG8_BAR;
    } else {
        PG8_STAGE(PG8_SB(0, 0), cB, voffB); PG8_STAGE(PG8_SA(0, 0), cA, voffA); PG8_STAGE(PG8_SB(0, 1), cB + hstep, voffB); PG8_STAGE(PG8_SA(0, 1), cA + hstep, voffA);
        if (wr == 1) PG8_BAR;
        PG8_WAIT_V(4); PG8_BAR;
        PG8_STAGE(PG8_SB(1, 0), cB + kstep, voffB); PG8_STAGE(PG8_SA(1, 0), cA + kstep, voffA); PG8_STAGE(PG8_SB(1, 1), cB + hstep + kstep, voffB);
        PG8_WAIT_V(6); PG8_BAR;
    }
    for (;;) {
        const bool has_next = S.next(ui + 1, nxt);
        const char* nA = has_next ? (const char*)g.A + (size_t)nxt.pm * tstep : cA; const char* nB = has_next ? (const char*)g.Bt + (size_t)nxt.pn * tstep : cB;
        for (int t = 0; t < nt; t += 2) {
            const bool last = (t == nt - 2);
            const char* a1 = cA + (size_t)(t + 1) * kstep;
            const char* a2 = last ? nA : cA + (size_t)(t + 2) * kstep; const char* b2 = last ? nB : cB + (size_t)(t + 2) * kstep;
            const char* a3 = a2 + kstep; const char* b3 = b2 + kstep;
            if (last && has_next) S.a_ready(nxt);
            if constexpr (SP2) {
            PG8_LDB(B0, 0, 0); PG8_LDB(B1, 0, 1); PG8_SCHED; PG8_LDA(At, 0, 0); PG8_STAGE(PG8_SA(1, 1), a1 + hstep, voffA);
            PG8_WAIT_V(8); PG8_WAIT_L(0); PG8_BAR; PG8_MMA(0, 0, At, B0); PG8_MMA(0, 1, At, B1); PG8_BAR; PG8_SCHED;
            PG8_LDA(At, 0, 1); PG8_STAGE(PG8_SB(0, 0), b2, voffB); PG8_STAGE(PG8_SB(0, 1), b2 + hstep, voffB); PG8_STAGE(PG8_SA(0, 0), a2, voffA);
            PG8_WAIT_V(8); PG8_WAIT_L(0); PG8_BAR; PG8_MMA(1, 0, At, B0); PG8_MMA(1, 1, At, B1); PG8_BAR; PG8_SCHED;
            PG8_LDB(B0, 1, 0); PG8_LDB(B1, 1, 1); PG8_SCHED; PG8_LDA(At, 1, 0); PG8_STAGE(PG8_SA(0, 1), a2 + hstep, voffA);
            PG8_WAIT_V(8); PG8_WAIT_L(0); PG8_BAR; PG8_MMA(0, 0, At, B0); PG8_MMA(0, 1, At, B1); PG8_BAR; PG8_SCHED;
            PG8_LDA(At, 1, 1); PG8_STAGE(PG8_SB(1, 0), b3, voffB); PG8_STAGE(PG8_SB(1, 1), b3 + hstep, voffB); PG8_STAGE(PG8_SA(1, 0), a3, voffA);
            PG8_WAIT_V(8); PG8_WAIT_L(0); PG8_BAR; PG8_MMA(1, 0, At, B0); PG8_MMA(1, 1, At, B1); PG8_BAR; PG8_SCHED;
            } else {
            PG8_LDB(B0, 0, 0); PG8_SCHED; PG8_LDA(At, 0, 0); PG8_STAGE(PG8_SA(1, 1), a1 + hstep, voffA);
            PG8_WAIT_L(8); PG8_BAR; PG8_WAIT_L(0); PG8_MMA(0, 0, At, B0); PG8_BAR; PG8_SCHED;
            PG8_LDB(B1, 0, 1); PG8_STAGE(PG8_SB(0, 0), b2, voffB);
            PG8_BAR; PG8_WAIT_L(0); PG8_MMA(0, 1, At, B1); PG8_BAR;
            PG8_LDA(At, 0, 1); PG8_STAGE(PG8_SA(0, 0), a2, voffA);
            PG8_BAR; PG8_WAIT_L(0); PG8_MMA(1, 0, At, B0); PG8_BAR; PG8_SCHED;
            PG8_STAGE(PG8_SB(0, 1), b2 + hstep, voffB);
            PG8_WAIT_V(6); PG8_BAR; PG8_MMA(1, 1, At, B1); PG8_BAR;
            PG8_LDB(B0, 1, 0); PG8_SCHED; PG8_LDA(At, 1, 0); PG8_STAGE(PG8_SA(0, 1), a2 + hstep, voffA);
            PG8_WAIT_L(8); PG8_BAR; PG8_WAIT_L(0); PG8_MMA(0, 0, At, B0); PG8_BAR; PG8_SCHED;
            PG8_LDB(B1, 1, 1); PG8_STAGE(PG8_SB(1, 0), b3, voffB);
            PG8_BAR; PG8_WAIT_L(0); PG8_MMA(0, 1, At, B1); PG8_BAR;
            PG8_LDA(At, 1, 1); PG8_STAGE(PG8_SA(1, 0), a3, voffA);
            PG8_BAR; PG8_WAIT_L(0); PG8_MMA(1, 0, At, B0); PG8_BAR; PG8_SCHED;
            PG8_STAGE(PG8_SB(1, 1), b3 + hstep, voffB);
            PG8_WAIT_V(6); PG8_BAR; PG8_MMA(1, 1, At, B1); PG8_BAR;
            }
        }
        if constexpr (ALIGN_EPI) { if (wr == 0) PG8_BAR; }
        bool keep_acc = false;
        if constexpr (!Epi::AFTER_DRAIN) { if constexpr (Epi::KEEP) keep_acc = E.apply(acc, cur, wr, wc, fr, fq); else E(acc, cur, wr, wc, fr, fq); S.done(cur); }
        if (!has_next) break;
        if (!keep_acc) {
#pragma unroll
        for (int a = 0; a < 2; ++a)
#pragma unroll
            for (int b = 0; b < 2; ++b)
#pragma unroll
                for (int m = 0; m < 4; ++m)
#pragma unroll
                    for (int n = 0; n < 2; ++n) acc[a][b][m][n] = (f32x4){0.f, 0.f, 0.f, 0.f};
        }
        cur = nxt; cA = nA; cB = nB; ++ui;
        if constexpr (ALIGN_EPI) { if (wr == 1) PG8_BAR; }
    }
    PG8_WAIT_V(0);
    if constexpr (!ALIGN_EPI) { if (wr == 0) PG8_BAR; }
    PG8_BAR;
    if constexpr (Epi::AFTER_DRAIN) { E.fused(acc, cur, wr, wc, fr, fq, lds, wid, lane); S.done(cur); }
#undef PG8_SA
#undef PG8_SB
#undef PG8_STAGE
#undef PG8_LDA
#undef PG8_LDB
#undef PG8_MMA
#undef PG8_WAIT_V
#undef PG8_WAIT_L
#undef PG8_BAR
#undef PG8_SCHED
}
}

#define LAS __attribute__((address_space(3)))
typedef unsigned short bf16_t;
typedef short bf16x8 __attribute__((ext_vector_type(8)));
typedef float f32x4 __attribute__((ext_vector_type(4)));
typedef float f32x16 __attribute__((ext_vector_type(16)));
typedef unsigned u32x4 __attribute__((ext_vector_type(4)));
typedef unsigned u32x2 __attribute__((ext_vector_type(2)));

constexpr int D = 1024, SEQ = 2048, DEPTH = 4, NHALF = 2, HB = 1, TH = HB * SEQ, NGRP = 8;
constexpr int INC = 4608, NPROJ = 7680, FF = 2816;
constexpr int C_POOL = 0, C_AQ = 512, C_AK = 1024, C_AV = 1536, C_RQ = 2048, C_RF = 2560, C_RB = 3072, C_RI = 3584, C_RG = 4096, C_GATE = 4608;
constexpr float EPS = 1e-6f;
constexpr int NT = 512, NW = 8;
constexpr int LDS_BYTES = 155648;
constexpr int LDS_ITEM_OFF = 155136;

constexpr size_t MiB = 1u << 20;
constexpr size_t WS_CTL = 0, CTL_BYTES = 163840;
constexpr size_t WS_W = 2 * MiB, W_LAYER = 37 * MiB;
constexpr size_t WO_IN = 0, WO_POOL = (size_t)NPROJ * D * 2, WO_UP = WO_POOL + 4 * 128 * 128 * 2, WO_OUT = WO_UP + (size_t)3 * D * 512 * 2,
                 WO_FFI = WO_OUT + (size_t)D * D * 2, WO_FFO = WO_FFI + (size_t)2 * FF * D * 2, WO_END = WO_FFO + (size_t)D * FF * 2;
static_assert(WO_END <= W_LAYER, "weights per layer");
constexpr size_t WS_ARENA = 150 * MiB, ARENA = 44 * MiB;
constexpr size_t WS_PROJ = 0;
constexpr size_t WS_GATE = 18 * MiB;
constexpr size_t WS_H = 30 * MiB;
constexpr size_t WS_Y = 34 * MiB;
constexpr size_t WS_O2 = 40 * MiB;
constexpr size_t WS_END = WS_ARENA + NGRP * ARENA;
static_assert(WS_W + DEPTH * W_LAYER <= WS_ARENA && WS_PROJ + (size_t)TH * INC * 2 <= WS_GATE && WS_GATE + (size_t)TH * 3072 * 2 <= WS_H && WS_H + (size_t)TH * D * 2 <= WS_Y && WS_Y + (size_t)3 * TH * 512 * 2 <= WS_O2 && WS_O2 + (size_t)2 * TH * 512 * 2 <= ARENA && WS_END <= 512 * MiB, "ws map");

struct Params { const float* in[20]; float* out; unsigned char* ws; };
enum { I_X = 0, I_N1G, I_WIN, I_POOLW, I_POOLS, I_LQ1, I_LK1, I_LQ2, I_LK2, I_DNG, I_HLB, I_HNG, I_WUP, I_WUA, I_WUR, I_WOUT, I_N2G, I_WFI, I_WFO, I_FNG };

typedef float f32x2c __attribute__((ext_vector_type(2)));
typedef __bf16 bf16x2c __attribute__((ext_vector_type(2)));
__device__ __forceinline__ unsigned pkbf(float lo, float hi) { const f32x2c v = {lo, hi}; const bf16x2c b = __builtin_convertvector(v, bf16x2c); return __builtin_bit_cast(unsigned, b); }
__device__ __forceinline__ float bflo(unsigned w) { return __uint_as_float(w << 16); }
__device__ __forceinline__ float bfhi(unsigned w) { return __uint_as_float(w & 0xffff0000u); }
__device__ __forceinline__ float bfe(const u32x4& w, int e) { const unsigned x = w[e >> 1]; return (e & 1) ? bfhi(x) : bflo(x); }
__device__ __forceinline__ float sigm(float x) { return __builtin_amdgcn_rcpf(1.0f + __expf(-x)); }
__device__ __forceinline__ float wave_sum(float v) {
#pragma unroll
    for (int o = 1; o < 64; o <<= 1) v += __shfl_xor(v, o);
    return v;
}
#define BARRIER() __syncthreads()

__device__ __forceinline__ void p0_transpose_item(const float* W, int K, int N, bf16_t* WT, int row_off, int mode, LAS float* scr, int item, int lane) {
    const int nblk = N / 32, kb = item / nblk, nb = item - kb * nblk, k0 = 64 * kb, n0 = 32 * nb;
#pragma unroll
    for (int i = 0; i < 32; ++i) { const int kk = 2 * i + (lane >> 5); scr[kk * 33 + (lane & 31)] = W[(size_t)(k0 + kk) * N + n0 + (lane & 31)]; }
    asm volatile("s_waitcnt lgkmcnt(0)" ::: "memory");
    int drow0;
    if (mode == 1) { const int bj = n0 / FF, jj = n0 - bj * FF; drow0 = (jj >> 7) * 256 + bj * 128 + (jj & 127); } else drow0 = row_off + n0;
    const int c = lane & 7;
#pragma unroll
    for (int j = 0; j < 4; ++j) { const int n = (lane >> 3) + 8 * j; const LAS float* s = scr + (8 * c) * 33 + n;
        u32x4 o; o.x = pkbf(s[0 * 33], s[1 * 33]); o.y = pkbf(s[2 * 33], s[3 * 33]); o.z = pkbf(s[4 * 33], s[5 * 33]); o.w = pkbf(s[6 * 33], s[7 * 33]);
        *(u32x4*)(WT + (size_t)(drow0 + n) * K + k0 + 8 * c) = o; }
    asm volatile("s_waitcnt lgkmcnt(0)" ::: "memory");
}
__device__ __forceinline__ void p0_prologue(const Params& p, LAS unsigned char* lds, int gw, int NGW, int wave, int lane) {
    LAS float* scr = (LAS float*)(lds + wave * 16384);
    constexpr int I_IN = (D / 64) * (NPROJ / 32), I_PL = 4 * 2 * 4, I_UP = (512 / 64) * (D / 32), I_OUT = (D / 64) * (D / 32), I_FI = (D / 64) * (2 * FF / 32), I_FO = (FF / 64) * (D / 32);
    constexpr int PER_LAYER = I_IN + I_PL + 3 * I_UP + I_OUT + I_FI + I_FO;
    for (int it = gw; it < DEPTH * PER_LAYER; it += NGW) {
        const int l = it / PER_LAYER; int r = it - l * PER_LAYER;
        unsigned char* wl = p.ws + WS_W + (size_t)l * W_LAYER;
        if (r < I_IN) { p0_transpose_item(p.in[I_WIN] + (size_t)l * D * NPROJ, D, NPROJ, (bf16_t*)(wl + WO_IN), 0, 0, scr, r, lane); continue; } r -= I_IN;
        if (r < I_PL) { const int g = r >> 3; p0_transpose_item(p.in[I_POOLW] + (size_t)(l * 4 + g) * 128 * 128, 128, 128, (bf16_t*)(wl + WO_POOL) + (size_t)g * 128 * 128, 0, 0, scr, r & 7, lane); continue; } r -= I_PL;
        if (r < 3 * I_UP) { const int br = r / I_UP; const float* src = p.in[br == 0 ? I_WUP : (br == 1 ? I_WUA : I_WUR)] + (size_t)l * 512 * D;
            p0_transpose_item(src, 512, D, (bf16_t*)(wl + WO_UP), br * D, 0, scr, r - br * I_UP, lane); continue; } r -= 3 * I_UP;
        if (r < I_OUT) { p0_transpose_item(p.in[I_WOUT] + (size_t)l * D * D, D, D, (bf16_t*)(wl + WO_OUT), 0, 0, scr, r, lane); continue; } r -= I_OUT;
        if (r < I_FI) { p0_transpose_item(p.in[I_WFI] + (size_t)l * D * 2 * FF, D, 2 * FF, (bf16_t*)(wl + WO_FFI), 0, 1, scr, r, lane); continue; } r -= I_FI;
        p0_transpose_item(p.in[I_WFO] + (size_t)l * FF * D, FF, D, (bf16_t*)(wl + WO_FFO), 0, 0, scr, r, lane);
    }
}

__device__ __forceinline__ void norm_rows_bf16(const float* x, const float* g, bf16_t* h, int nrows, int gw, int NGW, int lane) {
    for (int row = gw; row < nrows; row += 2 * NGW) {
        const int row2 = row + NGW; const bool has2 = row2 < nrows;
        const f32x4* xr = (const f32x4*)(x + (size_t)row * D) + lane; const f32x4* xr2 = (const f32x4*)(x + (size_t)(has2 ? row2 : row) * D) + lane;
        f32x4 v[4], w2[4]; float ss = 0.f, ss2 = 0.f;
#pragma unroll
        for (int j = 0; j < 4; ++j) { v[j] = xr[64 * j]; w2[j] = xr2[64 * j]; }
#pragma unroll
        for (int j = 0; j < 4; ++j) { ss += (v[j][0] * v[j][0] + v[j][1] * v[j][1]) + (v[j][2] * v[j][2] + v[j][3] * v[j][3]); ss2 += (w2[j][0] * w2[j][0] + w2[j][1] * w2[j][1]) + (w2[j][2] * w2[j][2] + w2[j][3] * w2[j][3]); }
        const float rstd = rsqrtf(wave_sum(ss) * (1.0f / D) + EPS), rstd2 = rsqrtf(wave_sum(ss2) * (1.0f / D) + EPS);
        u32x2* o = (u32x2*)(h + (size_t)row * D) + lane; u32x2* o2p = (u32x2*)(h + (size_t)row2 * D) + lane;
#pragma unroll
        for (int j = 0; j < 4; ++j) { const f32x4 gv = ((const f32x4*)g)[lane + 64 * j]; const f32x4 y = v[j] * rstd * gv; u32x2 w; w.x = pkbf(y[0], y[1]); w.y = pkbf(y[2], y[3]); o[64 * j] = w;
            if (has2) { const f32x4 y2 = w2[j] * rstd2 * gv; u32x2 q; q.x = pkbf(y2[0], y2[1]); q.y = pkbf(y2[2], y2[3]); o2p[64 * j] = q; } }
    }
}
__device__ __forceinline__ void norm_rows_f32_inplace(float* x, const float* g, int nrows, int gw, int NGW, int lane, int probe_rows) {
    (void)probe_rows;
    for (int row = gw; row < nrows; row += 2 * NGW) {
        const int row2 = row + NGW; const bool has2 = row2 < nrows;
        f32x4* xr = (f32x4*)(x + (size_t)row * D) + lane; f32x4* xr2 = (f32x4*)(x + (size_t)(has2 ? row2 : row) * D) + lane;
        f32x4 v[4], w2[4]; float ss = 0.f, ss2 = 0.f;
#pragma unroll
        for (int j = 0; j < 4; ++j) { v[j] = xr[64 * j]; w2[j] = xr2[64 * j]; }
#pragma unroll
        for (int j = 0; j < 4; ++j) { ss += (v[j][0] * v[j][0] + v[j][1] * v[j][1]) + (v[j][2] * v[j][2] + v[j][3] * v[j][3]); ss2 += (w2[j][0] * w2[j][0] + w2[j][1] * w2[j][1]) + (w2[j][2] * w2[j][2] + w2[j][3] * w2[j][3]); }
        const float rstd = rsqrtf(wave_sum(ss) * (1.0f / D) + EPS), rstd2 = rsqrtf(wave_sum(ss2) * (1.0f / D) + EPS);
#pragma unroll
        for (int j = 0; j < 4; ++j) { const f32x4 gv = ((const f32x4*)g)[lane + 64 * j]; xr[64 * j] = v[j] * rstd * gv; if (has2) xr2[64 * j] = w2[j] * rstd2 * gv; }
    }
}
__device__ __forceinline__ void hgrn_combine(const bf16_t* of, const bf16_t* ob, const bf16_t* proj, const float* gain, bf16_t* yrec, int gw, int NGW, int lane) {
    const f32x4 g0 = *(const f32x4*)(gain + ((8 * lane) & 127)), g1 = *(const f32x4*)(gain + ((8 * lane) & 127) + 4);
    for (int row0 = gw; row0 < TH; row0 += 2 * NGW) {
        u32x4 a[2], b[2], gz[2]; int rows[2] = {row0, row0 + NGW};
#pragma unroll
        for (int q = 0; q < 2; ++q) { const int row = rows[q] < TH ? rows[q] : row0;
            a[q] = *((const u32x4*)(of + (size_t)row * 512) + lane); b[q] = *((const u32x4*)(ob + (size_t)row * 512) + lane); gz[q] = *((const u32x4*)(proj + (size_t)row * INC + C_RG) + lane); }
#pragma unroll
        for (int q = 0; q < 2; ++q) { if (rows[q] >= TH) continue;
            float o[8]; float ss = 0.f;
#pragma unroll
            for (int e = 0; e < 8; ++e) { o[e] = bfe(a[q], e) + bfe(b[q], e); ss += o[e] * o[e]; }
            ss += __shfl_xor(ss, 1); ss += __shfl_xor(ss, 2); ss += __shfl_xor(ss, 4); ss += __shfl_xor(ss, 8);
            const float rstd = rsqrtf(ss * (1.0f / 128.0f) + EPS);
            float y[8];
#pragma unroll
            for (int e = 0; e < 8; ++e) { const float z = bfe(gz[q], e); const float gg = e < 4 ? g0[e] : g1[e - 4]; y[e] = o[e] * rstd * gg * (z * sigm(z)); }
            u32x4 w; w.x = pkbf(y[0], y[1]); w.y = pkbf(y[2], y[3]); w.z = pkbf(y[4], y[5]); w.w = pkbf(y[6], y[7]);
            *((u32x4*)(yrec + (size_t)rows[q] * 512) + lane) = w; }
    }
}

__device__ __forceinline__ void pool_unit(LAS unsigned char* lds, const bf16_t* proj, const bf16_t* wpool  , const float* pscale  , bf16_t* ypool, int unit, int tid) {
    const int tile = unit >> 2, g = unit & 3, t0 = tile * 128, p0 = t0 & (SEQ - 1), hw = 1 << g;
    LAS bf16_t* U = (LAS bf16_t*)lds; LAS bf16_t* Dt = (LAS bf16_t*)(lds + 39168); LAS bf16_t* Bw = (LAS bf16_t*)(lds + 39168 + 34816);
    for (int idx = tid; idx < 144 * 16; idx += NT) { const int r = idx >> 4, cs = idx & 15; const int pp = p0 - 8 + r;
        u32x4 v = (u32x4){0u, 0u, 0u, 0u};
        if (pp >= 0 && pp < SEQ) v = *(const u32x4*)(proj + (size_t)(t0 - 8 + r) * INC + C_POOL + g * 128 + cs * 8);
        *(LAS u32x4*)(U + r * 136 + cs * 8) = v; }
    for (int idx = tid; idx < 128 * 16; idx += NT) { const int r = idx >> 4, cs = idx & 15;
        *(LAS u32x4*)(Bw + r * 136 + cs * 8) = *(const u32x4*)(wpool + (size_t)g * 128 * 128 + r * 128 + cs * 8); }
    BARRIER();
    for (int idx = tid; idx < 128 * 16; idx += NT) { const int r = idx >> 4, cs = idx & 15; const int pp = p0 + r;
        int lo = pp - hw; if (lo < 0) lo = 0; int hi = pp + hw - 1; if (hi > SEQ - 1) hi = SEQ - 1;
        float s[8];
#pragma unroll
        for (int e = 0; e < 8; ++e) s[e] = 0.f;
        for (int q = lo; q <= hi; ++q) { const u32x4 v = *(const LAS u32x4*)(U + (q - p0 + 8) * 136 + cs * 8);
#pragma unroll
            for (int e = 0; e < 8; ++e) s[e] += bfe(v, e); }
        const float inv = 1.0f / (float)(hi - lo + 1);
        const u32x4 c = *(const LAS u32x4*)(U + (r + 8) * 136 + cs * 8);
        u32x4 w; w.x = pkbf(s[0] * inv - bfe(c, 0), s[1] * inv - bfe(c, 1)); w.y = pkbf(s[2] * inv - bfe(c, 2), s[3] * inv - bfe(c, 3));
        w.z = pkbf(s[4] * inv - bfe(c, 4), s[5] * inv - bfe(c, 5)); w.w = pkbf(s[6] * inv - bfe(c, 6), s[7] * inv - bfe(c, 7));
        *(LAS u32x4*)(Dt + r * 136 + cs * 8) = w; }
    BARRIER();
    const int wave = tid >> 6, lane = tid & 63, lr = lane & 15, lg = lane >> 4;
    f32x4 acc[8];
#pragma unroll
    for (int cb = 0; cb < 8; ++cb) acc[cb] = (f32x4){0.f, 0.f, 0.f, 0.f};
#pragma unroll
    for (int st = 0; st < 4; ++st) { const bf16x8 a = *(const LAS bf16x8*)(Dt + (16 * wave + lr) * 136 + 32 * st + 8 * lg);
#pragma unroll
        for (int cb = 0; cb < 8; ++cb) { const bf16x8 b = *(const LAS bf16x8*)(Bw + (16 * cb + lr) * 136 + 32 * st + 8 * lg);
            acc[cb] = __builtin_amdgcn_mfma_f32_16x16x32_bf16(a, b, acc[cb], 0, 0, 0); } }
#pragma unroll
    for (int cb = 0; cb < 8; ++cb) { const int n = g * 128 + 16 * cb + lr; const float sc = pscale[n];
#pragma unroll
        for (int r = 0; r < 4; ++r) { const int row = t0 + 16 * wave + 4 * lg + r; ypool[(size_t)row * 512 + n] = (bf16_t)(pkbf(acc[cb][r] * sc, 0.f) & 0xffffu); } }
    BARRIER();
}

constexpr int AT_Q = 0, AT_K = 34816, AT_V = AT_K + 2 * 17408, AT_END = AT_V + 2 * 17408;
static_assert(AT_END <= LDS_ITEM_OFF && 128 * 132 * 4 <= 4 * 17408, "attention LDS");
__device__ __forceinline__ void attn_unit(LAS unsigned char* lds, const bf16_t* proj, const float* lq1, const float* lk1, const float* lq2, const float* lk2, const float* dng, int layer, bf16_t* yattn, int unit, int tid) {
    const int b = unit >> 6, h = (unit >> 4) & 3, qb = unit & 15;
    const int wave = tid >> 6, lane = tid & 63, l31 = lane & 31, hi = lane >> 5, rg = wave & 3, c = wave >> 2;
    LAS bf16_t* Qs = (LAS bf16_t*)(lds + AT_Q);
    const size_t tok0 = (size_t)b * SEQ;
    const float lambda_init = 0.8f - 0.6f * __expf(-0.3f * (float)layer);
    float s1 = 0.f, s2 = 0.f;
    for (int i = 0; i < 64; ++i) { s1 += lq1[i] * lk1[i]; s2 += lq2[i] * lk2[i]; }
    const float lam = __expf(s1) - __expf(s2) + lambda_init;
    const float LOG2E = 1.4426950408889634f;
    const float sc2 = 0.125f * LOG2E;
    const float slope2 = exp2f(-2.0f * (float)(h + 1)) * LOG2E;
#pragma unroll
    for (int i = 0; i < 4; ++i) { const int idx = tid + NT * i, r = idx >> 4, cs = idx & 15;
        const u32x4 qv = *(const u32x4*)(proj + (tok0 + qb * 128 + r) * INC + C_AQ + h * 128 + cs * 8);
        u32x4 qs; qs.x = pkbf(bflo(qv.x) * sc2, bfhi(qv.x) * sc2); qs.y = pkbf(bflo(qv.y) * sc2, bfhi(qv.y) * sc2); qs.z = pkbf(bflo(qv.z) * sc2, bfhi(qv.z) * sc2); qs.w = pkbf(bflo(qv.w) * sc2, bfhi(qv.w) * sc2);
        *(LAS u32x4*)(Qs + r * 136 + cs * 8) = qs; }
    const int kr0 = tid >> 4, kcs = tid & 15;
    const int vkp = tid >> 4, vvg = tid & 15;
    const int vcolw = 2 * (vkp ^ (2 * (vvg >> 1)));
    const int hb4 = 4 * (hi ^ (l31 >> 4));
    u32x4 kreg[2], vreg[2];
    {
        const bf16_t* kb = proj + (tok0 + kr0) * INC + C_AK + h * 128 + kcs * 8;
        kreg[0] = *(const u32x4*)kb; kreg[1] = *(const u32x4*)(kb + (size_t)32 * INC);
        const bf16_t* vb = proj + (tok0 + 2 * vkp) * INC + C_AV + h * 128 + vvg * 8;
        vreg[0] = *(const u32x4*)vb; vreg[1] = *(const u32x4*)(vb + INC);
    }
    f32x16 O[4];
#pragma unroll
    for (int vt = 0; vt < 4; ++vt)
#pragma unroll
        for (int r = 0; r < 16; ++r) O[vt][r] = 0.f;
    float mrun = 0.f, lrun = 0.f;
    const int qpos = qb * 128 + 32 * rg + l31;
    const LAS bf16_t* qrow = Qs + (32 * rg + l31) * 136 + c * 64 + 8 * hi;
    for (int kt = 0; kt < SEQ / 64; ++kt) {
        const int cur = kt & 1;
        LAS bf16_t* Kc = (LAS bf16_t*)(lds + AT_K + cur * 17408); LAS bf16_t* Vc = (LAS bf16_t*)(lds + AT_V + cur * 17408);
        *(LAS u32x4*)(Kc + kr0 * 136 + kcs * 8) = kreg[0]; *(LAS u32x4*)(Kc + (kr0 + 32) * 136 + kcs * 8) = kreg[1];
#pragma unroll
        for (int e = 0; e < 8; ++e) { const unsigned lo = (e & 1) ? (vreg[0][e >> 1] >> 16) : (vreg[0][e >> 1] & 0xffffu); const unsigned hi16 = (e & 1) ? (vreg[1][e >> 1] & 0xffff0000u) : (vreg[1][e >> 1] << 16);
            *(LAS unsigned*)(Vc + (8 * vvg + e) * 68 + vcolw) = lo | hi16; }
        BARRIER();
        if (kt + 1 < SEQ / 64) {
            const bf16_t* kb = proj + (tok0 + (kt + 1) * 64 + kr0) * INC + C_AK + h * 128 + kcs * 8;
            kreg[0] = *(const u32x4*)kb; kreg[1] = *(const u32x4*)(kb + (size_t)32 * INC);
            const bf16_t* vb = proj + (tok0 + (kt + 1) * 64 + 2 * vkp) * INC + C_AV + h * 128 + vvg * 8;
            vreg[0] = *(const u32x4*)vb; vreg[1] = *(const u32x4*)(vb + INC);
        }
        f32x16 S[2];
#pragma unroll
        for (int ks = 0; ks < 2; ++ks)
#pragma unroll
            for (int r = 0; r < 16; ++r) S[ks][r] = -mrun;
#pragma unroll
        for (int st = 0; st < 4; ++st) {
            const bf16x8 qf = *(const LAS bf16x8*)(qrow + 16 * st);
#pragma unroll
            for (int ks = 0; ks < 2; ++ks) { const bf16x8 kf = *(const LAS bf16x8*)(Kc + (32 * ks + l31) * 136 + c * 64 + 16 * st + 8 * hi);
                S[ks] = __builtin_amdgcn_mfma_f32_32x32x16_bf16(kf, qf, S[ks], 0, 0, 0); }
        }
        float mx = -1e30f;
#pragma unroll
        for (int ks = 0; ks < 2; ++ks) { const float fq = (float)(qpos - (64 * kt + 32 * ks + 4 * hi));
#pragma unroll
            for (int r = 0; r < 16; ++r) { const float tt = fq - (float)((r & 3) + 8 * (r >> 2)); const float v = fmaf(-slope2, fabsf(tt), S[ks][r]); S[ks][r] = v; mx = fmaxf(mx, v); } }
        mx = fmaxf(mx, __shfl_xor(mx, 32));
        float psum = 0.f, delta = 0.f;
        const bool slow = (kt == 0) || __builtin_amdgcn_ballot_w64(mx > 4.0f) != 0ull;
        if (slow) {
            delta = (kt == 0) ? mx : fmaxf(mx, 0.f); const float alpha = (kt == 0) ? 1.0f : __builtin_amdgcn_exp2f(-delta);
            mrun += delta; lrun *= alpha;
#pragma unroll
            for (int vt = 0; vt < 4; ++vt) O[vt] = O[vt] * alpha;
        }
        if (slow) {
#pragma unroll
            for (int ks = 0; ks < 2; ++ks)
#pragma unroll
                for (int r = 0; r < 16; ++r) { const float pv = __builtin_amdgcn_exp2f(S[ks][r] - delta); S[ks][r] = pv; psum += pv; }
        } else {
#pragma unroll
            for (int ks = 0; ks < 2; ++ks)
#pragma unroll
                for (int r = 0; r < 16; ++r) { const float pv = __builtin_amdgcn_exp2f(S[ks][r]); S[ks][r] = pv; psum += pv; }
        }
        lrun += psum;
        bf16x8 pf[2][2];
#pragma unroll
        for (int ks = 0; ks < 2; ++ks)
#pragma unroll
            for (int s = 0; s < 2; ++s) { u32x4 pw; pw.x = pkbf(S[ks][8 * s + 0], S[ks][8 * s + 1]); pw.y = pkbf(S[ks][8 * s + 2], S[ks][8 * s + 3]);
                pw.z = pkbf(S[ks][8 * s + 4], S[ks][8 * s + 5]); pw.w = pkbf(S[ks][8 * s + 6], S[ks][8 * s + 7]); pf[ks][s] = __builtin_bit_cast(bf16x8, pw); }
#pragma unroll
        for (int vt = 0; vt < 4; ++vt) {
            f32x16 o = O[vt];
#pragma unroll
            for (int ks = 0; ks < 2; ++ks)
#pragma unroll
                for (int s = 0; s < 2; ++s) {
                    const LAS bf16_t* vp = Vc + (32 * vt + l31) * 68 + 32 * ks + 16 * (s ^ (vt >> 1)) + hb4;
                    const u32x2 a = *(const LAS u32x2*)(vp + 8 * (vt & 1)), bq = *(const LAS u32x2*)(vp + 8 * (1 ^ (vt & 1)));
                    const u32x4 w = (u32x4){a.x, a.y, bq.x, bq.y};
                    o = __builtin_amdgcn_mfma_f32_32x32x16_bf16(__builtin_bit_cast(bf16x8, w), pf[ks][s], o, 0, 0, 0);
                }
            O[vt] = o;
        }
    }
    const float ltot = lrun + __shfl_xor(lrun, 32);
    LAS float* X = (LAS float*)(lds + AT_K);
    BARRIER();
    if (c == 1) { const float sc = lam / ltot;
#pragma unroll
        for (int vt = 0; vt < 4; ++vt)
#pragma unroll
            for (int rq = 0; rq < 4; ++rq) { const f32x4 w = (f32x4){O[vt][4 * rq + 0] * sc, O[vt][4 * rq + 1] * sc, O[vt][4 * rq + 2] * sc, O[vt][4 * rq + 3] * sc};
                *(LAS f32x4*)(X + (32 * rg + l31) * 132 + 32 * vt + 8 * rq + 4 * hi) = w; } }
    BARRIER();
    if (c == 0) { const float i0 = 1.0f / ltot; float ss = 0.f;
#pragma unroll
        for (int vt = 0; vt < 4; ++vt)
#pragma unroll
            for (int rq = 0; rq < 4; ++rq) { const f32x4 x = *(const LAS f32x4*)(X + (32 * rg + l31) * 132 + 32 * vt + 8 * rq + 4 * hi);
#pragma unroll
                for (int e = 0; e < 4; ++e) { const float o = O[vt][4 * rq + e] * i0 - x[e]; O[vt][4 * rq + e] = o; ss += o * o; } }
        ss += __shfl_xor(ss, 32);
        const float rs = rsqrtf(ss * (1.0f / 128.0f) + EPS) * (1.0f - lambda_init);
#pragma unroll
        for (int vt = 0; vt < 4; ++vt)
#pragma unroll
            for (int rq = 0; rq < 4; ++rq) { const int v0 = 32 * vt + 8 * rq + 4 * hi; const f32x4 gv = *(const f32x4*)(dng + v0);
                u32x2 w; w.x = pkbf(O[vt][4 * rq + 0] * rs * gv[0], O[vt][4 * rq + 1] * rs * gv[1]); w.y = pkbf(O[vt][4 * rq + 2] * rs * gv[2], O[vt][4 * rq + 3] * rs * gv[3]);
                *(LAS u32x2*)(Qs + (32 * rg + l31) * 136 + v0) = w; } }
    BARRIER();
#pragma unroll
    for (int i = 0; i < 4; ++i) { const int idx = tid + NT * i, r = idx >> 4, cs = idx & 15;
        *(u32x4*)(yattn + (tok0 + qb * 128 + r) * 512 + h * 128 + cs * 8) = *(const LAS u32x4*)(Qs + r * 136 + cs * 8); }
    BARRIER();
}

constexpr int HG_QD = 0, HG_QG = 17408, HG_KE = 34816, HG_KT = 52224, HG_V = HG_KT + 18432, HG_S = HG_V + 18432, HG_VEC = HG_S + 34816, HG_SCP = HG_VEC + 8192, HG_LB = HG_SCP + 18432, HG_END = HG_LB + 512;
static_assert(HG_END <= LDS_ITEM_OFF, "hgrn LDS");
__device__ __forceinline__ bf16x8 scale_frag(const u32x4 w, const f32x4 m0, const f32x4 m1) {
    u32x4 o; o.x = pkbf(bflo(w.x) * m0[0], bfhi(w.x) * m0[1]); o.y = pkbf(bflo(w.y) * m0[2], bfhi(w.y) * m0[3]); o.z = pkbf(bflo(w.z) * m1[0], bfhi(w.z) * m1[1]); o.w = pkbf(bflo(w.w) * m1[2], bfhi(w.w) * m1[3]);
    return __builtin_bit_cast(bf16x8, o);
}
#ifndef PROBE
#define PROBE 0
#endif
#define HG_T0(id) do { if (PROBE == (id) && blockIdx.x == 0 && tid == 0) *(LAS unsigned long long*)(lds + LDS_ITEM_OFF + 128) = __builtin_amdgcn_s_memrealtime(); } while (0)
#define HG_T1(id) do { if (PROBE == (id) && blockIdx.x == 0 && tid == 0) *(LAS unsigned long long*)(lds + LDS_ITEM_OFF + 136) += __builtin_amdgcn_s_memrealtime() - *(LAS unsigned long long*)(lds + LDS_ITEM_OFF + 128); } while (0)
__device__ __forceinline__ void hgrn_unit(LAS unsigned char* lds, const bf16_t* proj, const float* hlb  , int layer, bf16_t* o2  , int unit, int tid) {
    const int b = unit >> 3, h = (unit >> 1) & 3, dir = unit & 1;
    const int wave = __builtin_amdgcn_readfirstlane(tid >> 6), lane = tid & 63, lr = lane & 15, lg = lane >> 4;
    LAS bf16_t* Qd = (LAS bf16_t*)(lds + HG_QD); LAS bf16_t* Qg = (LAS bf16_t*)(lds + HG_QG); LAS bf16_t* Ke = (LAS bf16_t*)(lds + HG_KE); LAS bf16_t* KeT = (LAS bf16_t*)(lds + HG_KT);
    LAS bf16_t* Vt = (LAS bf16_t*)(lds + HG_V); LAS bf16_t* St = (LAS bf16_t*)(lds + HG_S); LAS float* Vec = (LAS float*)(lds + HG_VEC); LAS bf16_t* Sc = (LAS bf16_t*)(lds + HG_SCP);
    LAS float* lbv = (LAS float*)(lds + HG_LB);
    const size_t tok0 = (size_t)b * SEQ;
    const float scale_q = 0.08838834764831845f;
    if (tid < 128) { const float* a = hlb + (size_t)dir * DEPTH * 512 + h * 128 + tid;
        const float a0 = a[0], a1 = a[512], a2 = a[1024], a3 = a[1536]; const float mx = fmaxf(fmaxf(a0, a1), fmaxf(a2, a3));
        const float e0 = __expf(a0 - mx), e1 = __expf(a1 - mx), e2 = __expf(a2 - mx), e3 = __expf(a3 - mx); const float inv = 1.0f / (e0 + e1 + e2 + e3);
        float lb = 0.f; if (layer >= 1) lb += e1 * inv; if (layer >= 2) lb += e2 * inv; if (layer >= 3) lb += e3 * inv;
        lbv[tid] = lb; }
    for (int idx = tid; idx < 128 * 136 / 2; idx += NT) ((LAS unsigned*)St)[idx] = 0u;
    f32x4 st[8];
#pragma unroll
    for (int vb = 0; vb < 8; ++vb) st[vb] = (f32x4){0.f, 0.f, 0.f, 0.f};
    const int ci4 = wave >> 1, half = lane >> 5, cp2 = 2 * (((wave & 1) << 5) | (lane & 31)), rb8 = 16 * ci4 + 8 * half;
    const __amdgpu_buffer_rsrc_t rsrc = __builtin_amdgcn_make_buffer_rsrc((void*)(proj + tok0 * INC + h * 128), (short)0, SEQ * INC * 2, 0x00020000);
    const int fcol = (dir == 0 ? C_RF : C_RB);
    const int vo = cp2 * 2 + (dir == 0 ? half : 1 - half) * (8 * INC * 2);
#define HG_ROWOFF(ci_, r_) ((dir == 0 ? ((ci_) * 64 + 16 * ci4 + (r_)) : (SEQ - 9 - ((ci_) * 64 + 16 * ci4 + (r_)))) * (INC * 2))
    unsigned qraw[8], zraw[8], vraw[8];
#pragma unroll
    for (int r = 0; r < 8; ++r) { const int ro = HG_ROWOFF(0, r);
        qraw[r] = __builtin_amdgcn_raw_buffer_load_b32(rsrc, vo, ro + C_RQ * 2, 0); zraw[r] = __builtin_amdgcn_raw_buffer_load_b32(rsrc, vo, ro + fcol * 2, 0); vraw[r] = __builtin_amdgcn_raw_buffer_load_b32(rsrc, vo, ro + C_RI * 2, 0); }
    BARRIER();
    typedef float f2 __attribute__((ext_vector_type(2)));
    for (int ci = 0; ci < SEQ / 64; ++ci) {
        HG_T0(12);
        {
            const f2 lb = *(const LAS f2*)(lbv + cp2), oml = 1.0f - lb;
            f2 ff[8]; f2 Pl = (f2){1.0f, 1.0f};
#pragma unroll
            for (int r = 0; r < 8; ++r) { f2 z = (f2){bflo(zraw[r]), bfhi(zraw[r])}; z = __builtin_elementwise_min(__builtin_elementwise_max(z, (f2){-30.0f, -30.0f}), (f2){30.0f, 30.0f});
                f2 ez; ez.x = __expf(-z.x); ez.y = __expf(-z.y); f2 sg; sg.x = __builtin_amdgcn_rcpf(1.0f + ez.x); sg.y = __builtin_amdgcn_rcpf(1.0f + ez.y);
                const f2 f = lb + oml * sg; ff[r] = f; Pl = Pl * f; }
            f2 Po; Po.x = __shfl_xor(Pl.x, 32); Po.y = __shfl_xor(Pl.y, 32);
            const f2 one = (f2){1.0f, 1.0f};
            f2 P = half ? Po : one;
#pragma unroll
            for (int r = 0; r < 8; ++r) { P = P * ff[r];
                const f2 qd = (f2){bflo(qraw[r]), bfhi(qraw[r])} * scale_q * P;
                *(LAS unsigned*)(Qd + (rb8 + r) * 136 + cp2) = pkbf(qd.x, qd.y); }
            if (half == 0) *(LAS f2*)(Vec + ci4 * 128 + cp2) = Pl * Po;
            unsigned kw0[4], kw1[4], vw0[4], vw1[4]; f2 suf = half ? one : Po;
#pragma unroll
            for (int r = 7; r >= 0; --r) { const f2 q = (f2){bflo(qraw[r]), bfhi(qraw[r])} * scale_q;
                const f2 ke = (1.0f - ff[r]) * suf; f2 iv; iv.x = fminf(__builtin_amdgcn_rcpf(suf.x), 5.5e34f); iv.y = fminf(__builtin_amdgcn_rcpf(suf.y), 5.5e34f); const f2 qg = q * iv;
                *(LAS unsigned*)(Qg + (rb8 + r) * 136 + cp2) = pkbf(qg.x, qg.y);
                const unsigned kd = pkbf(ke.x, ke.y); *(LAS unsigned*)(Ke + (rb8 + r) * 136 + cp2) = kd;
                const unsigned vd = vraw[r];
                if (r & 1) { kw0[r >> 1] = kd << 16; kw1[r >> 1] = kd & 0xffff0000u; vw0[r >> 1] = vd << 16; vw1[r >> 1] = vd & 0xffff0000u; }
                else { kw0[r >> 1] |= kd & 0xffffu; kw1[r >> 1] |= kd >> 16; vw0[r >> 1] |= vd & 0xffffu; vw1[r >> 1] |= vd >> 16; }
                suf = suf * ff[r]; }
            *(LAS u32x4*)(KeT + cp2 * 72 + rb8) = (u32x4){kw0[0], kw0[1], kw0[2], kw0[3]}; *(LAS u32x4*)(KeT + (cp2 + 1) * 72 + rb8) = (u32x4){kw1[0], kw1[1], kw1[2], kw1[3]};
            *(LAS u32x4*)(Vt + cp2 * 72 + rb8) = (u32x4){vw0[0], vw0[1], vw0[2], vw0[3]}; *(LAS u32x4*)(Vt + (cp2 + 1) * 72 + rb8) = (u32x4){vw1[0], vw1[1], vw1[2], vw1[3]};
        }
        BARRIER();
        if (ci + 1 < SEQ / 64) {
#pragma unroll
            for (int r = 0; r < 8; ++r) { const int ro = HG_ROWOFF(ci + 1, r);
                qraw[r] = __builtin_amdgcn_raw_buffer_load_b32(rsrc, vo, ro + C_RQ * 2, 0); zraw[r] = __builtin_amdgcn_raw_buffer_load_b32(rsrc, vo, ro + fcol * 2, 0); vraw[r] = __builtin_amdgcn_raw_buffer_load_b32(rsrc, vo, ro + C_RI * 2, 0); } }
        HG_T1(12); HG_T0(13);
        if (tid < 128) { const float T0 = Vec[tid], T1 = Vec[128 + tid], T2 = Vec[256 + tid], T3 = Vec[384 + tid];
            Vec[4 * 128 + tid] = T0; Vec[5 * 128 + tid] = T0 * T1; Vec[6 * 128 + tid] = T0 * T1 * T2;
            Vec[7 * 128 + tid] = T1; Vec[8 * 128 + tid] = T2; Vec[9 * 128 + tid] = T1 * T2;
            Vec[10 * 128 + tid] = T1 * T2 * T3; Vec[11 * 128 + tid] = T2 * T3; Vec[12 * 128 + tid] = T3; Vec[13 * 128 + tid] = 1.0f;
            Vec[14 * 128 + tid] = (T0 * T1) * (T2 * T3); }
        BARRIER();
        HG_T1(13); HG_T0(14);
        const int tb = wave & 3, vh = wave >> 2;
        {
            int nb = 1, i0 = 3, j0 = 0, i1 = 0, j1 = 0;
            switch (wave) { case 1: j0 = 1; break; case 2: i0 = 2; break; case 3: nb = 2; i0 = 0; j0 = 0; i1 = 1; j1 = 0; break; case 4: nb = 2; i0 = 1; j0 = 1; i1 = 2; j1 = 1; break;
                            case 5: nb = 2; i0 = 2; j0 = 2; i1 = 3; j1 = 2; break; case 6: j0 = 3; break; case 7: nb = 0; break; default: break; }
            for (int q = 0; q < nb; ++q) { const int bi = q ? i1 : i0, bj = q ? j1 : j0;
                f32x4 acc = (f32x4){0.f, 0.f, 0.f, 0.f};
                const int dsel = (bi - bj < 2) ? -1 : (bi == 2 ? 7 : (bj == 1 ? 8 : 9));
#pragma unroll
                for (int stp = 0; stp < 4; ++stp) { const int k0 = 32 * stp + 8 * lg;
                    bf16x8 a;
                    if (bj == bi) a = *(const LAS bf16x8*)(Qg + (16 * bi + lr) * 136 + k0);
                    else if (dsel < 0) a = *(const LAS bf16x8*)(Qd + (16 * bi + lr) * 136 + k0);
                    else a = scale_frag(*(const LAS u32x4*)(Qd + (16 * bi + lr) * 136 + k0), *(const LAS f32x4*)(Vec + dsel * 128 + k0), *(const LAS f32x4*)(Vec + dsel * 128 + k0 + 4));
                    const bf16x8 bq = *(const LAS bf16x8*)(Ke + (16 * bj + lr) * 136 + k0);
                    acc = __builtin_amdgcn_mfma_f32_16x16x32_bf16(a, bq, acc, 0, 0, 0); }
#pragma unroll
                for (int r = 0; r < 4; ++r) { float v = acc[r]; if (bj == bi && lr > 4 * lg + r) v = 0.f; Sc[(16 * bi + 4 * lg + r) * 72 + 16 * bj + lr] = (bf16_t)(pkbf(v, 0.f) & 0xffffu); } }
            if (wave == 7) {
#pragma unroll
                for (int zb = 0; zb < 6; ++zb) { const int bi = zb < 3 ? 0 : (zb < 5 ? 1 : 2), bj = zb < 3 ? zb + 1 : (zb < 5 ? zb - 1 : 3);
#pragma unroll
                    for (int r = 0; r < 4; ++r) Sc[(16 * bi + 4 * lg + r) * 72 + 16 * bj + lr] = (bf16_t)0; } }
        }
        f32x4 oa[4];
#pragma unroll
        for (int vb = 0; vb < 4; ++vb) oa[vb] = (f32x4){0.f, 0.f, 0.f, 0.f};
#pragma unroll
        for (int stp = 0; stp < 4; ++stp) { const int k0 = 32 * stp + 8 * lg;
            bf16x8 a;
            if (tb == 0) a = *(const LAS bf16x8*)(Qd + lr * 136 + k0);
            else a = scale_frag(*(const LAS u32x4*)(Qd + (16 * tb + lr) * 136 + k0), *(const LAS f32x4*)(Vec + (3 + tb) * 128 + k0), *(const LAS f32x4*)(Vec + (3 + tb) * 128 + k0 + 4));
#pragma unroll
            for (int vb = 0; vb < 4; ++vb) { const bf16x8 bq = *(const LAS bf16x8*)(St + (64 * vh + 16 * vb + lr) * 136 + k0);
                oa[vb] = __builtin_amdgcn_mfma_f32_16x16x32_bf16(a, bq, oa[vb], 0, 0, 0); } }
        BARRIER();
        HG_T1(14); HG_T0(15);
        {
#pragma unroll
            for (int stp = 0; stp < 2; ++stp) { const bf16x8 a = *(const LAS bf16x8*)(Sc + (16 * tb + lr) * 72 + 32 * stp + 8 * lg);
#pragma unroll
                for (int vb = 0; vb < 4; ++vb) { const bf16x8 bq = *(const LAS bf16x8*)(Vt + (64 * vh + 16 * vb + lr) * 72 + 32 * stp + 8 * lg);
                    oa[vb] = __builtin_amdgcn_mfma_f32_16x16x32_bf16(a, bq, oa[vb], 0, 0, 0); } }
            bf16_t* ob = o2 + (size_t)dir * TH * 512;
#pragma unroll
            for (int r = 0; r < 4; ++r) { const int pp_ = ci * 64 + 16 * tb + 4 * lg + r; const size_t tk = tok0 + (size_t)(dir == 0 ? pp_ : (SEQ - 1 - pp_));
#pragma unroll
                for (int vb = 0; vb < 4; ++vb) ob[tk * 512 + h * 128 + 64 * vh + 16 * vb + lr] = (bf16_t)(pkbf(oa[vb][r], 0.f) & 0xffffu); } }
        { const int kb = 16 * wave;
#pragma unroll
            for (int r = 0; r < 4; ++r) { const float dec = Vec[14 * 128 + kb + 4 * lg + r];
#pragma unroll
                for (int vb = 0; vb < 8; ++vb) st[vb][r] *= dec; }
#pragma unroll
            for (int stp = 0; stp < 2; ++stp) { const float fj = Vec[(10 + 2 * stp + (lg >> 1)) * 128 + kb + lr];
                const f32x4 m = (f32x4){fj, fj, fj, fj};
                const bf16x8 a = scale_frag(*(const LAS u32x4*)(KeT + (kb + lr) * 72 + 32 * stp + 8 * lg), m, m);
#pragma unroll
                for (int vb = 0; vb < 8; ++vb) { const bf16x8 bq = *(const LAS bf16x8*)(Vt + (16 * vb + lr) * 72 + 32 * stp + 8 * lg);
                    st[vb] = __builtin_amdgcn_mfma_f32_16x16x32_bf16(a, bq, st[vb], 0, 0, 0); } }
#pragma unroll
            for (int vb = 0; vb < 8; ++vb) { u32x2 w; w.x = pkbf(st[vb][0], st[vb][1]); w.y = pkbf(st[vb][2], st[vb][3]); *(LAS u32x2*)(St + (16 * vb + lr) * 136 + kb + 4 * lg) = w; } }
        BARRIER();
        HG_T1(15);
    }
#undef HG_ROWOFF
}
#define XB_TMO      128
#define XB_XCNT(j)  (256  + 64 * (j))
#define XB_XSUB(j)  (1280 + 64 * (j))
#define XB_XGEN(j)  (2304 + 64 * (j))
#define XB_TOP      3328
#define XB_TOPGEN   3392
#define XCD_BAR_WORDS 3456
#define XB_SPIN_CAP (1u << 22)

__device__ __forceinline__ unsigned xb_ld(unsigned* p)              { return __hip_atomic_load(p, __ATOMIC_RELAXED, __HIP_MEMORY_SCOPE_AGENT); }
__device__ __forceinline__ unsigned xb_add(unsigned* p, unsigned v) { return __hip_atomic_fetch_add(p, v, __ATOMIC_RELAXED, __HIP_MEMORY_SCOPE_AGENT); }
__device__ __forceinline__ unsigned xb_xcc_id() { return (unsigned)__builtin_amdgcn_s_getreg((3 << 11) | 20) & 0xFu; }
#define XB_SPIN(cond, bar) do { unsigned _sp = 0; while (cond) { __builtin_amdgcn_s_sleep(1); \
    if ((++_sp & 255u) == 0u) { if (xb_ld(&(bar)[XB_TMO])) break; if (_sp > XB_SPIN_CAP) { atomicAdd(&(bar)[XB_TMO], 1u); break; } } } } while (0)

struct XcdBarrier {
    unsigned* bar; unsigned x;
    volatile LAS unsigned* st;
};

__device__ __forceinline__ XcdBarrier xcd_barrier_post(unsigned* bar, volatile LAS unsigned* st) {
    XcdBarrier b; b.bar = bar; b.x = xb_xcc_id(); b.st = st;
    if (threadIdx.x == 0) (void)xb_add(&bar[XB_XCNT(b.x)], 1u);
    return b;
}
__device__ __forceinline__ void xcd_barrier_complete(unsigned* bar, unsigned x, unsigned& nloc, unsigned& nx) {
    const unsigned G = (gridDim.x * gridDim.y * gridDim.z) >> 3;
    unsigned sum, cnt, mine, sp = 0u;
    for (;;) {
        sum = 0u; cnt = 0u; mine = 0u;
#pragma unroll
        for (unsigned j = 0; j < 16; ++j) { const unsigned c = xb_ld(&bar[XB_XCNT(j)]); sum += c; cnt += (c > 0u) ? 1u : 0u; mine = (j == x) ? c : mine; }
        if (sum == G) break;
        __builtin_amdgcn_s_sleep(1);
        if ((++sp & 255u) == 0u) { if (xb_ld(&bar[XB_TMO])) break; if (sp > XB_SPIN_CAP) { atomicAdd(&bar[XB_TMO], 1u); break; } }
    }
    nloc = mine > 0u ? mine : 1u; nx = cnt > 0u ? cnt : 1u;
}

__device__ __forceinline__ void xcd_barrier(const XcdBarrier& b) {
    asm volatile("s_waitcnt vmcnt(0)" ::: "memory");
    __syncthreads();
    if (threadIdx.x == 0) {
        unsigned* bar = b.bar;
        __builtin_amdgcn_s_waitcnt(0);
        unsigned nloc = b.st[0], nx = b.st[1];
        if (nloc == 0u) { xcd_barrier_complete(bar, b.x, nloc, nx); b.st[0] = nloc; b.st[1] = nx; }
        const unsigned old = xb_add(&bar[XB_XSUB(b.x)], 1u);
        const unsigned gen = old / nloc;
        if (old + 1u == (gen + 1u) * nloc) {
            __builtin_amdgcn_fence(__ATOMIC_RELEASE, "agent");
            asm volatile("s_waitcnt vmcnt(0)" ::: "memory");
            const unsigned og = xb_add(&bar[XB_TOP], 1u);
            const unsigned tg = og / nx;
            if (og + 1u == (tg + 1u) * nx) xb_add(&bar[XB_TOPGEN], 1u);
            else XB_SPIN(xb_ld(&bar[XB_TOPGEN]) == tg, bar);
            __builtin_amdgcn_fence(__ATOMIC_ACQUIRE, "agent");
            xb_add(&bar[XB_XGEN(b.x)], 1u);
            asm volatile("s_waitcnt vmcnt(0)" ::: "memory");
        } else {
            XB_SPIN(xb_ld(&bar[XB_XGEN(b.x)]) == gen, bar);
            __builtin_amdgcn_fence(__ATOMIC_ACQUIRE, "agent");
            asm volatile("s_waitcnt vmcnt(0)" ::: "memory");
        }
    }
    __syncthreads();
}

constexpr int N_SCAN = 4 * 2;
constexpr int N_ATT = 4 * (SEQ / 128);
constexpr int N_POOLU = (TH / 128) * 4;
#ifndef PROBE
#define PROBE 0
#endif

__global__ void __launch_bounds__(NT, 2) mega_fwd(Params p) {
    extern __shared__ __attribute__((aligned(16))) unsigned char smem[];
    cg::grid_group grid = cg::this_grid();
    LAS unsigned char* lds = (LAS unsigned char*)smem;
    const int G = gridDim.x, bid = blockIdx.x, NGW = G * NW;
    const int grp = bid & 7, gidx = bid >> 3, GS = G >> 3, NGWG = GS * NW;
#define GRID_SYNC_CG() do { asm volatile("s_waitcnt vmcnt(0) lgkmcnt(0)" ::: "memory"); grid.sync(); __builtin_amdgcn_fence(__ATOMIC_ACQUIRE, "agent"); asm volatile("s_waitcnt vmcnt(0)" ::: "memory"); } while (0)
#define GROUP_SYNC() xcd_barrier(xbar)
#define OPAQUE_TID() int tid = threadIdx.x; asm volatile("" : "+v"(tid)); const int lane = tid & 63, wave = __builtin_amdgcn_readfirstlane(tid >> 6), gw = bid * NW + wave, gwg = gidx * NW + wave; (void)lane; (void)gw; (void)gwg
    unsigned char* ws = p.ws;
    unsigned* ctl = (unsigned*)(ws + WS_CTL);
    unsigned char* arena = ws + WS_ARENA + (size_t)grp * ARENA;
    bf16_t* proj = (bf16_t*)(arena + WS_PROJ); bf16_t* gates = (bf16_t*)(arena + WS_GATE); bf16_t* hbuf = (bf16_t*)(arena + WS_H); bf16_t* ycat = (bf16_t*)(arena + WS_Y); bf16_t* o2 = (bf16_t*)(arena + WS_O2);
    bf16_t* act = proj;

    { LAS unsigned* stw = (LAS unsigned*)(lds + LDS_ITEM_OFF + 64); if (threadIdx.x < 2) stw[threadIdx.x] = 0u; }
    __syncthreads();
    const XcdBarrier xbar = xcd_barrier_post(ctl + 8192 + grp * XCD_BAR_WORDS, (volatile LAS unsigned*)(lds + LDS_ITEM_OFF + 64));
    { OPAQUE_TID(); p0_prologue(p, lds, gw, NGW, wave, lane);
      norm_rows_bf16(p.in[I_X] + (size_t)grp * TH * D, p.in[I_N1G], hbuf, TH, gwg, NGWG, lane); }
    GRID_SYNC_CG();

    for (int half = 0; half < NHALF; ++half) {
        const size_t seq_off = (size_t)(half * NGRP + grp) * TH * D;
        const float* xin = p.in[I_X] + seq_off;
        float* xres = p.out + seq_off;
        for (int l = 0; l < DEPTH; ++l) {
            unsigned char* wl = ws + WS_W + (size_t)l * W_LAYER;
            const float* xcur = (l == 0) ? xin : xres;
            if (half + l > 0) { { OPAQUE_TID(); norm_rows_bf16(xcur, p.in[I_N1G] + l * D, hbuf, TH, gwg, NGWG, lane); }
                GROUP_SYNC(); }
            { pg8::Gemm g{hbuf, (const bf16_t*)(wl + WO_IN), TH, NPROJ, D}; pg8::GroupOrder S; S.init(NPROJ, GS, gidx);
              pg8::EpiStore E{proj, INC, gates, INC / 256};
              pg8::gemm_phase<pg8::EpiStore, pg8::GroupOrder, true, true>(lds, g, S, E); }
            GROUP_SYNC();
            {
                OPAQUE_TID();
                for (int u = gidx; u < N_SCAN; u += GS) hgrn_unit(lds, proj, p.in[I_HLB], l, o2, u, tid);
                unsigned* ctr = ctl + 64 * (1 + (half * DEPTH + l) * NGRP + grp);
                LAS unsigned* item_w = (LAS unsigned*)(lds + LDS_ITEM_OFF);
                for (;;) {
                    if (tid == 0) *item_w = atomicAdd(ctr, 1u);
                    BARRIER();
                    const int item = (int)*item_w;
                    BARRIER();
                    if (item >= N_ATT + N_POOLU) break;
                    asm volatile("" : "+v"(tid));
                    if (item < N_ATT) attn_unit(lds, proj, p.in[I_LQ1] + l * 64, p.in[I_LK1] + l * 64, p.in[I_LQ2] + l * 64, p.in[I_LK2] + l * 64, p.in[I_DNG] + l * 128, l, ycat + (size_t)TH * 512, item, tid);
                    else pool_unit(lds, proj, (const bf16_t*)(wl + WO_POOL), p.in[I_POOLS] + l * 512, ycat, item - N_ATT, tid);
                }
            }
            GROUP_SYNC();
            { OPAQUE_TID(); hgrn_combine(o2, o2 + (size_t)TH * 512, proj, p.in[I_HNG] + l * 128, ycat + (size_t)2 * TH * 512, gwg, NGWG, lane); }
            GROUP_SYNC();
            { pg8::Gemm g{ycat, (const bf16_t*)(wl + WO_UP), 3 * TH, 3 * D, 512}; pg8::MergeOrder S; S.init(GS, gidx);
              pg8::EpiMerge2 E{gates, hbuf, TH / 256};
              pg8::gemm_phase<pg8::EpiMerge2, pg8::MergeOrder, true, true>(lds, g, S, E); }
            GROUP_SYNC();
            { pg8::Gemm g{hbuf, (const bf16_t*)(wl + WO_OUT), TH, D, D}; pg8::GroupOrder S; S.init(D, GS, gidx);
              pg8::EpiResid E{xcur, xres, D};
              pg8::gemm_phase<pg8::EpiResid, pg8::GroupOrder, true, true>(lds, g, S, E); }
            GROUP_SYNC();
            { OPAQUE_TID(); norm_rows_bf16(xres, p.in[I_N2G] + l * D, hbuf, TH, gwg, NGWG, lane); }
            GROUP_SYNC();
            { pg8::Gemm g{hbuf, (const bf16_t*)(wl + WO_FFI), TH, 2 * FF, D}; pg8::GroupOrder S; S.init(2 * FF, GS, gidx);
              pg8::EpiSwiGLU E{act, FF};
              pg8::gemm_phase<pg8::EpiSwiGLU, pg8::GroupOrder, true, true>(lds, g, S, E); }
            GROUP_SYNC();
            { pg8::Gemm g{act, (const bf16_t*)(wl + WO_FFO), TH, D, FF}; pg8::GroupOrder S; S.init(D, GS, gidx);
              pg8::EpiResid E{xres, xres, D};
              pg8::gemm_phase<pg8::EpiResid, pg8::GroupOrder, true, true>(lds, g, S, E); }
            GROUP_SYNC();
        }
        { OPAQUE_TID(); norm_rows_f32_inplace(xres, p.in[I_FNG], TH, gwg, NGWG, lane, 0); }
    }
}

extern "C" void kernel_launch(void* const* d_in, const int* in_sizes, int n_in, void* d_out, int out_size, void* d_ws, size_t ws_size, hipStream_t stream) {
    static int grid = 0;
    if (grid == 0) {
        if (n_in != 20 || in_sizes[0] != 2 * NGRP * TH * D || out_size != 2 * NGRP * TH * D || ws_size < WS_END) {
            fprintf(stderr, "kernel_launch: unexpected shapes (n_in %d, in0 %d, out %d, ws %zu); nothing launched\n", n_in, n_in > 0 ? in_sizes[0] : -1, out_size, ws_size); grid = -1; return; }
        int dev = 0, cus = 0, per_cu = 0;
        if (hipGetDevice(&dev) != hipSuccess || hipDeviceGetAttribute(&cus, hipDeviceAttributeMultiprocessorCount, dev) != hipSuccess) { grid = -1; return; }
        if (hipFuncSetAttribute((const void*)mega_fwd, hipFuncAttributeMaxDynamicSharedMemorySize, LDS_BYTES) != hipSuccess) { fprintf(stderr, "kernel_launch: hipFuncSetAttribute failed\n"); grid = -1; return; }
        if (hipOccupancyMaxActiveBlocksPerMultiprocessor(&per_cu, (const void*)mega_fwd, NT, LDS_BYTES) != hipSuccess || per_cu < 1) { fprintf(stderr, "kernel_launch: occupancy query says %d\n", per_cu); per_cu = 1; }
        (void)hipGetLastError();
        grid = (cus / 8) * 8;
        if (grid < 64) { fprintf(stderr, "kernel_launch: too few CUs (%d)\n", cus); grid = -1; return; }
    }
    if (grid < 0) return;
    (void)hipMemsetAsync((char*)d_ws + WS_CTL, 0, CTL_BYTES, stream);
    Params prm{};
    for (int i = 0; i < 20; ++i) prm.in[i] = (const float*)d_in[i];
    prm.out = (float*)d_out; prm.ws = (unsigned char*)d_ws;
    void* args[] = {&prm};
    hipError_t e = hipLaunchCooperativeKernel((const void*)mega_fwd, dim3(grid), dim3(NT), args, LDS_BYTES, stream);
    if (e != hipSuccess) fprintf(stderr, "cooperative launch failed: %s (grid %d)\n", hipGetErrorString(e), grid);
}
```

```cpp
#include <hip/hip_runtime.h>
#include <hip/hip_cooperative_groups.h>
#include <cstdio>
#include <cstdint>
namespace cg = cooperative_groups;
namespace pg8 {
#define PG8_LAS __attribute__((address_space(3)))
typedef unsigned short bf16_t;
typedef short bf16x8 __attribute__((ext_vector_type(8)));
typedef float f32x4 __attribute__((ext_vector_type(4)));
typedef unsigned u32x4 __attribute__((ext_vector_type(4)));
constexpr int BM = 256, BK = 64, HALF = 128, HTB = HALF * BK * 2  , STAGE_BYTES = 8 * HTB, NXCD = 8, WGM = 8;

__host__ __device__ __forceinline__ int lds_byte(int r, int c) { const int st = (r >> 4) * 2 + (c >> 5), rr = r & 15, cc = c & 31, ob = rr * 64 + cc * 2; return st * 1024 + (ob ^ (((ob >> 9) & 1) << 5)); }
__host__ __device__ __forceinline__ void stage_rc(int b, int& R, int& C) { const int st = b / 1024, sb = b % 1024, swz = sb ^ (((sb >> 9) & 1) << 5); R = (st >> 1) * 16 + swz / 64; C = (st & 1) * 32 + (swz % 64) / 2; }
__host__ __device__ __forceinline__ int perm32(int rho) { const int n = rho >> 4, i = rho & 15; return 8 * (i >> 2) + 4 * n + (i & 3); }

struct Unit { int pm, pn; };
struct Gemm { const bf16_t* A; const bf16_t* Bt; int M, N, K; };

struct StaticOrder {
    int nM, nN, nwg, G, c;
    __host__ __device__ void init(int M, int N, int G_, int c_) { nM = M / BM; nN = N / BM; nwg = nM * nN; G = G_; c = c_; }
    __host__ __device__ bool next(int i, Unit& u) const {
        const long L = (long)i * G + c; if (L >= nwg) return false;
        int wgid = (int)L; { const int q = nwg / NXCD, r = nwg % NXCD, xcd = wgid % NXCD, off = wgid / NXCD; wgid = (xcd < r ? xcd * (q + 1) : r * (q + 1) + (xcd - r) * q) + off; }
        const int nig = WGM * nN, gid = wgid / nig, fm = gid * WGM, gsz = (nM - fm) < WGM ? (nM - fm) : WGM;
        u.pm = fm + ((wgid % nig) % gsz); u.pn = (wgid % nig) / gsz; return true;
    }
    __device__ __forceinline__ void a_ready(const Unit&) const {}
    __device__ __forceinline__ void done(const Unit&) const {}
};

typedef float f32x2c_ __attribute__((ext_vector_type(2)));
typedef __bf16 bf16x2c_ __attribute__((ext_vector_type(2)));
__device__ __forceinline__ unsigned cvt_pk_bf16(float lo, float hi) { const f32x2c_ v = {lo, hi}; const bf16x2c_ b = __builtin_convertvector(v, bf16x2c_); return __builtin_bit_cast(unsigned, b); }
typedef float f32x2 __attribute__((ext_vector_type(2)));
__device__ __forceinline__ float fast_sigmoid(float x) { return __builtin_amdgcn_rcpf(1.0f + __expf(-x)); }
typedef unsigned u32x2v __attribute__((ext_vector_type(2)));
struct EpiStore {
    static constexpr bool PERM = true, AFTER_DRAIN = false, KEEP = false;
    bf16_t* O; int ldc; bf16_t* G; int nrm;
    __device__ __forceinline__ void operator()(const f32x4 (&acc)[2][2][4][2], const Unit& u, int wr, int wc, int fr, int fq) const {
        const int row0 = u.pm * BM + wr * 64 + fr; const int col0 = u.pn * BM + wc * 32 + 8 * fq;
        const bool dump = u.pn >= nrm;
        bf16_t* gt = G + ((size_t)(u.pm * 12 + (u.pn - nrm)) << 16) + (wr * 4 + wc) * 512 + (fq * 16 + fr) * 8;
#pragma unroll
        for (int ai = 0; ai < 2; ++ai)
#pragma unroll
            for (int m = 0; m < 4; ++m) { bf16_t* rowp = O + (size_t)(row0 + ai * HALF + m * 16) * ldc + col0;
#pragma unroll
                for (int bj = 0; bj < 2; ++bj) { const f32x4 v0 = acc[ai][bj][m][0], v1 = acc[ai][bj][m][1];
                    u32x4 w; w.x = cvt_pk_bf16(v0[0], v0[1]); w.y = cvt_pk_bf16(v0[2], v0[3]); w.z = cvt_pk_bf16(v1[0], v1[1]); w.w = cvt_pk_bf16(v1[2], v1[3]);
                    if (dump) *(u32x4*)(gt + ((ai * 4 + m) * 2 + bj) * 4096) = w; else *(u32x4*)(rowp + bj * HALF) = w; } }
    }
};
struct EpiMerge {
    static constexpr bool PERM = true, AFTER_DRAIN = false, KEEP = false;
    bf16_t* proj; int ldp; int gate_col0; bf16_t* merged; int MT;
    __device__ __forceinline__ void operator()(const f32x4 (&acc)[2][2][4][2], const Unit& u, int wr, int wc, int fr, int fq) const {
        const int br = u.pm / MT, pmt = u.pm - br * MT, pnt = u.pn & 3;
        const int row0 = pmt * BM + wr * 64 + fr; const int col0 = pnt * BM + wc * 32 + 8 * fq;
#pragma unroll
        for (int ai = 0; ai < 2; ++ai)
#pragma unroll
            for (int mp = 0; mp < 2; ++mp) {
                u32x4 gw[2][2]; f32x4 p0[2][2], p1[2][2];
#pragma unroll
                for (int mm = 0; mm < 2; ++mm)
#pragma unroll
                    for (int bj = 0; bj < 2; ++bj) { const size_t row = (size_t)(row0 + ai * HALF + (2 * mp + mm) * 16); bf16_t* prow = proj + row * ldp; const int col = col0 + bj * HALF;
                        gw[mm][bj] = *(const u32x4*)(prow + gate_col0 + br * 1024 + col);
                        if (br > 0) { const float* part = (const float*)prow + col; p0[mm][bj] = *(const f32x4*)part; p1[mm][bj] = *(const f32x4*)(part + 4); }
                        else { p0[mm][bj] = (f32x4){0.f, 0.f, 0.f, 0.f}; p1[mm][bj] = (f32x4){0.f, 0.f, 0.f, 0.f}; } }
#pragma unroll
                for (int mm = 0; mm < 2; ++mm)
#pragma unroll
                    for (int bj = 0; bj < 2; ++bj) { const int m = 2 * mp + mm; const size_t row = (size_t)(row0 + ai * HALF + m * 16); bf16_t* prow = proj + row * ldp; const int col = col0 + bj * HALF;
                        const u32x4 g = gw[mm][bj]; f32x4 g0, g1;
                        g0[0] = fast_sigmoid(__uint_as_float(g.x << 16)); g0[1] = fast_sigmoid(__uint_as_float(g.x & 0xffff0000u));
                        g0[2] = fast_sigmoid(__uint_as_float(g.y << 16)); g0[3] = fast_sigmoid(__uint_as_float(g.y & 0xffff0000u));
                        g1[0] = fast_sigmoid(__uint_as_float(g.z << 16)); g1[1] = fast_sigmoid(__uint_as_float(g.z & 0xffff0000u));
                        g1[2] = fast_sigmoid(__uint_as_float(g.w << 16)); g1[3] = fast_sigmoid(__uint_as_float(g.w & 0xffff0000u));
                        const f32x4 v0 = g0 * acc[ai][bj][m][0] + p0[mm][bj], v1 = g1 * acc[ai][bj][m][1] + p1[mm][bj];
                        if (br < 2) { float* part = (float*)prow + col; *(f32x4*)part = v0; *(f32x4*)(part + 4) = v1; }
                        else { u32x4 w; w.x = cvt_pk_bf16(v0[0], v0[1]); w.y = cvt_pk_bf16(v0[2], v0[3]); w.z = cvt_pk_bf16(v1[0], v1[1]); w.w = cvt_pk_bf16(v1[2], v1[3]);
                            *(u32x4*)(merged + row * 1024 + col) = w; } }
            }
    }
};
struct EpiMerge2 {
    static constexpr bool PERM = true, AFTER_DRAIN = false, KEEP = true;
    const bf16_t* G; bf16_t* merged; int MT;
    static __device__ __forceinline__ float epos(unsigned bits) { return 1.0f + __expf(-fminf(fmaxf(__uint_as_float(bits), -30.0f), 30.0f)); }
    __device__ __forceinline__ bool apply(f32x4 (&acc)[2][2][4][2], const Unit& u, int wr, int wc, int fr, int fq) const {
        const int br = u.pm / MT, pmt = u.pm - br * MT, pnt = u.pn & 3;
        const int row0 = pmt * BM + wr * 64 + fr; const int col0 = pnt * BM + wc * 32 + 8 * fq;
        const bf16_t* gt = G + ((size_t)(pmt * 12 + br * 4 + pnt) << 16) + (wr * 4 + wc) * 512 + (fq * 16 + fr) * 8;
#pragma unroll
        for (int ai = 0; ai < 2; ++ai)
#pragma unroll
            for (int m = 0; m < 4; ++m) { const size_t row = (size_t)(row0 + ai * HALF + m * 16);
#pragma unroll
                for (int bj = 0; bj < 2; ++bj) { const int col = col0 + bj * HALF; const bf16_t* gp = gt + ((ai * 4 + m) * 2 + bj) * 4096;
                    const u32x4 ga = *(const u32x4*)gp;
                    float f[8];
                    if (br < 2) { const u32x4 gb = *(const u32x4*)(gp + (4 << 16));
#pragma unroll
                        for (int e = 0; e < 4; ++e) { f[2 * e] = epos(gb[e] << 16) * __builtin_amdgcn_rcpf(epos(ga[e] << 16)); f[2 * e + 1] = epos(gb[e] & 0xffff0000u) * __builtin_amdgcn_rcpf(epos(ga[e] & 0xffff0000u)); }
                    } else {
#pragma unroll
                        for (int e = 0; e < 4; ++e) { f[2 * e] = __builtin_amdgcn_rcpf(epos(ga[e] << 16)); f[2 * e + 1] = __builtin_amdgcn_rcpf(epos(ga[e] & 0xffff0000u)); }
                    }
                    f32x4 v0 = acc[ai][bj][m][0], v1 = acc[ai][bj][m][1];
                    v0[0] *= f[0]; v0[1] *= f[1]; v0[2] *= f[2]; v0[3] *= f[3]; v1[0] *= f[4]; v1[1] *= f[5]; v1[2] *= f[6]; v1[3] *= f[7];
                    if (br < 2) { acc[ai][bj][m][0] = v0; acc[ai][bj][m][1] = v1; }
                    else { u32x4 w; w.x = cvt_pk_bf16(v0[0], v0[1]); w.y = cvt_pk_bf16(v0[2], v0[3]); w.z = cvt_pk_bf16(v1[0], v1[1]); w.w = cvt_pk_bf16(v1[2], v1[3]);
                        *(u32x4*)(merged + row * 1024 + col) = w; } } }
        return br < 2;
    }
};
struct EpiResid {
    static constexpr bool PERM = false, AFTER_DRAIN = false, KEEP = false;
    const float* base; float* out; int ldc;
    __device__ __forceinline__ void operator()(const f32x4 (&acc)[2][2][4][2], const Unit& u, int wr, int wc, int fr, int fq) const {
        const int row0 = u.pm * BM + wr * 64 + fr; const int col0 = u.pn * BM + wc * 32 + 4 * fq;
#pragma unroll
        for (int ai = 0; ai < 2; ++ai) {
            f32x4 bs[4][2][2];
#pragma unroll
            for (int m = 0; m < 4; ++m) { const size_t off = (size_t)(row0 + ai * HALF + m * 16) * ldc + col0;
#pragma unroll
                for (int bj = 0; bj < 2; ++bj)
#pragma unroll
                    for (int n = 0; n < 2; ++n) bs[m][bj][n] = *(const f32x4*)(base + off + bj * HALF + n * 16); }
#pragma unroll
            for (int m = 0; m < 4; ++m) { const size_t off = (size_t)(row0 + ai * HALF + m * 16) * ldc + col0;
#pragma unroll
                for (int bj = 0; bj < 2; ++bj)
#pragma unroll
                    for (int n = 0; n < 2; ++n) *(f32x4*)(out + off + bj * HALF + n * 16) = bs[m][bj][n] + acc[ai][bj][m][n]; }
        }
    }
};
struct EpiSwiGLU {
    static constexpr bool PERM = true, AFTER_DRAIN = false, KEEP = false;
    bf16_t* O; int ldc;
    __device__ __forceinline__ void operator()(const f32x4 (&acc)[2][2][4][2], const Unit& u, int wr, int wc, int fr, int fq) const {
        const int row0 = u.pm * BM + wr * 64 + fr; const int col0 = u.pn * HALF + wc * 32 + 8 * fq;
#pragma unroll
        for (int ai = 0; ai < 2; ++ai)
#pragma unroll
            for (int m = 0; m < 4; ++m) { bf16_t* rowp = O + (size_t)(row0 + ai * HALF + m * 16) * ldc + col0;
                f32x4 r0, r1;
#pragma unroll
                for (int e = 0; e < 4; ++e) { const float ga = acc[ai][0][m][0][e], gb = acc[ai][0][m][1][e];
                    r0[e] = ga * fast_sigmoid(ga) * acc[ai][1][m][0][e]; r1[e] = gb * fast_sigmoid(gb) * acc[ai][1][m][1][e]; }
                u32x4 w; w.x = cvt_pk_bf16(r0[0], r0[1]); w.y = cvt_pk_bf16(r0[2], r0[3]); w.z = cvt_pk_bf16(r1[0], r1[1]); w.w = cvt_pk_bf16(r1[2], r1[3]);
                *(u32x4*)rowp = w; }
    }
};
struct GroupOrder {
    int nwg, gs, c;
    __device__ void init(int N, int gs_, int c_) { nwg = 8 * (N / BM); gs = gs_; c = c_; }
    __device__ bool next(int i, Unit& u) const { const int L = i * gs + c; if (L >= nwg) return false; u.pm = L & 7; u.pn = L >> 3; return true; }
    __device__ __forceinline__ void a_ready(const Unit&) const {}
    __device__ __forceinline__ void done(const Unit&) const {}
};
struct GroupOrderWin {
    int nwg, gs, c, pn0;
    __device__ void init(int pn0_, int ntn, int gs_, int c_) { nwg = 8 * ntn; gs = gs_; c = c_; pn0 = pn0_; }
    __device__ bool next(int i, Unit& u) const { const int L = i * gs + c; if (c < 0 || L >= nwg) return false; u.pm = L & 7; u.pn = pn0 + (L >> 3); return true; }
    __device__ __forceinline__ void a_ready(const Unit&) const {}
    __device__ __forceinline__ void done(const Unit&) const {}
};
struct MergeOrder {
    GroupOrder S; int MT;
    __device__ void init(int gs_, int c_) { S.init(1024, gs_, c_); MT = 8; }
    __device__ bool next(int i, Unit& u) const { const int t = i / 3, br = i - 3 * t; Unit b; if (!S.next(t, b)) return false; u.pm = br * MT + b.pm; u.pn = br * 4 + b.pn; return true; }
    __device__ __forceinline__ void a_ready(const Unit&) const {}
    __device__ __forceinline__ void done(const Unit&) const {}
};

template <class Epi, class Sched, bool ALIGN_EPI = false, bool SP2 = false>
__device__ __forceinline__ void gemm_phase(PG8_LAS unsigned char* lds, const Gemm g, const Sched& S, const Epi& E) {
    int tid_ = threadIdx.x; asm volatile("" : "+v"(tid_));
    const int tid = tid_, wid = __builtin_amdgcn_readfirstlane(tid >> 6), lane = tid & 63, wr = wid >> 2, wc = wid & 3, fr = lane & 15, fq = lane >> 4;
    const int K = g.K, nt = K / BK;
    unsigned voffA[2], voffB[2];
#pragma unroll
    for (int i = 0; i < 2; ++i) { int R, C; stage_rc(tid * 16 + i * 8192, R, C); const int Rb = Epi::PERM ? ((R & ~31) + perm32(R & 31)) : R;
        voffA[i] = (unsigned)(R * K + C) * 2u; voffB[i] = (unsigned)(Rb * K + C) * 2u; }
    const size_t kstep = (size_t)(BK * 2);
    const size_t hstep = (size_t)HALF * K * 2;
    const size_t tstep = 2 * hstep;
    const unsigned ldsw = (unsigned)wid * 1024u;
    const int aoff = lds_byte(wr * 64 + fr, fq * 8), boff = lds_byte(wc * 32 + fr, fq * 8);
#define PG8_SA(b, h) (((b) * 2 + (h)) * HTB)
#define PG8_SB(b, h) ((4 + (b) * 2 + (h)) * HTB)
#define PG8_STAGE(bufoff, gbase, voff) do { _Pragma("unroll") for (int _i = 0; _i < 2; ++_i) \
        __builtin_amdgcn_global_load_lds((const unsigned*)((const char*)(gbase) + (voff)[_i]), (PG8_LAS unsigned*)(lds + (bufoff) + ldsw + _i * 8192), 16, 0, 0); } while (0)
#define PG8_LDA(dst, b, h) do { _Pragma("unroll") for (int m = 0; m < 4; ++m) _Pragma("unroll") for (int k = 0; k < 2; ++k) dst[m][k] = *(const PG8_LAS bf16x8*)(lds + PG8_SA(b, h) + aoff + m * 2048 + k * 1024); } while (0)
#define PG8_LDB(dst, b, h) do { _Pragma("unroll") for (int n = 0; n < 2; ++n) _Pragma("unroll") for (int k = 0; k < 2; ++k) dst[n][k] = *(const PG8_LAS bf16x8*)(lds + PG8_SB(b, h) + boff + n * 2048 + k * 1024); } while (0)
#define PG8_MMA(ai, bj, At, Bt) do { __builtin_amdgcn_s_setprio(1); _Pragma("unroll") for (int m = 0; m < 4; ++m) _Pragma("unroll") for (int n = 0; n < 2; ++n) _Pragma("unroll") for (int k = 0; k < 2; ++k) \
        acc[ai][bj][m][n] = __builtin_amdgcn_mfma_f32_16x16x32_bf16(Bt[n][k], At[m][k], acc[ai][bj][m][n], 0, 0, 0); __builtin_amdgcn_s_setprio(0); } while (0)
#define PG8_WAIT_V(n) asm volatile("s_waitcnt vmcnt(" #n ")" ::: "memory")
#define PG8_WAIT_L(n) asm volatile("s_waitcnt lgkmcnt(" #n ")" ::: "memory")
#define PG8_BAR __builtin_amdgcn_s_barrier()
#define PG8_SCHED __builtin_amdgcn_sched_barrier(0)
    Unit cur, nxt; int ui = 0;
    if (!S.next(0, cur)) return;
    f32x4 acc[2][2][4][2];
#pragma unroll
    for (int a = 0; a < 2; ++a)
#pragma unroll
        for (int b = 0; b < 2; ++b)
#pragma unroll
            for (int m = 0; m < 4; ++m)
#pragma unroll
                for (int n = 0; n < 2; ++n) acc[a][b][m][n] = (f32x4){0.f, 0.f, 0.f, 0.f};
    bf16x8 At[4][2], B0[2][2], B1[2][2];
    const char* cA = (const char*)g.A + (size_t)cur.pm * tstep; const char* cB = (const char*)g.Bt + (size_t)cur.pn * tstep;
    S.a_ready(cur);
    if constexpr (SP2) {
        PG8_STAGE(PG8_SB(0, 0), cB, voffB); PG8_STAGE(PG8_SB(0, 1), cB + hstep, voffB); PG8_STAGE(PG8_SA(0, 0), cA, voffA); PG8_STAGE(PG8_SA(0, 1), cA + hstep, voffA);
        if (wr == 1) PG8_BAR;
        PG8_WAIT_V(2); PG8_BAR;
        PG8_STAGE(PG8_SB(1, 0), cB + kstep, voffB); PG8_STAGE(PG8_SA(1, 0), cA + kstep, voffA); PG8_STAGE(PG8_SB(1, 1), cB + hstep + kstep, voffB);
        PG8_WAIT_V(6); PG8_BAR;
    } else {
        PG8_STAGE(PG8_SB(0, 0), cB, voffB); PG8_STAGE(PG8_SA(0, 0), cA, voffA); PG8_STAGE(PG8_SB(0, 1), cB + hstep, voffB); PG8_STAGE(PG8_SA(0, 1), cA + hstep, voffA);
        if (wr == 1) PG8_BAR;
        PG8_WAIT_V(4); PG8_BAR;
        PG8_STAGE(PG8_SB(1, 0), cB + kstep, voffB); PG8_STAGE(PG8_SA(1, 0), cA + kstep, voffA); PG8_STAGE(PG8_SB(1, 1), cB + hstep + kstep, voffB);
        PG8_WAIT_V(6); PG8_BAR;
    }
    for (;;) {
        const bool has_next = S.next(ui + 1, nxt);
        const char* nA = has_next ? (const char*)g.A + (size_t)nxt.pm * tstep : cA; const char* nB = has_next ? (const char*)g.Bt + (size_t)nxt.pn * tstep : cB;
        for (int t = 0; t < nt; t += 2) {
            const bool last = (t == nt - 2);
            const char* a1 = cA + (size_t)(t + 1) * kstep;
            const char* a2 = last ? nA : cA + (size_t)(t + 2) * kstep; const char* b2 = last ? nB : cB + (size_t)(t + 2) * kstep;
            const char* a3 = a2 + kstep; const char* b3 = b2 + kstep;
            if (last && has_next) S.a_ready(nxt);
            if constexpr (SP2) {
            PG8_LDB(B0, 0, 0); PG8_LDB(B1, 0, 1); PG8_SCHED; PG8_LDA(At, 0, 0); PG8_STAGE(PG8_SA(1, 1), a1 + hstep, voffA);
            PG8_WAIT_V(8); PG8_WAIT_L(0); PG8_BAR; PG8_MMA(0, 0, At, B0); PG8_MMA(0, 1, At, B1); PG8_BAR; PG8_SCHED;
            PG8_LDA(At, 0, 1); PG8_STAGE(PG8_SB(0, 0), b2, voffB); PG8_STAGE(PG8_SB(0, 1), b2 + hstep, voffB); PG8_STAGE(PG8_SA(0, 0), a2, voffA);
            PG8_WAIT_V(8); PG8_WAIT_L(0); PG8_BAR; PG8_MMA(1, 0, At, B0); PG8_MMA(1, 1, At, B1); PG8_BAR; PG8_SCHED;
            PG8_LDB(B0, 1, 0); PG8_LDB(B1, 1, 1); PG8_SCHED; PG8_LDA(At, 1, 0); PG8_STAGE(PG8_SA(0, 1), a2 + hstep, voffA);
            PG8_WAIT_V(8); PG8_WAIT_L(0); PG8_BAR; PG8_MMA(0, 0, At, B0); PG8_MMA(0, 1, At, B1); PG8_BAR; PG8_SCHED;
            PG8_LDA(At, 1, 1); PG8_STAGE(PG8_SB(1, 0), b3, voffB); PG8_STAGE(PG8_SB(1, 1), b3 + hstep, voffB); PG8_STAGE(PG8_SA(1, 0), a3, voffA);
            PG8_WAIT_V(8); PG8_WAIT_L(0); PG8_BAR; PG8_MMA(1, 0, At, B0); PG8_MMA(1, 1, At, B1); PG8_BAR; PG8_SCHED;
            } else {
            PG8_LDB(B0, 0, 0); PG8_SCHED; PG8_LDA(At, 0, 0); PG8_STAGE(PG8_SA(1, 1), a1 + hstep, voffA);
            PG8_WAIT_L(8); PG8_BAR; PG8_WAIT_L(0); PG8_MMA(0, 0, At, B0); PG8_BAR; PG8_SCHED;
            PG8_LDB(B1, 0, 1); PG8_STAGE(PG8_SB(0, 0), b2, voffB);
            PG8_BAR; PG8_WAIT_L(0); PG8_MMA(0, 1, At, B1); PG8_BAR;
            PG8_LDA(At, 0, 1); PG8_STAGE(PG8_SA(0, 0), a2, voffA);
            PG8_BAR; PG8_WAIT_L(0); PG8_MMA(1, 0, At, B0); PG8_BAR; PG8_SCHED;
            PG8_STAGE(PG8_SB(0, 1), b2 + hstep, voffB);
            PG8_WAIT_V(6); PG8_BAR; PG8_MMA(1, 1, At, B1); PG8_BAR;
            PG8_LDB(B0, 1, 0); PG8_SCHED; PG8_LDA(At, 1, 0); PG8_STAGE(PG8_SA(0, 1), a2 + hstep, voffA);
            PG8_WAIT_L(8); PG8_BAR; PG8_WAIT_L(0); PG8_MMA(0, 0, At, B0); PG8_BAR; PG8_SCHED;
            PG8_LDB(B1, 1, 1); PG8_STAGE(PG8_SB(1, 0), b3, voffB);
            PG8_BAR; PG8_WAIT_L(0); PG8_MMA(0, 1, At, B1); PG8_BAR;
            PG8_LDA(At, 1, 1); PG8_STAGE(PG8_SA(1, 0), a3, voffA);
            PG8_BAR; PG8_WAIT_L(0); PG8_MMA(1, 0, At, B0); PG8_BAR; PG8_SCHED;
            PG8_STAGE(PG8_SB(1, 1), b3 + hstep, voffB);
            PG8_WAIT_V(6); PG8_BAR; PG8_MMA(1, 1, At, B1); PG8_BAR;
            }
        }
        if constexpr (ALIGN_EPI) { if (wr == 0) PG8_BAR; }
        bool keep_acc = false;
        if constexpr (!Epi::AFTER_DRAIN) { if constexpr (Epi::KEEP) keep_acc = E.apply(acc, cur, wr, wc, fr, fq); else E(acc, cur, wr, wc, fr, fq); S.done(cur); }
        if (!has_next) break;
        if (!keep_acc) {
#pragma unroll
        for (int a = 0; a < 2; ++a)
#pragma unroll
            for (int b = 0; b < 2; ++b)
#pragma unroll
                for (int m = 0; m < 4; ++m)
#pragma unroll
                    for (int n = 0; n < 2; ++n) acc[a][b][m][n] = (f32x4){0.f, 0.f, 0.f, 0.f};
        }
        cur = nxt; cA = nA; cB = nB; ++ui;
        if constexpr (ALIGN_EPI) { if (wr == 1) PG8_BAR; }
    }
    PG8_WAIT_V(0);
    if constexpr (!ALIGN_EPI) { if (wr == 0) PG8_BAR; }
    PG8_BAR;
    if constexpr (Epi::AFTER_DRAIN) { E.fused(acc, cur, wr, wc, fr, fq, lds, wid, lane); S.done(cur); }
#undef PG8_SA
#undef PG8_SB
#undef PG8_STAGE
#undef PG8_LDA
#undef PG8_LDB
#undef PG8_MMA
#undef PG8_WAIT_V
#undef PG8_WAIT_L
#undef PG8_BAR
#undef PG8_SCHED
}
}

#define LAS __attribute__((address_space(3)))
typedef unsigned short bf16_t;
typedef short bf16x8 __attribute__((ext_vector_type(8)));
typedef float f32x4 __attribute__((ext_vector_type(4)));
typedef float f32x16 __attribute__((ext_vector_type(16)));
typedef unsigned u32x4 __attribute__((ext_vector_type(4)));
typedef unsigned u32x2 __attribute__((ext_vector_type(2)));

constexpr int D = 1024, SEQ = 2048, DEPTH = 4, NHALF = 2, HB = 1, TH = HB * SEQ, NGRP = 8;
constexpr int INC = 4608, NPROJ = 7680, FF = 2816;
constexpr int C_POOL = 0, C_AQ = 512, C_AK = 1024, C_AV = 1536, C_RQ = 2048, C_RF = 2560, C_RB = 3072, C_RI = 3584, C_RG = 4096, C_GATE = 4608;
constexpr float EPS = 1e-6f;
constexpr int NT = 512, NW = 8;
constexpr int LDS_BYTES = 155648;
constexpr int LDS_ITEM_OFF = 155136;

constexpr size_t MiB = 1u << 20;
constexpr size_t WS_CTL = 0, CTL_BYTES = 163840;
constexpr size_t WS_W = 2 * MiB, W_LAYER = 37 * MiB;
constexpr size_t WO_IN = 0, WO_POOL = (size_t)NPROJ * D * 2, WO_UP = WO_POOL + 4 * 128 * 128 * 2, WO_OUT = WO_UP + (size_t)3 * D * 512 * 2,
                 WO_FFI = WO_OUT + (size_t)D * D * 2, WO_FFO = WO_FFI + (size_t)2 * FF * D * 2, WO_END = WO_FFO + (size_t)D * FF * 2;
static_assert(WO_END <= W_LAYER, "weights per layer");
constexpr size_t WS_ARENA = 150 * MiB, ARENA = 44 * MiB;
constexpr size_t WS_PROJ = 0;
constexpr size_t WS_GATE = 18 * MiB;
constexpr size_t WS_H = 30 * MiB;
constexpr size_t WS_Y = 34 * MiB;
constexpr size_t WS_O2 = 40 * MiB;
constexpr size_t WS_END = WS_ARENA + NGRP * ARENA;
static_assert(WS_W + DEPTH * W_LAYER <= WS_ARENA && WS_PROJ + (size_t)TH * INC * 2 <= WS_GATE && WS_GATE + (size_t)TH * 3072 * 2 <= WS_H && WS_H + (size_t)TH * D * 2 <= WS_Y && WS_Y + (size_t)3 * TH * 512 * 2 <= WS_O2 && WS_O2 + (size_t)2 * TH * 512 * 2 <= ARENA && WS_END <= 512 * MiB, "ws map");

struct Params { const float* in[20]; float* out; unsigned char* ws; };
enum { I_X = 0, I_N1G, I_WIN, I_POOLW, I_POOLS, I_LQ1, I_LK1, I_LQ2, I_LK2, I_DNG, I_HLB, I_HNG, I_WUP, I_WUA, I_WUR, I_WOUT, I_N2G, I_WFI, I_WFO, I_FNG };

typedef float f32x2c __attribute__((ext_vector_type(2)));
typedef __bf16 bf16x2c __attribute__((ext_vector_type(2)));
__device__ __forceinline__ unsigned pkbf(float lo, float hi) { const f32x2c v = {lo, hi}; const bf16x2c b = __builtin_convertvector(v, bf16x2c); return __builtin_bit_cast(unsigned, b); }
__device__ __forceinline__ float bflo(unsigned w) { return __uint_as_float(w << 16); }
__device__ __forceinline__ float bfhi(unsigned w) { return __uint_as_float(w & 0xffff0000u); }
__device__ __forceinline__ float bfe(const u32x4& w, int e) { const unsigned x = w[e >> 1]; return (e & 1) ? bfhi(x) : bflo(x); }
__device__ __forceinline__ float sigm(float x) { return __builtin_amdgcn_rcpf(1.0f + __expf(-x)); }
__device__ __forceinline__ float wave_sum(float v) {
#pragma unroll
    for (int o = 1; o < 64; o <<= 1) v += __shfl_xor(v, o);
    return v;
}
#define BARRIER() __syncthreads()

__device__ __forceinline__ void p0_transpose_item(const float* W, int K, int N, bf16_t* WT, int row_off, int mode, LAS float* scr, int item, int lane) {
    const int nblk = N / 32, kb = item / nblk, nb = item - kb * nblk, k0 = 64 * kb, n0 = 32 * nb;
#pragma unroll
    for (int i = 0; i < 32; ++i) { const int kk = 2 * i + (lane >> 5); scr[kk * 33 + (lane & 31)] = W[(size_t)(k0 + kk) * N + n0 + (lane & 31)]; }
    asm volatile("s_waitcnt lgkmcnt(0)" ::: "memory");
    int drow0;
    if (mode == 1) { const int bj = n0 / FF, jj = n0 - bj * FF; drow0 = (jj >> 7) * 256 + bj * 128 + (jj & 127); } else drow0 = row_off + n0;
    const int c = lane & 7;
#pragma unroll
    for (int j = 0; j < 4; ++j) { const int n = (lane >> 3) + 8 * j; const LAS float* s = scr + (8 * c) * 33 + n;
        u32x4 o; o.x = pkbf(s[0 * 33], s[1 * 33]); o.y = pkbf(s[2 * 33], s[3 * 33]); o.z = pkbf(s[4 * 33], s[5 * 33]); o.w = pkbf(s[6 * 33], s[7 * 33]);
        *(u32x4*)(WT + (size_t)(drow0 + n) * K + k0 + 8 * c) = o; }
    asm volatile("s_waitcnt lgkmcnt(0)" ::: "memory");
}
__device__ __forceinline__ void p0_prologue(const Params& p, LAS unsigned char* lds, int gw, int NGW, int wave, int lane) {
    LAS float* scr = (LAS float*)(lds + wave * 16384);
    constexpr int I_IN = (D / 64) * (NPROJ / 32), I_PL = 4 * 2 * 4, I_UP = (512 / 64) * (D / 32), I_OUT = (D / 64) * (D / 32), I_FI = (D / 64) * (2 * FF / 32), I_FO = (FF / 64) * (D / 32);
    constexpr int PER_LAYER = I_IN + I_PL + 3 * I_UP + I_OUT + I_FI + I_FO;
    for (int it = gw; it < DEPTH * PER_LAYER; it += NGW) {
        const int l = it / PER_LAYER; int r = it - l * PER_LAYER;
        unsigned char* wl = p.ws + WS_W + (size_t)l * W_LAYER;
        if (r < I_IN) { p0_transpose_item(p.in[I_WIN] + (size_t)l * D * NPROJ, D, NPROJ, (bf16_t*)(wl + WO_IN), 0, 0, scr, r, lane); continue; } r -= I_IN;
        if (r < I_PL) { const int g = r >> 3; p0_transpose_item(p.in[I_POOLW] + (size_t)(l * 4 + g) * 128 * 128, 128, 128, (bf16_t*)(wl + WO_POOL) + (size_t)g * 128 * 128, 0, 0, scr, r & 7, lane); continue; } r -= I_PL;
        if (r < 3 * I_UP) { const int br = r / I_UP; const float* src = p.in[br == 0 ? I_WUP : (br == 1 ? I_WUA : I_WUR)] + (size_t)l * 512 * D;
            p0_transpose_item(src, 512, D, (bf16_t*)(wl + WO_UP), br * D, 0, scr, r - br * I_UP, lane); continue; } r -= 3 * I_UP;
        if (r < I_OUT) { p0_transpose_item(p.in[I_WOUT] + (size_t)l * D * D, D, D, (bf16_t*)(wl + WO_OUT), 0, 0, scr, r, lane); continue; } r -= I_OUT;
        if (r < I_FI) { p0_transpose_item(p.in[I_WFI] + (size_t)l * D * 2 * FF, D, 2 * FF, (bf16_t*)(wl + WO_FFI), 0, 1, scr, r, lane); continue; } r -= I_FI;
        p0_transpose_item(p.in[I_WFO] + (size_t)l * FF * D, FF, D, (bf16_t*)(wl + WO_FFO), 0, 0, scr, r, lane);
    }
}

__device__ __forceinline__ void norm_rows_bf16(const float* x, const float* g, bf16_t* h, int nrows, int gw, int NGW, int lane) {
    for (int row = gw; row < nrows; row += 2 * NGW) {
        const int row2 = row + NGW; const bool has2 = row2 < nrows;
        const f32x4* xr = (const f32x4*)(x + (size_t)row * D) + lane; const f32x4* xr2 = (const f32x4*)(x + (size_t)(has2 ? row2 : row) * D) + lane;
        f32x4 v[4], w2[4]; float ss = 0.f, ss2 = 0.f;
#pragma unroll
        for (int j = 0; j < 4; ++j) { v[j] = xr[64 * j]; w2[j] = xr2[64 * j]; }
#pragma unroll
        for (int j = 0; j < 4; ++j) { ss += (v[j][0] * v[j][0] + v[j][1] * v[j][1]) + (v[j][2] * v[j][2] + v[j][3] * v[j][3]); ss2 += (w2[j][0] * w2[j][0] + w2[j][1] * w2[j][1]) + (w2[j][2] * w2[j][2] + w2[j][3] * w2[j][3]); }
        const float rstd = rsqrtf(wave_sum(ss) * (1.0f / D) + EPS), rstd2 = rsqrtf(wave_sum(ss2) * (1.0f / D) + EPS);
        u32x2* o = (u32x2*)(h + (size_t)row * D) + lane; u32x2* o2p = (u32x2*)(h + (size_t)row2 * D) + lane;
#pragma unroll
        for (int j = 0; j < 4; ++j) { const f32x4 gv = ((const f32x4*)g)[lane + 64 * j]; const f32x4 y = v[j] * rstd * gv; u32x2 w; w.x = pkbf(y[0], y[1]); w.y = pkbf(y[2], y[3]); o[64 * j] = w;
            if (has2) { const f32x4 y2 = w2[j] * rstd2 * gv; u32x2 q; q.x = pkbf(y2[0], y2[1]); q.y = pkbf(y2[2], y2[3]); o2p[64 * j] = q; } }
    }
}
__device__ __forceinline__ void norm_rows_f32_inplace(float* x, const float* g, int nrows, int gw, int NGW, int lane, int probe_rows) {
    (void)probe_rows;
    for (int row = gw; row < nrows; row += 2 * NGW) {
        const int row2 = row + NGW; const bool has2 = row2 < nrows;
        f32x4* xr = (f32x4*)(x + (size_t)row * D) + lane; f32x4* xr2 = (f32x4*)(x + (size_t)(has2 ? row2 : row) * D) + lane;
        f32x4 v[4], w2[4]; float ss = 0.f, ss2 = 0.f;
#pragma unroll
        for (int j = 0; j < 4; ++j) { v[j] = xr[64 * j]; w2[j] = xr2[64 * j]; }
#pragma unroll
        for (int j = 0; j < 4; ++j) { ss += (v[j][0] * v[j][0] + v[j][1] * v[j][1]) + (v[j][2] * v[j][2] + v[j][3] * v[j][3]); ss2 += (w2[j][0] * w2[j][0] + w2[j][1] * w2[j][1]) + (w2[j][2] * w2[j][2] + w2[j][3] * w2[j][3]); }
        const float rstd = rsqrtf(wave_sum(ss) * (1.0f / D) + EPS), rstd2 = rsqrtf(wave_sum(ss2) * (1.0f / D) + EPS);
#pragma unroll
        for (int j = 0; j < 4; ++j) { const f32x4 gv = ((const f32x4*)g)[lane + 64 * j]; xr[64 * j] = v[j] * rstd * gv; if (has2) xr2[64 * j] = w2[j] * rstd2 * gv; }
    }
}
__device__ __forceinline__ void hgrn_combine(const bf16_t* of, const bf16_t* ob, const bf16_t* proj, const float* gain, bf16_t* yrec, int gw, int NGW, int lane) {
    const f32x4 g0 = *(const f32x4*)(gain + ((8 * lane) & 127)), g1 = *(const f32x4*)(gain + ((8 * lane) & 127) + 4);
    for (int row0 = gw; row0 < TH; row0 += 2 * NGW) {
        u32x4 a[2], b[2], gz[2]; int rows[2] = {row0, row0 + NGW};
#pragma unroll
        for (int q = 0; q < 2; ++q) { const int row = rows[q] < TH ? rows[q] : row0;
            a[q] = *((const u32x4*)(of + (size_t)row * 512) + lane); b[q] = *((const u32x4*)(ob + (size_t)row * 512) + lane); gz[q] = *((const u32x4*)(proj + (size_t)row * INC + C_RG) + lane); }
#pragma unroll
        for (int q = 0; q < 2; ++q) { if (rows[q] >= TH) continue;
            float o[8]; float ss = 0.f;
#pragma unroll
            for (int e = 0; e < 8; ++e) { o[e] = bfe(a[q], e) + bfe(b[q], e); ss += o[e] * o[e]; }
            ss += __shfl_xor(ss, 1); ss += __shfl_xor(ss, 2); ss += __shfl_xor(ss, 4); ss += __shfl_xor(ss, 8);
            const float rstd = rsqrtf(ss * (1.0f / 128.0f) + EPS);
            float y[8];
#pragma unroll
            for (int e = 0; e < 8; ++e) { const float z = bfe(gz[q], e); const float gg = e < 4 ? g0[e] : g1[e - 4]; y[e] = o[e] * rstd * gg * (z * sigm(z)); }
            u32x4 w; w.x = pkbf(y[0], y[1]); w.y = pkbf(y[2], y[3]); w.z = pkbf(y[4], y[5]); w.w = pkbf(y[6], y[7]);
            *((u32x4*)(yrec + (size_t)rows[q] * 512) + lane) = w; }
    }
}

__device__ __forceinline__ void pool_unit(LAS unsigned char* lds, const bf16_t* proj, const bf16_t* wpool  , const float* pscale  , bf16_t* ypool, int unit, int tid) {
    const int tile = unit >> 2, g = unit & 3, t0 = tile * 128, p0 = t0 & (SEQ - 1), hw = 1 << g;
    LAS bf16_t* U = (LAS bf16_t*)lds; LAS bf16_t* Dt = (LAS bf16_t*)(lds + 39168); LAS bf16_t* Bw = (LAS bf16_t*)(lds + 39168 + 34816);
    for (int idx = tid; idx < 144 * 16; idx += NT) { const int r = idx >> 4, cs = idx & 15; const int pp = p0 - 8 + r;
        u32x4 v = (u32x4){0u, 0u, 0u, 0u};
        if (pp >= 0 && pp < SEQ) v = *(const u32x4*)(proj + (size_t)(t0 - 8 + r) * INC + C_POOL + g * 128 + cs * 8);
        *(LAS u32x4*)(U + r * 136 + cs * 8) = v; }
    for (int idx = tid; idx < 128 * 16; idx += NT) { const int r = idx >> 4, cs = idx & 15;
        *(LAS u32x4*)(Bw + r * 136 + cs * 8) = *(const u32x4*)(wpool + (size_t)g * 128 * 128 + r * 128 + cs * 8); }
    BARRIER();
    for (int idx = tid; idx < 128 * 16; idx += NT) { const int r = idx >> 4, cs = idx & 15; const int pp = p0 + r;
        int lo = pp - hw; if (lo < 0) lo = 0; int hi = pp + hw - 1; if (hi > SEQ - 1) hi = SEQ - 1;
        float s[8];
#pragma unroll
        for (int e = 0; e < 8; ++e) s[e] = 0.f;
        for (int q = lo; q <= hi; ++q) { const u32x4 v = *(const LAS u32x4*)(U + (q - p0 + 8) * 136 + cs * 8);
#pragma unroll
            for (int e = 0; e < 8; ++e) s[e] += bfe(v, e); }
        const float inv = 1.0f / (float)(hi - lo + 1);
        const u32x4 c = *(const LAS u32x4*)(U + (r + 8) * 136 + cs * 8);
        u32x4 w; w.x = pkbf(s[0] * inv - bfe(c, 0), s[1] * inv - bfe(c, 1)); w.y = pkbf(s[2] * inv - bfe(c, 2), s[3] * inv - bfe(c, 3));
        w.z = pkbf(s[4] * inv - bfe(c, 4), s[5] * inv - bfe(c, 5)); w.w = pkbf(s[6] * inv - bfe(c, 6), s[7] * inv - bfe(c, 7));
        *(LAS u32x4*)(Dt + r * 136 + cs * 8) = w; }
    BARRIER();
    const int wave = tid >> 6, lane = tid & 63, lr = lane & 15, lg = lane >> 4;
    f32x4 acc[8];
#pragma unroll
    for (int cb = 0; cb < 8; ++cb) acc[cb] = (f32x4){0.f, 0.f, 0.f, 0.f};
#pragma unroll
    for (int st = 0; st < 4; ++st) { const bf16x8 a = *(const LAS bf16x8*)(Dt + (16 * wave + lr) * 136 + 32 * st + 8 * lg);
#pragma unroll
        for (int cb = 0; cb < 8; ++cb) { const bf16x8 b = *(const LAS bf16x8*)(Bw + (16 * cb + lr) * 136 + 32 * st + 8 * lg);
            acc[cb] = __builtin_amdgcn_mfma_f32_16x16x32_bf16(a, b, acc[cb], 0, 0, 0); } }
#pragma unroll
    for (int cb = 0; cb < 8; ++cb) { const int n = g * 128 + 16 * cb + lr; const float sc = pscale[n];
#pragma unroll
        for (int r = 0; r < 4; ++r) { const int row = t0 + 16 * wave + 4 * lg + r; ypool[(size_t)row * 512 + n] = (bf16_t)(pkbf(acc[cb][r] * sc, 0.f) & 0xffffu); } }
    BARRIER();
}

constexpr int KSTR = 152, KBUF = 64 * KSTR * 2;
constexpr int AT_Q = 0, AT_K = 34816, AT_V = AT_K + 2 * KBUF, AT_END = AT_V + 2 * 17408;
static_assert(AT_END <= LDS_ITEM_OFF && 128 * 132 * 4 <= 2 * KBUF + 2 * 17408, "attention LDS");
__device__ __forceinline__ void attn_unit(LAS unsigned char* lds, const bf16_t* proj, const float* lq1, const float* lk1, const float* lq2, const float* lk2, const float* dng, int layer, bf16_t* yattn, int unit, int tid) {
    const int b = unit >> 6, h = (unit >> 4) & 3, qb = unit & 15;
    const int wave = __builtin_amdgcn_readfirstlane(tid >> 6), lane = tid & 63, l31 = lane & 31, hi = lane >> 5, rg = wave & 3, c = wave >> 2;
    LAS bf16_t* Qs = (LAS bf16_t*)(lds + AT_Q);
    const size_t tok0 = (size_t)b * SEQ;
    const float lambda_init = 0.8f - 0.6f * __expf(-0.3f * (float)layer);
    float s1 = 0.f, s2 = 0.f;
    for (int i = 0; i < 64; ++i) { s1 += lq1[i] * lk1[i]; s2 += lq2[i] * lk2[i]; }
    const float lam = __expf(s1) - __expf(s2) + lambda_init;
    const float LOG2E = 1.4426950408889634f;
    const float sc2 = 0.125f * LOG2E;
    const float slope2 = exp2f(-2.0f * (float)(h + 1)) * LOG2E;
#pragma unroll
    for (int i = 0; i < 4; ++i) { const int idx = tid + NT * i, r = idx >> 4, cs = idx & 15;
        const u32x4 qv = *(const u32x4*)(proj + (tok0 + qb * 128 + r) * INC + C_AQ + h * 128 + cs * 8);
        u32x4 qs; qs.x = pkbf(bflo(qv.x) * sc2, bfhi(qv.x) * sc2); qs.y = pkbf(bflo(qv.y) * sc2, bfhi(qv.y) * sc2); qs.z = pkbf(bflo(qv.z) * sc2, bfhi(qv.z) * sc2); qs.w = pkbf(bflo(qv.w) * sc2, bfhi(qv.w) * sc2);
        *(LAS u32x4*)(Qs + r * 136 + cs * 8) = qs; }
    const int kr0 = tid >> 4, kcs = tid & 15;
    const int vkp = tid >> 4, vvg = tid & 15;
    const int vcolw = 2 * (vkp ^ (2 * (vvg >> 1)));
    const int hb4 = 4 * (hi ^ (l31 >> 4));
    u32x4 kreg[2], vreg[2];
    {
        const bf16_t* kb = proj + (tok0 + kr0) * INC + C_AK + h * 128 + kcs * 8;
        kreg[0] = *(const u32x4*)kb; kreg[1] = *(const u32x4*)(kb + (size_t)32 * INC);
        const bf16_t* vb = proj + (tok0 + 2 * vkp) * INC + C_AV + h * 128 + vvg * 8;
        vreg[0] = *(const u32x4*)vb; vreg[1] = *(const u32x4*)(vb + INC);
    }
    f32x16 O[4];
#pragma unroll
    for (int vt = 0; vt < 4; ++vt)
#pragma unroll
        for (int r = 0; r < 16; ++r) O[vt][r] = 0.f;
    float mrun = 0.f, lrun = 0.f;
    if (tid < 128) { const int r = tid & 63; LAS bf16_t* kx = (LAS bf16_t*)(lds + AT_K + (tid >> 6) * KBUF) + r * KSTR + 128;
        const unsigned rb = __float_as_uint((float)r) >> 16; *(LAS u32x4*)kx = (u32x4){rb | (rb << 16), 0u, 0u, 0u}; *(LAS u32x4*)(kx + 8) = (u32x4){0u, 0u, 0u, 0u}; }
    const unsigned sl_hi = __float_as_uint(slope2) >> 16; const unsigned sl_lo = __float_as_uint(slope2 - __uint_as_float(sl_hi << 16)) >> 16;
    const unsigned qpw = hi == 0 ? (sl_hi | (sl_lo << 16)) : 0u;
    const bf16x8 qpf = __builtin_bit_cast(bf16x8, (u32x4){qpw, 0u, 0u, 0u}), qnf = __builtin_bit_cast(bf16x8, (u32x4){hi == 0 ? (qpw ^ 0x80008000u) : 0u, 0u, 0u, 0u});
    const int q0w = qb * 128 + 32 * rg;
    const int qpos = qb * 128 + 32 * rg + l31;
    const LAS bf16_t* qrow = Qs + (32 * rg + l31) * 136 + c * 64 + 8 * hi;
    for (int kt = 0; kt < SEQ / 64; ++kt) {
        const int cur = kt & 1;
        LAS bf16_t* Kc = (LAS bf16_t*)(lds + AT_K + cur * KBUF); LAS bf16_t* Vc = (LAS bf16_t*)(lds + AT_V + cur * 17408);
        *(LAS u32x4*)(Kc + kr0 * KSTR + kcs * 8) = kreg[0]; *(LAS u32x4*)(Kc + (kr0 + 32) * KSTR + kcs * 8) = kreg[1];
#pragma unroll
        for (int e = 0; e < 8; ++e) { const unsigned lo = (e & 1) ? (vreg[0][e >> 1] >> 16) : (vreg[0][e >> 1] & 0xffffu); const unsigned hi16 = (e & 1) ? (vreg[1][e >> 1] & 0xffff0000u) : (vreg[1][e >> 1] << 16);
            *(LAS unsigned*)(Vc + (8 * vvg + e) * 68 + vcolw) = lo | hi16; }
        BARRIER();
        if (kt + 1 < SEQ / 64) {
            const bf16_t* kb = proj + (tok0 + (kt + 1) * 64 + kr0) * INC + C_AK + h * 128 + kcs * 8;
            kreg[0] = *(const u32x4*)kb; kreg[1] = *(const u32x4*)(kb + (size_t)32 * INC);
            const bf16_t* vb = proj + (tok0 + (kt + 1) * 64 + 2 * vkp) * INC + C_AV + h * 128 + vvg * 8;
            vreg[0] = *(const u32x4*)vb; vreg[1] = *(const u32x4*)(vb + INC);
        }
        const int side = (64 * kt + 63 < q0w) ? 1 : ((64 * kt > q0w + 31) ? -1 : 0);
        const float sinit = (side == 0) ? -mrun : (-mrun + (side > 0 ? slope2 : -slope2) * (float)(64 * kt - qpos));
        f32x16 S[2];
#pragma unroll
        for (int ks = 0; ks < 2; ++ks)
#pragma unroll
            for (int r = 0; r < 16; ++r) S[ks][r] = sinit;
#pragma unroll
        for (int st = 0; st < 4; ++st) {
            const bf16x8 qf = *(const LAS bf16x8*)(qrow + 16 * st);
#pragma unroll
            for (int ks = 0; ks < 2; ++ks) { const bf16x8 kf = *(const LAS bf16x8*)(Kc + (32 * ks + l31) * KSTR + c * 64 + 16 * st + 8 * hi);
                S[ks] = __builtin_amdgcn_mfma_f32_32x32x16_bf16(kf, qf, S[ks], 0, 0, 0); }
        }
        float mx = -1e30f;
        if (side != 0) {
#pragma unroll
            for (int ks = 0; ks < 2; ++ks) { const bf16x8 kf = *(const LAS bf16x8*)(Kc + (32 * ks + l31) * KSTR + 128 + 8 * hi);
                S[ks] = __builtin_amdgcn_mfma_f32_32x32x16_bf16(kf, side > 0 ? qpf : qnf, S[ks], 0, 0, 0); }
#pragma unroll
            for (int ks = 0; ks < 2; ++ks)
#pragma unroll
                for (int r = 0; r < 16; ++r) mx = fmaxf(mx, S[ks][r]);
        } else {
#pragma unroll
            for (int ks = 0; ks < 2; ++ks) { const float fq = (float)(qpos - (64 * kt + 32 * ks + 4 * hi));
#pragma unroll
                for (int r = 0; r < 16; ++r) { const float tt = fq - (float)((r & 3) + 8 * (r >> 2)); const float v = fmaf(-slope2, fabsf(tt), S[ks][r]); S[ks][r] = v; mx = fmaxf(mx, v); } }
        }
        mx = fmaxf(mx, __shfl_xor(mx, 32));
        float psum = 0.f, delta = 0.f;
        const bool slow = (kt == 0) || __builtin_amdgcn_ballot_w64(mx > 4.0f) != 0ull;
        if (slow) {
            delta = (kt == 0) ? mx : fmaxf(mx, 0.f); const float alpha = (kt == 0) ? 1.0f : __builtin_amdgcn_exp2f(-delta);
            mrun += delta; lrun *= alpha;
#pragma unroll
            for (int vt = 0; vt < 4; ++vt) O[vt] = O[vt] * alpha;
        }
        if (slow) {
#pragma unroll
            for (int ks = 0; ks < 2; ++ks)
#pragma unroll
                for (int r = 0; r < 16; ++r) { const float pv = __builtin_amdgcn_exp2f(S[ks][r] - delta); S[ks][r] = pv; psum += pv; }
        } else {
#pragma unroll
            for (int ks = 0; ks < 2; ++ks)
#pragma unroll
                for (int r = 0; r < 16; ++r) { const float pv = __builtin_amdgcn_exp2f(S[ks][r]); S[ks][r] = pv; psum += pv; }
        }
        lrun += psum;
        bf16x8 pf[2][2];
#pragma unroll
        for (int ks = 0; ks < 2; ++ks)
#pragma unroll
            for (int s = 0; s < 2; ++s) { u32x4 pw; pw.x = pkbf(S[ks][8 * s + 0], S[ks][8 * s + 1]); pw.y = pkbf(S[ks][8 * s + 2], S[ks][8 * s + 3]);
                pw.z = pkbf(S[ks][8 * s + 4], S[ks][8 * s + 5]); pw.w = pkbf(S[ks][8 * s + 6], S[ks][8 * s + 7]); pf[ks][s] = __builtin_bit_cast(bf16x8, pw); }
#pragma unroll
        for (int vt = 0; vt < 4; ++vt) {
            f32x16 o = O[vt];
#pragma unroll
            for (int ks = 0; ks < 2; ++ks)
#pragma unroll
                for (int s = 0; s < 2; ++s) {
                    const LAS bf16_t* vp = Vc + (32 * vt + l31) * 68 + 32 * ks + 16 * (s ^ (vt >> 1)) + hb4;
                    const u32x2 a = *(const LAS u32x2*)(vp + 8 * (vt & 1)), bq = *(const LAS u32x2*)(vp + 8 * (1 ^ (vt & 1)));
                    const u32x4 w = (u32x4){a.x, a.y, bq.x, bq.y};
                    o = __builtin_amdgcn_mfma_f32_32x32x16_bf16(__builtin_bit_cast(bf16x8, w), pf[ks][s], o, 0, 0, 0);
                }
            O[vt] = o;
        }
    }
    const float ltot = lrun + __shfl_xor(lrun, 32);
    LAS float* X = (LAS float*)(lds + AT_K);
    BARRIER();
    if (c == 1) { const float sc = lam / ltot;
#pragma unroll
        for (int vt = 0; vt < 4; ++vt)
#pragma unroll
            for (int rq = 0; rq < 4; ++rq) { const f32x4 w = (f32x4){O[vt][4 * rq + 0] * sc, O[vt][4 * rq + 1] * sc, O[vt][4 * rq + 2] * sc, O[vt][4 * rq + 3] * sc};
                *(LAS f32x4*)(X + (32 * rg + l31) * 132 + 32 * vt + 8 * rq + 4 * hi) = w; } }
    BARRIER();
    if (c == 0) { const float i0 = 1.0f / ltot; float ss = 0.f;
#pragma unroll
        for (int vt = 0; vt < 4; ++vt)
#pragma unroll
            for (int rq = 0; rq < 4; ++rq) { const f32x4 x = *(const LAS f32x4*)(X + (32 * rg + l31) * 132 + 32 * vt + 8 * rq + 4 * hi);
#pragma unroll
                for (int e = 0; e < 4; ++e) { const float o = O[vt][4 * rq + e] * i0 - x[e]; O[vt][4 * rq + e] = o; ss += o * o; } }
        ss += __shfl_xor(ss, 32);
        const float rs = rsqrtf(ss * (1.0f / 128.0f) + EPS) * (1.0f - lambda_init);
#pragma unroll
        for (int vt = 0; vt < 4; ++vt)
#pragma unroll
            for (int rq = 0; rq < 4; ++rq) { const int v0 = 32 * vt + 8 * rq + 4 * hi; const f32x4 gv = *(const f32x4*)(dng + v0);
                u32x2 w; w.x = pkbf(O[vt][4 * rq + 0] * rs * gv[0], O[vt][4 * rq + 1] * rs * gv[1]); w.y = pkbf(O[vt][4 * rq + 2] * rs * gv[2], O[vt][4 * rq + 3] * rs * gv[3]);
                *(LAS u32x2*)(Qs + (32 * rg + l31) * 136 + v0) = w; } }
    BARRIER();
#pragma unroll
    for (int i = 0; i < 4; ++i) { const int idx = tid + NT * i, r = idx >> 4, cs = idx & 15;
        *(u32x4*)(yattn + (tok0 + qb * 128 + r) * 512 + h * 128 + cs * 8) = *(const LAS u32x4*)(Qs + r * 136 + cs * 8); }
    BARRIER();
}

constexpr int HG_QD = 0, HG_QG = 17408, HG_KE = 34816, HG_KT = 52224, HG_V = HG_KT + 18432, HG_S = HG_V + 18432, HG_VEC = HG_S + 34816, HG_SCP = HG_VEC + 8192, HG_LB = HG_SCP + 18432, HG_END = HG_LB + 512;
static_assert(HG_END <= LDS_ITEM_OFF, "hgrn LDS");
__device__ __forceinline__ bf16x8 scale_frag(const u32x4 w, const f32x4 m0, const f32x4 m1) {
    u32x4 o; o.x = pkbf(bflo(w.x) * m0[0], bfhi(w.x) * m0[1]); o.y = pkbf(bflo(w.y) * m0[2], bfhi(w.y) * m0[3]); o.z = pkbf(bflo(w.z) * m1[0], bfhi(w.z) * m1[1]); o.w = pkbf(bflo(w.w) * m1[2], bfhi(w.w) * m1[3]);
    return __builtin_bit_cast(bf16x8, o);
}
#ifndef PROBE
#define PROBE 0
#endif
#define HG_T0(id) do { if (PROBE == (id) && blockIdx.x == 0 && tid == 0) *(LAS unsigned long long*)(lds + LDS_ITEM_OFF + 128) = __builtin_amdgcn_s_memrealtime(); } while (0)
#define HG_T1(id) do { if (PROBE == (id) && blockIdx.x == 0 && tid == 0) *(LAS unsigned long long*)(lds + LDS_ITEM_OFF + 136) += __builtin_amdgcn_s_memrealtime() - *(LAS unsigned long long*)(lds + LDS_ITEM_OFF + 128); } while (0)
__device__ __forceinline__ void hgrn_unit(LAS unsigned char* lds, const bf16_t* proj, const float* hlb  , int layer, bf16_t* o2  , int unit, int tid) {
    const int b = unit >> 3, h = (unit >> 1) & 3, dir = unit & 1;
    const int wave = __builtin_amdgcn_readfirstlane(tid >> 6), lane = tid & 63, lr = lane & 15, lg = lane >> 4;
    LAS bf16_t* Qd = (LAS bf16_t*)(lds + HG_QD); LAS bf16_t* Qg = (LAS bf16_t*)(lds + HG_QG); LAS bf16_t* Ke = (LAS bf16_t*)(lds + HG_KE); LAS bf16_t* KeT = (LAS bf16_t*)(lds + HG_KT);
    LAS bf16_t* Vt = (LAS bf16_t*)(lds + HG_V); LAS bf16_t* St = (LAS bf16_t*)(lds + HG_S); LAS float* Vec = (LAS float*)(lds + HG_VEC); LAS bf16_t* Sc = (LAS bf16_t*)(lds + HG_SCP);
    LAS float* lbv = (LAS float*)(lds + HG_LB);
    const size_t tok0 = (size_t)b * SEQ;
    const float scale_q = 0.08838834764831845f;
    if (tid < 128) { const float* a = hlb + (size_t)dir * DEPTH * 512 + h * 128 + tid;
        const float a0 = a[0], a1 = a[512], a2 = a[1024], a3 = a[1536]; const float mx = fmaxf(fmaxf(a0, a1), fmaxf(a2, a3));
        const float e0 = __expf(a0 - mx), e1 = __expf(a1 - mx), e2 = __expf(a2 - mx), e3 = __expf(a3 - mx); const float inv = 1.0f / (e0 + e1 + e2 + e3);
        float lb = 0.f; if (layer >= 1) lb += e1 * inv; if (layer >= 2) lb += e2 * inv; if (layer >= 3) lb += e3 * inv;
        lbv[tid] = lb; }
    for (int idx = tid; idx < 128 * 136 / 2; idx += NT) ((LAS unsigned*)St)[idx] = 0u;
    f32x4 st[8];
#pragma unroll
    for (int vb = 0; vb < 8; ++vb) st[vb] = (f32x4){0.f, 0.f, 0.f, 0.f};
    const int ci4 = wave >> 1, half = lane >> 5, cp2 = 2 * (((wave & 1) << 5) | (lane & 31)), rb8 = 16 * ci4 + 8 * half;
    const __amdgpu_buffer_rsrc_t rsrc = __builtin_amdgcn_make_buffer_rsrc((void*)(proj + tok0 * INC + h * 128), (short)0, SEQ * INC * 2, 0x00020000);
    const int fcol = (dir == 0 ? C_RF : C_RB);
    const int vo = cp2 * 2 + (dir == 0 ? half : 1 - half) * (8 * INC * 2);
#define HG_ROWOFF(ci_, r_) ((dir == 0 ? ((ci_) * 64 + 16 * ci4 + (r_)) : (SEQ - 9 - ((ci_) * 64 + 16 * ci4 + (r_)))) * (INC * 2))
    unsigned qraw[8], zraw[8], vraw[8];
#pragma unroll
    for (int r = 0; r < 8; ++r) { const int ro = HG_ROWOFF(0, r);
        qraw[r] = __builtin_amdgcn_raw_buffer_load_b32(rsrc, vo, ro + C_RQ * 2, 0); zraw[r] = __builtin_amdgcn_raw_buffer_load_b32(rsrc, vo, ro + fcol * 2, 0); vraw[r] = __builtin_amdgcn_raw_buffer_load_b32(rsrc, vo, ro + C_RI * 2, 0); }
    BARRIER();
    typedef float f2 __attribute__((ext_vector_type(2)));
    for (int ci = 0; ci < SEQ / 64; ++ci) {
        HG_T0(12);
        {
            const f2 lb = *(const LAS f2*)(lbv + cp2), oml = 1.0f - lb;
            f2 ff[8]; f2 Pl = (f2){1.0f, 1.0f};
#pragma unroll
            for (int r = 0; r < 8; ++r) { f2 z = (f2){bflo(zraw[r]), bfhi(zraw[r])}; z = __builtin_elementwise_min(__builtin_elementwise_max(z, (f2){-30.0f, -30.0f}), (f2){30.0f, 30.0f});
                f2 ez; ez.x = __expf(-z.x); ez.y = __expf(-z.y); f2 sg; sg.x = __builtin_amdgcn_rcpf(1.0f + ez.x); sg.y = __builtin_amdgcn_rcpf(1.0f + ez.y);
                const f2 f = lb + oml * sg; ff[r] = f; Pl = Pl * f; }
            f2 Po; Po.x = __shfl_xor(Pl.x, 32); Po.y = __shfl_xor(Pl.y, 32);
            const f2 one = (f2){1.0f, 1.0f};
            f2 P = half ? Po : one;
#pragma unroll
            for (int r = 0; r < 8; ++r) { P = P * ff[r];
                const f2 qd = (f2){bflo(qraw[r]), bfhi(qraw[r])} * scale_q * P;
                *(LAS unsigned*)(Qd + (rb8 + r) * 136 + cp2) = pkbf(qd.x, qd.y); }
            if (half == 0) *(LAS f2*)(Vec + ci4 * 128 + cp2) = Pl * Po;
            unsigned kw0[4], kw1[4], vw0[4], vw1[4]; f2 suf = half ? one : Po;
#pragma unroll
            for (int r = 7; r >= 0; --r) { const f2 q = (f2){bflo(qraw[r]), bfhi(qraw[r])} * scale_q;
                const f2 ke = (1.0f - ff[r]) * suf; f2 iv; iv.x = fminf(__builtin_amdgcn_rcpf(suf.x), 5.5e34f); iv.y = fminf(__builtin_amdgcn_rcpf(suf.y), 5.5e34f); const f2 qg = q * iv;
                *(LAS unsigned*)(Qg + (rb8 + r) * 136 + cp2) = pkbf(qg.x, qg.y);
                const unsigned kd = pkbf(ke.x, ke.y); *(LAS unsigned*)(Ke + (rb8 + r) * 136 + cp2) = kd;
                const unsigned vd = vraw[r];
                if (r & 1) { kw0[r >> 1] = kd << 16; kw1[r >> 1] = kd & 0xffff0000u; vw0[r >> 1] = vd << 16; vw1[r >> 1] = vd & 0xffff0000u; }
                else { kw0[r >> 1] |= kd & 0xffffu; kw1[r >> 1] |= kd >> 16; vw0[r >> 1] |= vd & 0xffffu; vw1[r >> 1] |= vd >> 16; }
                suf = suf * ff[r]; }
            *(LAS u32x4*)(KeT + cp2 * 72 + rb8) = (u32x4){kw0[0], kw0[1], kw0[2], kw0[3]}; *(LAS u32x4*)(KeT + (cp2 + 1) * 72 + rb8) = (u32x4){kw1[0], kw1[1], kw1[2], kw1[3]};
            *(LAS u32x4*)(Vt + cp2 * 72 + rb8) = (u32x4){vw0[0], vw0[1], vw0[2], vw0[3]}; *(LAS u32x4*)(Vt + (cp2 + 1) * 72 + rb8) = (u32x4){vw1[0], vw1[1], vw1[2], vw1[3]};
        }
        BARRIER();
        if (ci + 1 < SEQ / 64) {
#pragma unroll
            for (int r = 0; r < 8; ++r) { const int ro = HG_ROWOFF(ci + 1, r);
                qraw[r] = __builtin_amdgcn_raw_buffer_load_b32(rsrc, vo, ro + C_RQ * 2, 0); zraw[r] = __builtin_amdgcn_raw_buffer_load_b32(rsrc, vo, ro + fcol * 2, 0); vraw[r] = __builtin_amdgcn_raw_buffer_load_b32(rsrc, vo, ro + C_RI * 2, 0); } }
        HG_T1(12); HG_T0(13);
        if (tid < 128) { const float T0 = Vec[tid], T1 = Vec[128 + tid], T2 = Vec[256 + tid], T3 = Vec[384 + tid];
            Vec[4 * 128 + tid] = T0; Vec[5 * 128 + tid] = T0 * T1; Vec[6 * 128 + tid] = T0 * T1 * T2;
            Vec[7 * 128 + tid] = T1; Vec[8 * 128 + tid] = T2; Vec[9 * 128 + tid] = T1 * T2;
            Vec[10 * 128 + tid] = T1 * T2 * T3; Vec[11 * 128 + tid] = T2 * T3; Vec[12 * 128 + tid] = T3; Vec[13 * 128 + tid] = 1.0f;
            Vec[14 * 128 + tid] = (T0 * T1) * (T2 * T3); }
        BARRIER();
        HG_T1(13); HG_T0(14);
        const int tb = wave & 3, vh = wave >> 2;
        {
            int nb = 1, i0 = 3, j0 = 0, i1 = 0, j1 = 0;
            switch (wave) { case 1: j0 = 1; break; case 2: i0 = 2; break; case 3: nb = 2; i0 = 0; j0 = 0; i1 = 1; j1 = 0; break; case 4: nb = 2; i0 = 1; j0 = 1; i1 = 2; j1 = 1; break;
                            case 5: nb = 2; i0 = 2; j0 = 2; i1 = 3; j1 = 2; break; case 6: j0 = 3; break; case 7: nb = 0; break; default: break; }
            for (int q = 0; q < nb; ++q) { const int bi = q ? i1 : i0, bj = q ? j1 : j0;
                f32x4 acc = (f32x4){0.f, 0.f, 0.f, 0.f};
                const int dsel = (bi - bj < 2) ? -1 : (bi == 2 ? 7 : (bj == 1 ? 8 : 9));
#pragma unroll
                for (int stp = 0; stp < 4; ++stp) { const int k0 = 32 * stp + 8 * lg;
                    bf16x8 a;
                    if (bj == bi) a = *(const LAS bf16x8*)(Qg + (16 * bi + lr) * 136 + k0);
                    else if (dsel < 0) a = *(const LAS bf16x8*)(Qd + (16 * bi + lr) * 136 + k0);
                    else a = scale_frag(*(const LAS u32x4*)(Qd + (16 * bi + lr) * 136 + k0), *(const LAS f32x4*)(Vec + dsel * 128 + k0), *(const LAS f32x4*)(Vec + dsel * 128 + k0 + 4));
                    const bf16x8 bq = *(const LAS bf16x8*)(Ke + (16 * bj + lr) * 136 + k0);
                    acc = __builtin_amdgcn_mfma_f32_16x16x32_bf16(a, bq, acc, 0, 0, 0); }
#pragma unroll
                for (int r = 0; r < 4; ++r) { float v = acc[r]; if (bj == bi && lr > 4 * lg + r) v = 0.f; Sc[(16 * bi + 4 * lg + r) * 72 + 16 * bj + lr] = (bf16_t)(pkbf(v, 0.f) & 0xffffu); } }
            if (wave == 7) {
#pragma unroll
                for (int zb = 0; zb < 6; ++zb) { const int bi = zb < 3 ? 0 : (zb < 5 ? 1 : 2), bj = zb < 3 ? zb + 1 : (zb < 5 ? zb - 1 : 3);
#pragma unroll
                    for (int r = 0; r < 4; ++r) Sc[(16 * bi + 4 * lg + r) * 72 + 16 * bj + lr] = (bf16_t)0; } }
        }
        f32x4 oa[4];
#pragma unroll
        for (int vb = 0; vb < 4; ++vb) oa[vb] = (f32x4){0.f, 0.f, 0.f, 0.f};
#pragma unroll
        for (int stp = 0; stp < 4; ++stp) { const int k0 = 32 * stp + 8 * lg;
            bf16x8 a;
            if (tb == 0) a = *(const LAS bf16x8*)(Qd + lr * 136 + k0);
            else a = scale_frag(*(const LAS u32x4*)(Qd + (16 * tb + lr) * 136 + k0), *(const LAS f32x4*)(Vec + (3 + tb) * 128 + k0), *(const LAS f32x4*)(Vec + (3 + tb) * 128 + k0 + 4));
#pragma unroll
            for (int vb = 0; vb < 4; ++vb) { const bf16x8 bq = *(const LAS bf16x8*)(St + (64 * vh + 16 * vb + lr) * 136 + k0);
                oa[vb] = __builtin_amdgcn_mfma_f32_16x16x32_bf16(a, bq, oa[vb], 0, 0, 0); } }
        BARRIER();
        HG_T1(14); HG_T0(15);
        {
#pragma unroll
            for (int stp = 0; stp < 2; ++stp) { const bf16x8 a = *(const LAS bf16x8*)(Sc + (16 * tb + lr) * 72 + 32 * stp + 8 * lg);
#pragma unroll
                for (int vb = 0; vb < 4; ++vb) { const bf16x8 bq = *(const LAS bf16x8*)(Vt + (64 * vh + 16 * vb + lr) * 72 + 32 * stp + 8 * lg);
                    oa[vb] = __builtin_amdgcn_mfma_f32_16x16x32_bf16(a, bq, oa[vb], 0, 0, 0); } }
            bf16_t* ob = o2 + (size_t)dir * TH * 512;
#pragma unroll
            for (int r = 0; r < 4; ++r) { const int pp_ = ci * 64 + 16 * tb + 4 * lg + r; const size_t tk = tok0 + (size_t)(dir == 0 ? pp_ : (SEQ - 1 - pp_));
#pragma unroll
                for (int vb = 0; vb < 4; ++vb) ob[tk * 512 + h * 128 + 64 * vh + 16 * vb + lr] = (bf16_t)(pkbf(oa[vb][r], 0.f) & 0xffffu); } }
        { const int kb = 16 * wave;
#pragma unroll
            for (int r = 0; r < 4; ++r) { const float dec = Vec[14 * 128 + kb + 4 * lg + r];
#pragma unroll
                for (int vb = 0; vb < 8; ++vb) st[vb][r] *= dec; }
#pragma unroll
            for (int stp = 0; stp < 2; ++stp) { const float fj = Vec[(10 + 2 * stp + (lg >> 1)) * 128 + kb + lr];
                const f32x4 m = (f32x4){fj, fj, fj, fj};
                const bf16x8 a = scale_frag(*(const LAS u32x4*)(KeT + (kb + lr) * 72 + 32 * stp + 8 * lg), m, m);
#pragma unroll
                for (int vb = 0; vb < 8; ++vb) { const bf16x8 bq = *(const LAS bf16x8*)(Vt + (16 * vb + lr) * 72 + 32 * stp + 8 * lg);
                    st[vb] = __builtin_amdgcn_mfma_f32_16x16x32_bf16(a, bq, st[vb], 0, 0, 0); } }
#pragma unroll
            for (int vb = 0; vb < 8; ++vb) { u32x2 w; w.x = pkbf(st[vb][0], st[vb][1]); w.y = pkbf(st[vb][2], st[vb][3]); *(LAS u32x2*)(St + (16 * vb + lr) * 136 + kb + 4 * lg) = w; } }
        BARRIER();
        HG_T1(15);
    }
#undef HG_ROWOFF
}
#define XB_TMO      128
#define XB_XCNT(j)  (256  + 64 * (j))
#define XB_XSUB(j)  (1280 + 64 * (j))
#define XB_XGEN(j)  (2304 + 64 * (j))
#define XB_TOP      3328
#define XB_TOPGEN   3392
#define XCD_BAR_WORDS 3456
#define XB_SPIN_CAP (1u << 22)

__device__ __forceinline__ unsigned xb_ld(unsigned* p)              { return __hip_atomic_load(p, __ATOMIC_RELAXED, __HIP_MEMORY_SCOPE_AGENT); }
__device__ __forceinline__ unsigned xb_add(unsigned* p, unsigned v) { return __hip_atomic_fetch_add(p, v, __ATOMIC_RELAXED, __HIP_MEMORY_SCOPE_AGENT); }
__device__ __forceinline__ unsigned xb_xcc_id() { return (unsigned)__builtin_amdgcn_s_getreg((3 << 11) | 20) & 0xFu; }
#define XB_SPIN(cond, bar) do { unsigned _sp = 0; while (cond) { __builtin_amdgcn_s_sleep(1); \
    if ((++_sp & 255u) == 0u) { if (xb_ld(&(bar)[XB_TMO])) break; if (_sp > XB_SPIN_CAP) { atomicAdd(&(bar)[XB_TMO], 1u); break; } } } } while (0)

struct XcdBarrier {
    unsigned* bar; unsigned x;
    volatile LAS unsigned* st;
};

__device__ __forceinline__ XcdBarrier xcd_barrier_post(unsigned* bar, volatile LAS unsigned* st) {
    XcdBarrier b; b.bar = bar; b.x = xb_xcc_id(); b.st = st;
    if (threadIdx.x == 0) (void)xb_add(&bar[XB_XCNT(b.x)], 1u);
    return b;
}
__device__ __forceinline__ void xcd_barrier_complete(unsigned* bar, unsigned x, unsigned& nloc, unsigned& nx) {
    const unsigned G = (gridDim.x * gridDim.y * gridDim.z) >> 3;
    unsigned sum, cnt, mine, sp = 0u;
    for (;;) {
        sum = 0u; cnt = 0u; mine = 0u;
#pragma unroll
        for (unsigned j = 0; j < 16; ++j) { const unsigned c = xb_ld(&bar[XB_XCNT(j)]); sum += c; cnt += (c > 0u) ? 1u : 0u; mine = (j == x) ? c : mine; }
        if (sum == G) break;
        __builtin_amdgcn_s_sleep(1);
        if ((++sp & 255u) == 0u) { if (xb_ld(&bar[XB_TMO])) break; if (sp > XB_SPIN_CAP) { atomicAdd(&bar[XB_TMO], 1u); break; } }
    }
    nloc = mine > 0u ? mine : 1u; nx = cnt > 0u ? cnt : 1u;
}

__device__ __forceinline__ void xcd_barrier(const XcdBarrier& b) {
    asm volatile("s_waitcnt vmcnt(0)" ::: "memory");
    __syncthreads();
    if (threadIdx.x == 0) {
        unsigned* bar = b.bar;
        __builtin_amdgcn_s_waitcnt(0);
        unsigned nloc = b.st[0], nx = b.st[1];
        if (nloc == 0u) { xcd_barrier_complete(bar, b.x, nloc, nx); b.st[0] = nloc; b.st[1] = nx; }
        const unsigned old = xb_add(&bar[XB_XSUB(b.x)], 1u);
        const unsigned gen = old / nloc;
        if (old + 1u == (gen + 1u) * nloc) {
            __builtin_amdgcn_fence(__ATOMIC_RELEASE, "agent");
            asm volatile("s_waitcnt vmcnt(0)" ::: "memory");
            const unsigned og = xb_add(&bar[XB_TOP], 1u);
            const unsigned tg = og / nx;
            if (og + 1u == (tg + 1u) * nx) xb_add(&bar[XB_TOPGEN], 1u);
            else XB_SPIN(xb_ld(&bar[XB_TOPGEN]) == tg, bar);
            __builtin_amdgcn_fence(__ATOMIC_ACQUIRE, "agent");
            xb_add(&bar[XB_XGEN(b.x)], 1u);
            asm volatile("s_waitcnt vmcnt(0)" ::: "memory");
        } else {
            XB_SPIN(xb_ld(&bar[XB_XGEN(b.x)]) == gen, bar);
            __builtin_amdgcn_fence(__ATOMIC_ACQUIRE, "agent");
            asm volatile("s_waitcnt vmcnt(0)" ::: "memory");
        }
    }
    __syncthreads();
}

constexpr int N_SCAN = 4 * 2;
constexpr int N_ATT = 4 * (SEQ / 128);
constexpr int N_POOLU = (TH / 128) * 4;
#ifndef PROBE
#define PROBE 0
#endif

__global__ void __launch_bounds__(NT, 2) mega_fwd(Params p) {
    extern __shared__ __attribute__((aligned(16))) unsigned char smem[];
    cg::grid_group grid = cg::this_grid();
    LAS unsigned char* lds = (LAS unsigned char*)smem;
    const int G = gridDim.x, bid = blockIdx.x, NGW = G * NW;
    const int grp = bid & 7, gidx = bid >> 3, GS = G >> 3, NGWG = GS * NW;
#define GRID_SYNC_CG() do { asm volatile("s_waitcnt vmcnt(0) lgkmcnt(0)" ::: "memory"); grid.sync(); __builtin_amdgcn_fence(__ATOMIC_ACQUIRE, "agent"); asm volatile("s_waitcnt vmcnt(0)" ::: "memory"); } while (0)
#define GROUP_SYNC() xcd_barrier(xbar)
#define OPAQUE_TID() int tid = threadIdx.x; asm volatile("" : "+v"(tid)); const int lane = tid & 63, wave = __builtin_amdgcn_readfirstlane(tid >> 6), gw = bid * NW + wave, gwg = gidx * NW + wave; (void)lane; (void)gw; (void)gwg
    unsigned char* ws = p.ws;
    unsigned* ctl = (unsigned*)(ws + WS_CTL);
    unsigned char* arena = ws + WS_ARENA + (size_t)grp * ARENA;
    bf16_t* proj = (bf16_t*)(arena + WS_PROJ); bf16_t* gates = (bf16_t*)(arena + WS_GATE); bf16_t* hbuf = (bf16_t*)(arena + WS_H); bf16_t* ycat = (bf16_t*)(arena + WS_Y); bf16_t* o2 = (bf16_t*)(arena + WS_O2);
    bf16_t* act = proj;

    { LAS unsigned* stw = (LAS unsigned*)(lds + LDS_ITEM_OFF + 64); if (threadIdx.x < 2) stw[threadIdx.x] = 0u; }
    __syncthreads();
    const XcdBarrier xbar = xcd_barrier_post(ctl + 8192 + grp * XCD_BAR_WORDS, (volatile LAS unsigned*)(lds + LDS_ITEM_OFF + 64));
    { OPAQUE_TID(); p0_prologue(p, lds, gw, NGW, wave, lane);
      norm_rows_bf16(p.in[I_X] + (size_t)grp * TH * D, p.in[I_N1G], hbuf, TH, gwg, NGWG, lane); }
    GRID_SYNC_CG();

    for (int half = 0; half < NHALF; ++half) {
        const size_t seq_off = (size_t)(half * NGRP + grp) * TH * D;
        const float* xin = p.in[I_X] + seq_off;
        float* xres = p.out + seq_off;
        for (int l = 0; l < DEPTH; ++l) {
            unsigned char* wl = ws + WS_W + (size_t)l * W_LAYER;
            const float* xcur = (l == 0) ? xin : xres;
            if (half + l > 0) { { OPAQUE_TID(); norm_rows_bf16(xcur, p.in[I_N1G] + l * D, hbuf, TH, gwg, NGWG, lane); }
                GROUP_SYNC(); }
            { pg8::Gemm g{hbuf, (const bf16_t*)(wl + WO_IN), TH, NPROJ, D}; pg8::GroupOrder S; S.init(NPROJ, GS, gidx);
              pg8::EpiStore E{proj, INC, gates, INC / 256};
              pg8::gemm_phase<pg8::EpiStore, pg8::GroupOrder, true, true>(lds, g, S, E); }
            GROUP_SYNC();
            {
                OPAQUE_TID();
                for (int u = gidx; u < N_SCAN; u += GS) hgrn_unit(lds, proj, p.in[I_HLB], l, o2, u, tid);
                unsigned* ctr = ctl + 64 * (1 + (half * DEPTH + l) * NGRP + grp);
                LAS unsigned* item_w = (LAS unsigned*)(lds + LDS_ITEM_OFF);
                for (;;) {
                    if (tid == 0) *item_w = atomicAdd(ctr, 1u);
                    BARRIER();
                    const int item = (int)*item_w;
                    BARRIER();
                    if (item >= N_ATT + N_POOLU) break;
                    asm volatile("" : "+v"(tid));
                    if (item < N_ATT) attn_unit(lds, proj, p.in[I_LQ1] + l * 64, p.in[I_LK1] + l * 64, p.in[I_LQ2] + l * 64, p.in[I_LK2] + l * 64, p.in[I_DNG] + l * 128, l, ycat + (size_t)TH * 512, item, tid);
                    else pool_unit(lds, proj, (const bf16_t*)(wl + WO_POOL), p.in[I_POOLS] + l * 512, ycat, item - N_ATT, tid);
                }
            }
            GROUP_SYNC();
            { OPAQUE_TID(); hgrn_combine(o2, o2 + (size_t)TH * 512, proj, p.in[I_HNG] + l * 128, ycat + (size_t)2 * TH * 512, gwg, NGWG, lane); }
            GROUP_SYNC();
            { pg8::Gemm g{ycat, (const bf16_t*)(wl + WO_UP), 3 * TH, 3 * D, 512}; pg8::MergeOrder S; S.init(GS, gidx);
              pg8::EpiMerge2 E{gates, hbuf, TH / 256};
              pg8::gemm_phase<pg8::EpiMerge2, pg8::MergeOrder, true, true>(lds, g, S, E); }
            GROUP_SYNC();
            { pg8::Gemm g{hbuf, (const bf16_t*)(wl + WO_OUT), TH, D, D}; pg8::GroupOrder S; S.init(D, GS, gidx);
              pg8::EpiResid E{xcur, xres, D};
              pg8::gemm_phase<pg8::EpiResid, pg8::GroupOrder, true, true>(lds, g, S, E); }
            GROUP_SYNC();
            { OPAQUE_TID(); norm_rows_bf16(xres, p.in[I_N2G] + l * D, hbuf, TH, gwg, NGWG, lane); }
            GROUP_SYNC();
            { pg8::Gemm g{hbuf, (const bf16_t*)(wl + WO_FFI), TH, 2 * FF, D}; pg8::GroupOrder S; S.init(2 * FF, GS, gidx);
              pg8::EpiSwiGLU E{act, FF};
              pg8::gemm_phase<pg8::EpiSwiGLU, pg8::GroupOrder, true, true>(lds, g, S, E); }
            GROUP_SYNC();
            { pg8::Gemm g{act, (const bf16_t*)(wl + WO_FFO), TH, D, FF}; pg8::GroupOrder S; S.init(D, GS, gidx);
              pg8::EpiResid E{xres, xres, D};
              pg8::gemm_phase<pg8::EpiResid, pg8::GroupOrder, true, true>(lds, g, S, E); }
            GROUP_SYNC();
        }
        { OPAQUE_TID(); norm_rows_f32_inplace(xres, p.in[I_FNG], TH, gwg, NGWG, lane, 0); }
    }
}

extern "C" void kernel_launch(void* const* d_in, const int* in_sizes, int n_in, void* d_out, int out_size, void* d_ws, size_t ws_size, hipStream_t stream) {
    static int grid = 0;
    if (grid == 0) {
        if (n_in != 20 || in_sizes[0] != 2 * NGRP * TH * D || out_size != 2 * NGRP * TH * D || ws_size < WS_END) {
            fprintf(stderr, "kernel_launch: unexpected shapes (n_in %d, in0 %d, out %d, ws %zu); nothing launched\n", n_in, n_in > 0 ? in_sizes[0] : -1, out_size, ws_size); grid = -1; return; }
        int dev = 0, cus = 0, per_cu = 0;
        if (hipGetDevice(&dev) != hipSuccess || hipDeviceGetAttribute(&cus, hipDeviceAttributeMultiprocessorCount, dev) != hipSuccess) { grid = -1; return; }
        if (hipFuncSetAttribute((const void*)mega_fwd, hipFuncAttributeMaxDynamicSharedMemorySize, LDS_BYTES) != hipSuccess) { fprintf(stderr, "kernel_launch: hipFuncSetAttribute failed\n"); grid = -1; return; }
        if (hipOccupancyMaxActiveBlocksPerMultiprocessor(&per_cu, (const void*)mega_fwd, NT, LDS_BYTES) != hipSuccess || per_cu < 1) { fprintf(stderr, "kernel_launch: occupancy query says %d\n", per_cu); per_cu = 1; }
        (void)hipGetLastError();
        grid = (cus / 8) * 8;
        if (grid < 64) { fprintf(stderr, "kernel_launch: too few CUs (%d)\n", cus); grid = -1; return; }
    }
    if (grid < 0) return;
    (void)hipMemsetAsync((char*)d_ws + WS_CTL, 0, CTL_BYTES, stream);
    Params prm{};
    for (int i = 0; i < 20; ++i) prm.in[i] = (const float*)d_in[i];
    prm.out = (float*)d_out; prm.ws = (unsigned char*)d_ws;
    void* args[] = {&prm};
    hipError_t e = hipLaunchCooperativeKernel((const void*)mega_fwd, dim3(grid), dim3(NT), args, LDS_BYTES, stream);
    if (e != hipSuccess) fprintf(stderr, "cooperative launch failed: %s (grid %d)\n", hipGetErrorString(e), grid);
}
```
